# Optimizing an MI355X kernel written in HIP

```python
import jax
import jax.numpy as jnp
from jax import lax
import numpy as np

D_MODEL = 2048
BATCH = 4
SEQ = 4096
DEPTH = 2

GRID_W = 64
CTX_LEN = 256
MIX_WIDTH = D_MODEL

RET_WIDTH = D_MODEL // 4
RET_HEAD_DIM = 128
RET_HEADS = RET_WIDTH // RET_HEAD_DIM
RET_CHUNK = 128
RET_GN_EPS = 1e-5

MLA_WIDTH = D_MODEL // 2
MLA_V = 128
MLA_HEADS = MLA_WIDTH // MLA_V
MLA_NOPE = 128
MLA_ROPE = 64
Q_LORA = D_MODEL // 4
KV_LORA = D_MODEL // 8
ATTN_BLOCK = 128
ROPE_BASE = 10000.0
MLA_SCALE = (MLA_NOPE + MLA_ROPE) ** -0.5

RWKV_WIDTH = D_MODEL // 4
RWKV_HEAD = 64
RWKV_HEADS = RWKV_WIDTH // RWKV_HEAD
RWKV_LORA = 64
RWKV_FEAT = 3 * RWKV_WIDTH + 4 * RWKV_LORA
RWKV_GN_EPS = 64e-5

IN_WIDTHS = (RET_WIDTH, RET_WIDTH, RET_WIDTH, RET_WIDTH,
             Q_LORA, KV_LORA, MLA_ROPE, MLA_WIDTH,
             RWKV_FEAT, RWKV_WIDTH)
N_IN = sum(IN_WIDTHS)

ALPHA = (2 * DEPTH) ** 0.25
OUT_INIT = (8 * DEPTH) ** -0.25
LN_EPS = 1e-5
RMS_EPS = 1e-6
F32 = jnp.float32

kernel_name = 'hybrid_ret_mla_rwkv7_diffusion_block'


def split_cols(p, widths):
    out, start = [], 0
    for w in widths:
        out.append(p[..., start:start + w])
        start += w
    return out


def layer_norm(x, g, b, eps=LN_EPS):
    xf = x.astype(F32)
    mu = jnp.mean(xf, -1, keepdims=True)
    var = jnp.mean(jnp.square(xf - mu), -1, keepdims=True)
    return ((xf - mu) * lax.rsqrt(var + eps)).astype(x.dtype) * g + b


def rms_norm(x, g, eps=RMS_EPS):
    xf = x.astype(F32)
    return (xf * lax.rsqrt(jnp.mean(jnp.square(xf), -1, keepdims=True) + eps)).astype(x.dtype) * g


def head_group_norm(y, g, n_heads, eps):
    shp = y.shape
    yh = y.reshape(shp[:-1] + (n_heads, shp[-1] // n_heads)).astype(F32)
    mu = jnp.mean(yh, -1, keepdims=True)
    var = jnp.mean(jnp.square(yh - mu), -1, keepdims=True)
    return ((yh - mu) * lax.rsqrt(var + eps)).reshape(shp).astype(y.dtype) * g


def axial_rope(x, row, col):
    nf = MLA_ROPE // 4
    inv = ROPE_BASE ** (-jnp.arange(nf, dtype=F32) / nf)
    extra = (1,) * (x.ndim - 3)

    def rot(xh, pos):
        ang = pos.astype(F32)[:, None] * inv[None, :]
        ang = ang.reshape((ang.shape[0],) + extra + (nf,))
        cos, sin = jnp.cos(ang).astype(x.dtype), jnp.sin(ang).astype(x.dtype)
        x1, x2 = xh[..., :nf], xh[..., nf:]
        return jnp.concatenate([x1 * cos - x2 * sin, x2 * cos + x1 * sin], -1)

    half = MLA_ROPE // 2
    return jnp.concatenate([rot(x[..., :half], row), rot(x[..., half:], col)], -1)


def bidir_concat(a_ctx, a_lat):
    fwd = jnp.concatenate([a_ctx, a_lat], axis=1)
    bwd = jnp.concatenate([jnp.flip(a_ctx, 1), jnp.flip(a_lat, 1)], axis=1)
    return jnp.stack([fwd, bwd], 0)


def bidir_merge(y, n_ctx):
    y_ctx = y[0, :, :n_ctx] + jnp.flip(y[1, :, :n_ctx], 1)
    y_lat = y[0, :, n_ctx:] + jnp.flip(y[1, :, n_ctx:], 1)
    return y_ctx, y_lat


def centred_shift(p, mu):
    prev = jnp.pad(p[:, :-1], ((0, 0), (1, 0), (0, 0)))
    nxt = jnp.pad(p[:, 1:], ((0, 0), (0, 1), (0, 0)))
    return p + mu[0] * (prev - p) + mu[1] * (nxt - p)


def retention_bidir(q, k, v, decay_logit):
    out_dtype = q.dtype
    q, k, v = (t.astype(F32) for t in (q, k, v))
    n_dir, bsz, length, n_h, dh = q.shape
    C = RET_CHUNK
    nc = length // C
    k = k * dh ** -0.5
    q, k, v = (t.reshape(n_dir, bsz, nc, C, n_h, dh) for t in (q, k, v))
    log_g = jax.nn.log_sigmoid(decay_logit.astype(F32))
    i = jnp.arange(C, dtype=F32)
    rel = i[:, None] - i[None, :]
    dmask = jnp.where(rel >= 0, jnp.exp(jnp.maximum(rel, 0.0)[None, None] * log_g[:, :, None, None]), 0.0)
    s = jnp.einsum('dbnihe,dbnjhe->dbnhij', q, k) * dmask[:, None, None]
    intra = jnp.einsum('dbnhij,dbnjhe->dbnihe', s, v)
    zeta = jnp.exp((C - 1 - i)[None, :] * log_g[:, :, None])
    xi = jnp.exp((i + 1)[None, :] * log_g[:, :, None])
    u = jnp.einsum('dbnjhk,dhj,dbnjhv->ndbhkv', k, zeta, v)
    g_chunk = jnp.exp(C * log_g)[:, None, :, None, None]

    def step(state, u_n):
        return state * g_chunk + u_n, state

    _, s_prev = lax.scan(step, jnp.zeros(u.shape[1:], F32), u)
    cross = jnp.einsum('dbnihk,dhi,ndbhkv->dbnihv', q, xi, s_prev)
    return (intra + cross).reshape(n_dir, bsz, length, n_h * dh).astype(out_dtype)


def mla_attend(q_nope, q_rope, k_nope, k_rope, v):
    s = jnp.einsum('bqhd,bkhd->bhqk', q_nope, k_nope) + jnp.einsum('bqhr,bkr->bhqk', q_rope, k_rope)
    p = jax.nn.softmax(s.astype(F32) * MLA_SCALE, axis=-1).astype(v.dtype)
    return jnp.einsum('bhqk,bkhd->bqhd', p, v)


def rwkv7_bidir(r, k, v, w_lora, a_lora, w0, w2, a0, a2, k_k, k_a):
    out_dtype = r.dtype
    r, k, v, w_lora, a_lora = (t.astype(F32) for t in (r, k, v, w_lora, a_lora))
    n_dir, bsz, length, width = r.shape
    w_in_d = jnp.stack([w_lora[0, ..., :RWKV_LORA], w_lora[1, ..., RWKV_LORA:]])
    a_in_d = jnp.stack([a_lora[0, ..., :RWKV_LORA], a_lora[1, ..., RWKV_LORA:]])
    w_log = -jax.nn.softplus(-(w0[:, None, None] + jnp.einsum('dblr,drc->dblc', jnp.tanh(w_in_d), w2))) - 0.5
    decay = jnp.exp(-jnp.exp(w_log))
    a_rate = jax.nn.sigmoid(a0[:, None, None] + jnp.einsum('dblr,drc->dblc', a_in_d, a2))
    heads = lambda t: t.reshape(n_dir, bsz, length, RWKV_HEADS, RWKV_HEAD)
    kk = heads(k * k_k)
    kk = kk / jnp.maximum(jnp.sqrt(jnp.sum(jnp.square(kk), -1, keepdims=True)), 1e-12)
    k_eff = k * (1.0 + (a_rate - 1.0) * k_a)
    xs = tuple(jnp.moveaxis(t, 2, 0) for t in
               (heads(r), heads(decay), heads(k_eff), heads(v), -kk, kk * heads(a_rate)))

    def step(state, inp):
        r_t, w_t, k_t, v_t, a_t, b_t = inp
        sa = jnp.einsum('dbhvk,dbhk->dbhv', state, a_t)
        state = state * w_t[..., None, :] + sa[..., :, None] * b_t[..., None, :] + v_t[..., :, None] * k_t[..., None, :]
        return state, jnp.einsum('dbhvk,dbhk->dbhv', state, r_t)

    state0 = jnp.zeros((n_dir, bsz, RWKV_HEADS, RWKV_HEAD, RWKV_HEAD), F32)
    _, y = lax.scan(step, state0, xs)
    return jnp.moveaxis(y, 0, 2).reshape(n_dir, bsz, length, width).astype(out_dtype)


def mix_layer(x_lat, x_ctx, c, c_ctx, row, col, need_ctx, w_ada, b_ada, w_in, ret_decay_logit, ret_gn_g,
              mla_q_norm_g, mla_w_uq, mla_kv_norm_g, mla_w_ukv, rwkv_shift_mu, rwkv_w0, rwkv_w2, rwkv_a0,
              rwkv_a2, rwkv_k_k, rwkv_k_a, rwkv_r_k, rwkv_gn_g, w_out, ln_g, ln_b):
    bsz, n_lat = x_lat.shape[:2]
    n_ctx = x_ctx.shape[1]
    shift, scale, gate = jnp.split(jax.nn.silu(c) @ w_ada + b_ada, 3, axis=-1)
    shift_c, scale_c, gate_c = jnp.split(jax.nn.silu(c_ctx) @ w_ada + b_ada, 3, axis=-1)
    h_lat = x_lat * (1.0 + scale[:, None]) + shift[:, None]
    h_ctx = x_ctx * (1.0 + scale_c) + shift_c
    p_lat = split_cols(h_lat @ w_in, IN_WIDTHS)
    p_ctx = split_cols(h_ctx @ w_in, IN_WIDTHS)

    ret_seq = [bidir_concat(p_ctx[j], p_lat[j]).reshape(2, bsz, n_ctx + n_lat, RET_HEADS, RET_HEAD_DIM)
               for j in range(3)]
    ret_c, ret_l = bidir_merge(retention_bidir(ret_seq[0], ret_seq[1], ret_seq[2], ret_decay_logit), n_ctx)

    def ret_out(y, g):
        return head_group_norm(y, ret_gn_g, RET_HEADS, RET_GN_EPS) * jax.nn.silu(g)

    def q_heads(cq):
        q = (rms_norm(cq, mla_q_norm_g) @ mla_w_uq).reshape(cq.shape[:2] + (MLA_HEADS, MLA_NOPE + MLA_ROPE))
        return q[..., :MLA_NOPE], q[..., MLA_NOPE:]

    def kv_heads(ckv):
        kv = (rms_norm(ckv, mla_kv_norm_g) @ mla_w_ukv).reshape(ckv.shape[:2] + (MLA_HEADS, MLA_NOPE + MLA_V))
        return kv[..., :MLA_NOPE], kv[..., MLA_NOPE:]

    kn_c, v_c = kv_heads(p_ctx[5])
    kr_c = p_ctx[6]
    kn_l, v_l = kv_heads(p_lat[5])
    kr_l = axial_rope(p_lat[6], row, col)
    kn_all = jnp.concatenate([kn_c, kn_l], 1)
    kr_all = jnp.concatenate([kr_c, kr_l], 1)
    v_all = jnp.concatenate([v_c, v_l], 1)
    qn_l, qr_l = q_heads(p_lat[4])
    qr_l = axial_rope(qr_l, row, col)
    n_blk = n_lat // ATTN_BLOCK

    def to_blocks(t):
        return jnp.moveaxis(t.reshape((bsz, n_blk, ATTN_BLOCK) + t.shape[2:]), 1, 0)

    mla_l = lax.map(lambda qb: mla_attend(qb[0], qb[1], kn_all, kr_all, v_all), (to_blocks(qn_l), to_blocks(qr_l)))
    mla_l = jnp.moveaxis(mla_l, 0, 1).reshape(bsz, n_lat, MLA_WIDTH)

    feat_c = centred_shift(p_ctx[8], rwkv_shift_mu)
    feat_l = centred_shift(p_lat[8], rwkv_shift_mu)
    rw_seq = split_cols(bidir_concat(feat_c, feat_l), (RWKV_WIDTH,) * 3 + (2 * RWKV_LORA,) * 2)
    rw_c, rw_l = bidir_merge(rwkv7_bidir(rw_seq[0], rw_seq[1], rw_seq[2], rw_seq[3], rw_seq[4], rwkv_w0, rwkv_w2,
                                         rwkv_a0, rwkv_a2, rwkv_k_k, rwkv_k_a), n_ctx)

    def rwkv_out(y, feat, g):
        r_, k_, v_ = split_cols(feat, (RWKV_WIDTH,) * 3)
        shp = r_.shape[:-1] + (RWKV_HEADS, RWKV_HEAD)
        bonus = jnp.sum((r_ * k_).reshape(shp) * rwkv_r_k, -1, keepdims=True) * v_.reshape(shp)
        return (head_group_norm(y, rwkv_gn_g, RWKV_HEADS, RWKV_GN_EPS) + bonus.reshape(r_.shape)) * jax.nn.silu(g)

    def merge(ret_y, mla_y, rw_y, p, feat):
        return jnp.concatenate([ret_out(ret_y, p[3]), mla_y * jax.nn.silu(p[7]), rwkv_out(rw_y, feat, p[9])], -1) @ w_out

    x_lat_new = layer_norm(ALPHA * x_lat + gate[:, None] * merge(ret_l, mla_l, rw_l, p_lat, feat_l), ln_g, ln_b)
    if not need_ctx:
        return x_lat_new, x_ctx
    qn_c, qr_c = q_heads(p_ctx[4])
    mla_c = mla_attend(qn_c, qr_c, kn_c, kr_c, v_c).reshape(bsz, n_ctx, MLA_WIDTH)
    x_ctx_new = layer_norm(ALPHA * x_ctx + gate_c * merge(ret_c, mla_c, rw_c, p_ctx, feat_c), ln_g, ln_b)
    return x_lat_new, x_ctx_new


def setup_inputs(seed: int = 0) -> dict:
    key = jax.random.key(seed)
    ks = jax.random.split(key, 25)
    nrm = lambda k, shape: jax.random.normal(k, shape, F32)
    L = DEPTH
    gam = 1.0 - 2.0 ** (-5.0 - np.arange(RET_HEADS))
    ret_logit0 = jnp.asarray(np.log(gam / (1.0 - gam)), F32)
    return {
        'x': nrm(ks[0], (BATCH, SEQ, D_MODEL)),
        'c': nrm(ks[1], (BATCH, D_MODEL)),
        'ctx': nrm(ks[2], (BATCH, CTX_LEN, D_MODEL)),
        'c_ctx': nrm(ks[3], (D_MODEL,)),
        'w_ada': nrm(ks[4], (L, D_MODEL, 3 * D_MODEL)) * D_MODEL ** -0.5,
        'b_ada': 0.02 * nrm(ks[5], (L, 3 * D_MODEL)),
        'w_in': nrm(ks[6], (L, D_MODEL, N_IN)) * D_MODEL ** -0.5,
        'ret_decay_logit': ret_logit0 + 0.1 * nrm(ks[7], (L, 2, RET_HEADS)),
        'ret_gn_g': 1.0 + 0.02 * nrm(ks[8], (L, RET_WIDTH)),
        'mla_q_norm_g': 1.0 + 0.02 * nrm(ks[9], (L, Q_LORA)),
        'mla_w_uq': nrm(ks[10], (L, Q_LORA, MLA_HEADS * (MLA_NOPE + MLA_ROPE))) * Q_LORA ** -0.5,
        'mla_kv_norm_g': 1.0 + 0.02 * nrm(ks[11], (L, KV_LORA)),
        'mla_w_ukv': nrm(ks[12], (L, KV_LORA, MLA_HEADS * (MLA_NOPE + MLA_V))) * KV_LORA ** -0.5,
        'rwkv_shift_mu': jax.random.uniform(ks[13], (L, 2, RWKV_FEAT), F32, 0.0, 0.5),
        'rwkv_w0': jnp.linspace(-6.0, -1.0, RWKV_WIDTH, dtype=F32) + 0.1 * nrm(ks[14], (L, 2, RWKV_WIDTH)),
        'rwkv_w2': 0.5 * nrm(ks[15], (L, 2, RWKV_LORA, RWKV_WIDTH)) * RWKV_LORA ** -0.5,
        'rwkv_a0': 0.1 * nrm(ks[16], (L, 2, RWKV_WIDTH)),
        'rwkv_a2': 0.5 * nrm(ks[17], (L, 2, RWKV_LORA, RWKV_WIDTH)) * RWKV_LORA ** -0.5,
        'rwkv_k_k': 0.85 + 0.05 * nrm(ks[18], (L, RWKV_WIDTH)),
        'rwkv_k_a': 1.0 + 0.05 * nrm(ks[19], (L, RWKV_WIDTH)),
        'rwkv_r_k': 0.1 * nrm(ks[20], (L, RWKV_HEADS, RWKV_HEAD)),
        'rwkv_gn_g': 1.0 + 0.02 * nrm(ks[21], (L, RWKV_WIDTH)),
        'w_out': nrm(ks[22], (L, MIX_WIDTH, D_MODEL)) * MIX_WIDTH ** -0.5 * OUT_INIT,
        'ln_g': 1.0 + 0.02 * nrm(ks[23], (L, D_MODEL)),
        'ln_b': 0.02 * nrm(ks[24], (L, D_MODEL)),
    }


def reference(x, c, ctx, c_ctx, w_ada, b_ada, w_in, ret_decay_logit, ret_gn_g, mla_q_norm_g, mla_w_uq,
              mla_kv_norm_g, mla_w_ukv, rwkv_shift_mu, rwkv_w0, rwkv_w2, rwkv_a0, rwkv_a2, rwkv_k_k, rwkv_k_a,
              rwkv_r_k, rwkv_gn_g, w_out, ln_g, ln_b):
    n_lat = x.shape[1]
    rows = n_lat // GRID_W
    row = jnp.repeat(jnp.arange(rows, dtype=jnp.int32), GRID_W, total_repeat_length=rows * GRID_W)
    col = jnp.arange(rows * GRID_W, dtype=jnp.int32) % GRID_W
    x_lat, x_ctx = x, ctx
    for l in range(DEPTH):
        x_lat, x_ctx = mix_layer(
            x_lat, x_ctx, c, c_ctx, row, col, l < DEPTH - 1,
            w_ada[l], b_ada[l], w_in[l], ret_decay_logit[l], ret_gn_g[l], mla_q_norm_g[l], mla_w_uq[l],
            mla_kv_norm_g[l], mla_w_ukv[l], rwkv_shift_mu[l], rwkv_w0[l], rwkv_w2[l], rwkv_a0[l], rwkv_a2[l],
            rwkv_k_k[l], rwkv_k_a[l], rwkv_r_k[l], rwkv_gn_g[l], w_out[l], ln_g[l], ln_b[l])
    return x_lat
```

```cpp
#include <hip/hip_runtime.h>
#include <hip/hip_cooperative_groups.h>
#include <cstdio>
namespace cg = cooperative_groups;

#define DI __device__ __forceinline__
typedef unsigned short u16;
using bf16x8 = __attribute__((ext_vector_type(8))) short;
using s16x4 = __attribute__((ext_vector_type(4))) short;
using f32x16 = __attribute__((ext_vector_type(16))) float;
using f32x4 = __attribute__((ext_vector_type(4))) float;
using u32x4 = __attribute__((ext_vector_type(4))) unsigned;
using u32x2 = __attribute__((ext_vector_type(2))) unsigned;
#define MFMA(a, b, c) __builtin_amdgcn_mfma_f32_32x32x16_bf16((a), (b), (c), 0, 0, 0)

constexpr int DM = 2048, NIN = 6208, NLAT = 16384, NTOK = 17408, LPOS = 4352;
constexpr int NTHR = 512;
constexpr size_t LDS_BYTES = 143360;
constexpr float ALPHA = 1.4142135623730951f;
constexpr float QSCALE = 0.07216878364870323f * 1.4426950408889634f;

struct KP {
  const float *x, *c, *ctx, *c_ctx, *w_ada, *b_ada, *w_in, *ret_logit, *ret_gn, *q_g, *w_uq, *kv_g, *w_ukv, *mu, *w0, *w2, *a0,
      *a2, *k_k, *k_a, *r_k, *rw_gn, *w_out, *ln_g, *ln_b;
  float* out;
  u16 *P, *H, *Q, *Kn, *Vt, *Kr, *Yret, *Yrw, *WinT, *WuqT, *WukvT, *WoutT, *W2T, *A2T;
  float *X1c, *mod;
  unsigned* cnt;
};

DI int otid() { int t = threadIdx.x; asm volatile("" : "+v"(t)); return t; }
DI int obid() { int t = blockIdx.x; asm volatile("" : "+s"(t)); return t; }
DI float bf2f(u16 v) { return __uint_as_float(((unsigned)v) << 16); }
DI float bflo(unsigned v) { return __uint_as_float(v << 16); }
DI float bfhi(unsigned v) { return __uint_as_float(v & 0xffff0000u); }
DI u16 f2bf(float a) { __bf16 r = (__bf16)a; return __builtin_bit_cast(u16, r); }
DI unsigned pk2(float a, float b) {
  typedef __bf16 bf2 __attribute__((ext_vector_type(2)));
  typedef float f2 __attribute__((ext_vector_type(2)));
  f2 v = {a, b};
  bf2 r = __builtin_convertvector(v, bf2);
  return __builtin_bit_cast(unsigned, r);
}
DI int crow(int reg, int h) { return (reg & 3) + 8 * (reg >> 2) + 4 * h; }
DI float silu(float x) { return x / (1.f + __expf(-x)); }
DI void unpack8(const bf16x8& v, float* f) {
  u32x4 u = __builtin_bit_cast(u32x4, v);
#pragma unroll
  for (int i = 0; i < 4; ++i) { f[2 * i] = bflo(u[i]); f[2 * i + 1] = bfhi(u[i]); }
}
DI bf16x8 pack8(const float* f) {
  u32x4 u;
#pragma unroll
  for (int i = 0; i < 4; ++i) u[i] = pk2(f[2 * i], f[2 * i + 1]);
  return __builtin_bit_cast(bf16x8, u);
}
DI bf16x8 ld8(const u16* p) { return *(const bf16x8*)p; }
DI bf16x8 zero8() { bf16x8 z = {0, 0, 0, 0, 0, 0, 0, 0}; return z; }
DI f32x16 zero16() { f32x16 z; for (int i = 0; i < 16; ++i) z[i] = 0.f; return z; }
DI s16x4 trread(const u16* p) {
  return __builtin_amdgcn_ds_read_tr16_b64_v4i16((s16x4 __attribute__((address_space(3)))*)(p));
}
DI bf16x8 cat4(s16x4 lo, s16x4 hi) { return __builtin_shufflevector(lo, hi, 0, 1, 2, 3, 4, 5, 6, 7); }
DI void rope_cs(int pos, int i, float& cs, float& sn) {
  float inv = exp2f(-(float)i * (13.287712379549449f / 16.f));
  float rev = (float)pos * inv * 0.15915494309189535f;
  rev -= floorf(rev);
  cs = __builtin_amdgcn_cosf(rev);
  sn = __builtin_amdgcn_sinf(rev);
}

DI void transpose_item(const float* src, u16* dst, int K, int N, int kt, int nt, char* smem) {
  float* tile = (float*)smem;
  const int tid = otid();
  __syncthreads();
  {
    const int kk = tid >> 4, n4 = tid & 15;
#pragma unroll
    for (int i = 0; i < 2; ++i) {
      const int k = kk + 32 * i;
      f32x4 v = *(const f32x4*)(src + (size_t)(kt * 64 + k) * N + nt * 64 + n4 * 4);
      tile[k * 65 + n4 * 4 + 0] = v[0]; tile[k * 65 + n4 * 4 + 1] = v[1];
      tile[k * 65 + n4 * 4 + 2] = v[2]; tile[k * 65 + n4 * 4 + 3] = v[3];
    }
  }
  __syncthreads();
  {
    const int n = tid >> 3, k8 = tid & 7;
    float f[8];
#pragma unroll
    for (int j = 0; j < 8; ++j) f[j] = tile[(k8 * 8 + j) * 65 + n];
    *(bf16x8*)(dst + (size_t)(nt * 64 + n) * K + kt * 64 + k8 * 8) = pack8(f);
  }
}

DI void convert_weights(const KP& p, int layer, char* smem) {
  const int n_in = 32 * 97, n_uq = 8 * 24, n_ukv = 4 * 32, n_out = 32 * 32, n_lora = 8;
  const int total = n_in + n_uq + n_ukv + n_out + 4 * n_lora;
  for (int it = obid(); it < total; it += gridDim.x) {
    int i = it;
    if (i < n_in) { transpose_item(p.w_in + (size_t)layer * DM * NIN, p.WinT, DM, NIN, i / 97, i % 97, smem); continue; }
    i -= n_in;
    if (i < n_uq) { transpose_item(p.w_uq + (size_t)layer * 512 * 1536, p.WuqT, 512, 1536, i / 24, i % 24, smem); continue; }
    i -= n_uq;
    if (i < n_ukv) { transpose_item(p.w_ukv + (size_t)layer * 256 * 2048, p.WukvT, 256, 2048, i / 32, i % 32, smem); continue; }
    i -= n_ukv;
    if (i < n_out) { transpose_item(p.w_out + (size_t)layer * DM * DM, p.WoutT, DM, DM, i / 32, i % 32, smem); continue; }
    i -= n_out;
    {
      const int which = i / (2 * n_lora), r = i % (2 * n_lora), d = r / n_lora, nt = r % n_lora;
      const float* src = (which ? p.a2 : p.w2) + ((size_t)layer * 2 + d) * 64 * 512;
      u16* dst = (which ? p.A2T : p.W2T) + (size_t)d * 512 * 64;
      transpose_item(src, dst, 64, 512, 0, nt, smem);
    }
  }
}

DI void mod_phase(const KP& p, char* smem) {
  float* sc = (float*)smem;
  float* red = sc + 5 * 2048;
  const int tid = otid();
  __syncthreads();
  for (int i = tid; i < 5 * 2048; i += NTHR) {
    float v = i < 4 * 2048 ? p.c[i] : p.c_ctx[i - 4 * 2048];
    sc[i] = silu(v);
  }
  __syncthreads();
  const int kg = tid >> 5, col = tid & 31;
  for (int it = obid(); it < 384; it += gridDim.x) {
    const int layer = it / 192, j = (it % 192) * 32 + col;
    const float* w = p.w_ada + (size_t)layer * DM * 6144 + j;
    float acc[5] = {0.f, 0.f, 0.f, 0.f, 0.f};
    for (int k = kg * 128; k < kg * 128 + 128; ++k) {
      float wv = w[(size_t)k * 6144];
#pragma unroll
      for (int r = 0; r < 5; ++r) acc[r] += sc[r * 2048 + k] * wv;
    }
#pragma unroll
    for (int r = 0; r < 5; ++r) red[(kg * 5 + r) * 32 + col] = acc[r];
    __syncthreads();
    if (tid < 160) {
      const int r = tid >> 5;
      float s = p.b_ada[(size_t)layer * 6144 + j];
      for (int g = 0; g < 16; ++g) s += red[(g * 5 + r) * 32 + col];
      p.mod[((size_t)layer * 5 + r) * 6144 + j] = s;
    }
    __syncthreads();
  }
}

DI void h0_phase(const KP& p) {
  const int lane = otid() & 63, w = otid() >> 6;
  for (int row = obid() * 8 + w; row < NTOK; row += gridDim.x * 8) {
    const float* src = row < NLAT ? p.x + (size_t)row * DM : p.ctx + (size_t)(row - NLAT) * DM;
    const int bb = row < NLAT ? (row >> 12) : 4;
    const float* md = p.mod + (size_t)bb * 6144;
#pragma unroll
    for (int i = 0; i < 8; ++i) {
      const int c = (i * 64 + lane) * 4;
      f32x4 v = *(const f32x4*)(src + c), sh = *(const f32x4*)(md + c), scl = *(const f32x4*)(md + 2048 + c);
      u32x2 o;
      o[0] = pk2(v[0] * (1.f + scl[0]) + sh[0], v[1] * (1.f + scl[1]) + sh[1]);
      o[1] = pk2(v[2] * (1.f + scl[2]) + sh[2], v[3] * (1.f + scl[3]) + sh[3]);
      *(u32x2*)(p.H + (size_t)row * DM + c) = o;
    }
  }
}

DI void gemm_tile(const KP& p, int mode, int layer, int m0, int n0, char* smem) {
  u16* As = (u16*)smem;
  u16* Bs = As + 256 * 72;
  float* rs = (float*)(Bs + 128 * 72);
  const int tid = otid(), lane = tid & 63, w = tid >> 6, wm = w >> 1, wn = w & 1, l31 = lane & 31, h = lane >> 5;
  const u16* A; const u16* Bt; const float* gv = nullptr; int lda, K, N;
  if (mode == 0) { A = p.H; lda = DM; K = DM; N = NIN; Bt = p.WinT; }
  else if (mode == 1) { A = p.P + 2048; lda = NIN; K = 512; N = 1536; Bt = p.WuqT; gv = p.q_g + layer * 512; }
  else if (mode == 2) { A = p.P + 2560; lda = NIN; K = 256; N = 2048; Bt = p.WukvT; gv = p.kv_g + layer * 256; }
  else { A = p.H; lda = DM; K = DM; N = DM; Bt = p.WoutT; }
  const bool xf = (mode == 1 || mode == 2);
  __syncthreads();
  if (xf) {
    const int r = tid >> 1, part = tid & 1;
    const u16* src = A + (size_t)(m0 + r) * lda + part * (K >> 1);
    float ss = 0.f;
    for (int i = 0; i < (K >> 1); i += 8) {
      float f[8]; unpack8(ld8(src + i), f);
#pragma unroll
      for (int j = 0; j < 8; ++j) ss += f[j] * f[j];
    }
    ss += __shfl_xor(ss, 1);
    if (!part) rs[r] = rsqrtf(ss / (float)K + 1e-6f);
    __syncthreads();
  }
  f32x16 acc[2][2];
#pragma unroll
  for (int i = 0; i < 2; ++i)
#pragma unroll
    for (int j = 0; j < 2; ++j) acc[i][j] = zero16();
  bf16x8 ra[4], rb[2];
  const int arow = tid >> 3, ac = tid & 7;
  auto loadg = [&](int k0) {
#pragma unroll
    for (int i = 0; i < 4; ++i) {
      const int row = arow + 64 * i;
      bf16x8 v = ld8(A + (size_t)(m0 + row) * lda + k0 + ac * 8);
      if (xf) {
        float f[8]; unpack8(v, f);
        const float s = rs[row];
        f32x4 g0 = *(const f32x4*)(gv + k0 + ac * 8), g1 = *(const f32x4*)(gv + k0 + ac * 8 + 4);
#pragma unroll
        for (int j = 0; j < 4; ++j) { f[j] *= s * g0[j]; f[4 + j] *= s * g1[j]; }
        v = pack8(f);
      }
      ra[i] = v;
    }
#pragma unroll
    for (int i = 0; i < 2; ++i) {
      int nrow = n0 + arow + 64 * i;
      nrow = nrow < N ? nrow : N - 1;
      rb[i] = ld8(Bt + (size_t)nrow * K + k0 + ac * 8);
    }
  };
  loadg(0);
  for (int k0 = 0; k0 < K; k0 += 64) {
    __syncthreads();
#pragma unroll
    for (int i = 0; i < 4; ++i) *(bf16x8*)(As + (arow + 64 * i) * 72 + ac * 8) = ra[i];
#pragma unroll
    for (int i = 0; i < 2; ++i) *(bf16x8*)(Bs + (arow + 64 * i) * 72 + ac * 8) = rb[i];
    __syncthreads();
    if (k0 + 64 < K) loadg(k0 + 64);
#pragma unroll
    for (int ks = 0; ks < 4; ++ks) {
      bf16x8 a0 = ld8(As + (wm * 64 + l31) * 72 + ks * 16 + h * 8);
      bf16x8 a1 = ld8(As + (wm * 64 + 32 + l31) * 72 + ks * 16 + h * 8);
      bf16x8 b0 = ld8(Bs + (wn * 64 + l31) * 72 + ks * 16 + h * 8);
      bf16x8 b1 = ld8(Bs + (wn * 64 + 32 + l31) * 72 + ks * 16 + h * 8);
      acc[0][0] = MFMA(a0, b0, acc[0][0]);
      acc[0][1] = MFMA(a0, b1, acc[0][1]);
      acc[1][0] = MFMA(a1, b0, acc[1][0]);
      acc[1][1] = MFMA(a1, b1, acc[1][1]);
    }
  }
#pragma unroll
  for (int mi = 0; mi < 2; ++mi)
#pragma unroll
    for (int ni = 0; ni < 2; ++ni) {
      const int cb = n0 + wn * 64 + ni * 32;
      if (cb >= N) continue;
      const int col = cb + l31;
      const int rb0 = m0 + wm * 64 + mi * 32;
      const f32x16& a = acc[mi][ni];
      if (mode == 0) {
#pragma unroll
        for (int r = 0; r < 16; ++r) p.P[(size_t)(rb0 + crow(r, h)) * NIN + col] = f2bf(a[r]);
      } else if (mode == 1) {
        const int dd = cb % 192;
        const bool rope = (dd >= 128) && (rb0 < NLAT);
        const int part = (dd - 128) >> 5;
#pragma unroll
        for (int r = 0; r < 16; ++r) {
          const int row = rb0 + crow(r, h);
          float v = a[r] * QSCALE;
          if (rope) {
            const int t = row & 4095;
            const int pos = part ? (t & 63) : (t >> 6);
            float cs, sn; rope_cs(pos, l31 & 15, cs, sn);
            const float pr = __shfl_xor(v, 16);
            v = (l31 < 16) ? (v * cs - pr * sn) : (v * cs + pr * sn);
          }
          p.Q[(size_t)row * 1536 + col] = f2bf(v);
        }
      } else if (mode == 2) {
        const int head = col >> 8, dd = col & 255;
#pragma unroll
        for (int g = 0; g < 4; ++g) {
          const int row = rb0 + 8 * g + 4 * h;
          int b, pos;
          if (row < NLAT) { b = row >> 12; pos = 256 + (row & 4095); } else { b = (row - NLAT) >> 8; pos = (row - NLAT) & 255; }
          if (dd < 128) {
#pragma unroll
            for (int j = 0; j < 4; ++j) p.Kn[((size_t)(b * 8 + head) * LPOS + pos + j) * 128 + dd] = f2bf(a[4 * g + j]);
          } else {
            u32x2 o; o[0] = pk2(a[4 * g], a[4 * g + 1]); o[1] = pk2(a[4 * g + 2], a[4 * g + 3]);
            *(u32x2*)(p.Vt + ((size_t)(b * 8 + head) * 128 + (dd - 128)) * LPOS + pos) = o;
          }
        }
      } else {
#pragma unroll
        for (int r = 0; r < 16; ++r) {
          const int row = rb0 + crow(r, h);
          const int bb = row < NLAT ? (row >> 12) : 4;
          const float gate = p.mod[((size_t)layer * 5 + bb) * 6144 + 4096 + col];
          float xv;
          float* dst;
          if (row < NLAT) {
            dst = p.out + (size_t)row * DM + col;
            xv = layer == 0 ? p.x[(size_t)row * DM + col] : *dst;
          } else {
            dst = p.X1c + (size_t)(row - NLAT) * DM + col;
            xv = p.ctx[(size_t)(row - NLAT) * DM + col];
          }
          *dst = ALPHA * xv + gate * a[r];
        }
      }
    }
}

DI void krope_item(const KP& p, int it) {
  const int tid = otid(), tok = tid >> 6, dim = tid & 63;
  const int row = it * 8 + tok;
  const u16* src = p.P + (size_t)row * NIN + 2816;
  float v = bf2f(src[dim]);
  int b, pos;
  if (row < NLAT) {
    const float pr = bf2f(src[dim ^ 16]);
    const int t = row & 4095, part = dim >> 5;
    const int ps = part ? (t & 63) : (t >> 6);
    float cs, sn; rope_cs(ps, dim & 15, cs, sn);
    v = ((dim & 31) < 16) ? (v * cs - pr * sn) : (v * cs + pr * sn);
    b = row >> 12; pos = 256 + t;
  } else { b = (row - NLAT) >> 8; pos = (row - NLAT) & 255; }
  p.Kr[((size_t)b * LPOS + pos) * 64 + dim] = f2bf(v);
}

DI void attn_item(const KP& p, int qrow0, int b, int hd, int nkeys, char* smem) {
  u16* Ksm = (u16*)smem;
  u16* Vsm = Ksm + 64 * 200;
  const int tid = otid(), lane = tid & 63, w = tid >> 6, l31 = lane & 31, h = lane >> 5;
  const int qrow = qrow0 + 32 * w + l31;
  bf16x8 qf[12];
  {
    const u16* qp = p.Q + (size_t)qrow * 1536 + hd * 192 + 8 * h;
#pragma unroll
    for (int ks = 0; ks < 12; ++ks) qf[ks] = ld8(qp + 16 * ks);
  }
  f32x16 o[4];
#pragma unroll
  for (int i = 0; i < 4; ++i) o[i] = zero16();
  float m = -1e30f, lsum = 0.f;
  const u16* kn = p.Kn + (size_t)(b * 8 + hd) * LPOS * 128;
  const u16* kr = p.Kr + (size_t)b * LPOS * 64;
  const u16* vt = p.Vt + (size_t)(b * 8 + hd) * 128 * LPOS;
  for (int kt0 = 0; kt0 < nkeys; kt0 += 64) {
    __syncthreads();
#pragma unroll
    for (int i = 0; i < 3; ++i) {
      const int idx = tid + NTHR * i, key = idx / 24, c = idx % 24;
      const u16* src = c < 16 ? kn + (size_t)(kt0 + key) * 128 + c * 8 : kr + (size_t)(kt0 + key) * 64 + (c - 16) * 8;
      *(bf16x8*)(Ksm + key * 200 + c * 8) = ld8(src);
    }
#pragma unroll
    for (int i = 0; i < 2; ++i) {
      const int idx = tid + NTHR * i, d = idx >> 3, c = idx & 7;
      *(bf16x8*)(Vsm + d * 72 + c * 8) = ld8(vt + (size_t)d * LPOS + kt0 + c * 8);
    }
    __syncthreads();
    f32x16 s[2];
#pragma unroll
    for (int kt = 0; kt < 2; ++kt) {
      s[kt] = zero16();
#pragma unroll
      for (int ks = 0; ks < 12; ++ks) {
        bf16x8 a = ld8(Ksm + (kt * 32 + l31) * 200 + ks * 16 + h * 8);
        s[kt] = MFMA(a, qf[ks], s[kt]);
        if ((ks & 3) == 3) asm volatile("" ::: "memory");
      }
    }
    float mx = s[0][0];
#pragma unroll
    for (int r = 0; r < 16; ++r) { mx = fmaxf(mx, s[0][r]); mx = fmaxf(mx, s[1][r]); }
    mx = fmaxf(mx, __shfl_xor(mx, 32));
    const float mnew = fmaxf(m, mx);
    const float alpha = exp2f(m - mnew);
    m = mnew;
    float ps = 0.f;
#pragma unroll
    for (int kt = 0; kt < 2; ++kt)
#pragma unroll
      for (int r = 0; r < 16; ++r) { float e = exp2f(s[kt][r] - mnew); s[kt][r] = e; ps += e; }
    lsum = lsum * alpha + ps;
#pragma unroll
    for (int dt = 0; dt < 4; ++dt)
#pragma unroll
      for (int r = 0; r < 16; ++r) o[dt][r] *= alpha;
#pragma unroll
    for (int kt = 0; kt < 2; ++kt)
#pragma unroll
      for (int sI = 0; sI < 2; ++sI) {
        u32x4 pu;
#pragma unroll
        for (int j = 0; j < 4; ++j) pu[j] = pk2(s[kt][8 * sI + 2 * j], s[kt][8 * sI + 2 * j + 1]);
        const bf16x8 pb = __builtin_bit_cast(bf16x8, pu);
        const int kb = kt * 32 + sI * 16 + 4 * h;
#pragma unroll
        for (int dt = 0; dt < 4; ++dt) {
          const u16* vp = Vsm + (dt * 32 + l31) * 72 + kb;
          s16x4 lo = *(const s16x4*)vp, hi = *(const s16x4*)(vp + 8);
          o[dt] = MFMA(cat4(lo, hi), pb, o[dt]);
        }
        asm volatile("" ::: "memory");
      }
  }
  lsum += __shfl_xor(lsum, 32);
  const float inv = 1.f / lsum;
  const u16* gp = p.P + (size_t)qrow * NIN + 2880 + hd * 128;
  u16* op = p.H + (size_t)qrow * DM + 512 + hd * 128;
#pragma unroll
  for (int dt = 0; dt < 4; ++dt)
#pragma unroll
    for (int g = 0; g < 4; ++g) {
      const int d0 = dt * 32 + 8 * g + 4 * h;
      u32x2 gg = *(const u32x2*)(gp + d0);
      float g0 = bflo(gg[0]), g1 = bfhi(gg[0]), g2 = bflo(gg[1]), g3 = bfhi(gg[1]);
      u32x2 ov;
      ov[0] = pk2(o[dt][4 * g] * inv * silu(g0), o[dt][4 * g + 1] * inv * silu(g1));
      ov[1] = pk2(o[dt][4 * g + 2] * inv * silu(g2), o[dt][4 * g + 3] * inv * silu(g3));
      *(u32x2*)(op + d0) = ov;
    }
}

DI void ret_chain(const KP& p, int layer, int chain, char* smem) {
  const int d = chain >> 4, b = (chain >> 2) & 3, hd = chain & 3;
  u16* Qs = (u16*)smem;
  u16* Ks = Qs + 128 * 136;
  u16* Vs = Ks + 128 * 136;
  u16* Sts = Vs + 128 * 136;
  const int tid = otid(), lane = tid & 63, w = tid >> 6, l31 = lane & 31, h = lane >> 5;
  const int q4 = (lane & 15) >> 2, p4 = lane & 3, blk = (lane >> 4) & 1;
  const float logit = p.ret_logit[(layer * 2 + d) * 4 + hd];
  const float z = -logit;
  const float logg = -(fmaxf(z, 0.f) + log1pf(expf(-fabsf(z))));
  const float lg2 = logg * 1.4426950408889634f;
  const float gC = exp2f(128.f * lg2);
  const float kscale = 0.08838834764831845f;
  const int iw = w & 3, half = w >> 2;
  const int kt = w & 3, vh = w >> 2;
  f32x16 st[2];
  st[0] = zero16(); st[1] = zero16();
  __syncthreads();
  for (int i = tid; i < 128 * 136 / 8; i += NTHR) *(bf16x8*)(Sts + i * 8) = zero8();
  bf16x8 rq[4], rk[4], rv[4];
  const int trow = tid >> 4, tc = tid & 15;
  auto rowbase = [&](int n) -> size_t {
    if (d == 0) return n < 2 ? (size_t)(NLAT + b * 256 + 128 * n) : (size_t)(b * 4096 + 128 * (n - 2));
    return n < 2 ? (size_t)(NLAT + b * 256 + 128 * (1 - n)) : (size_t)(b * 4096 + 128 * (33 - n));
  };
  auto loadg = [&](int n) {
    const size_t rb = rowbase(n);
#pragma unroll
    for (int i = 0; i < 4; ++i) {
      const u16* src = p.P + (rb + trow + 32 * i) * NIN + hd * 128 + tc * 8;
      rq[i] = ld8(src); rk[i] = ld8(src + 512); rv[i] = ld8(src + 1024);
    }
  };
  loadg(0);
  for (int n = 0; n < 34; ++n) {
    const size_t rb = rowbase(n);
#pragma unroll
    for (int i = 0; i < 4; ++i) {
      const int j = trow + 32 * i;
      *(bf16x8*)(Qs + j * 136 + tc * 8) = rq[i];
      *(bf16x8*)(Ks + j * 136 + tc * 8) = rk[i];
      const float zeta = exp2f((d == 0 ? (float)(127 - j) : (float)j) * lg2) * kscale;
      float f[8]; unpack8(rv[i], f);
#pragma unroll
      for (int jj = 0; jj < 8; ++jj) f[jj] *= zeta;
      *(bf16x8*)(Vs + j * 136 + tc * 8) = pack8(f);
    }
    __syncthreads();
    if (n + 1 < 34) loadg(n + 1);
    f32x16 acc[2];
    acc[0] = zero16(); acc[1] = zero16();
    bf16x8 qf[8];
#pragma unroll
    for (int ks = 0; ks < 8; ++ks) qf[ks] = ld8(Qs + (32 * iw + l31) * 136 + 16 * ks + 8 * h);
#pragma unroll
    for (int et = 0; et < 2; ++et)
#pragma unroll
      for (int ks = 0; ks < 8; ++ks) {
        bf16x8 a = ld8(Sts + (32 * (2 * half + et) + l31) * 136 + 16 * ks + 8 * h);
        acc[et] = MFMA(a, qf[ks], acc[et]);
      }
#pragma unroll
    for (int et = 0; et < 2; ++et)
#pragma unroll
      for (int r = 0; r < 16; ++r) acc[et][r] *= gC;
    const int ii = 32 * iw + l31;
#pragma unroll
    for (int jt = 0; jt < 4; ++jt) {
      f32x16 sT = zero16();
#pragma unroll
      for (int ks = 0; ks < 8; ++ks) {
        bf16x8 a = ld8(Ks + (32 * jt + l31) * 136 + 16 * ks + 8 * h);
        sT = MFMA(a, qf[ks], sT);
      }
#pragma unroll
      for (int r = 0; r < 16; ++r) {
        const int j = 32 * jt + crow(r, h);
        const bool keep = d == 0 ? (ii >= j) : (j >= ii);
        sT[r] = keep ? sT[r] : 0.f;
      }
#pragma unroll
      for (int sI = 0; sI < 2; ++sI) {
        u32x4 pu;
#pragma unroll
        for (int j = 0; j < 4; ++j) pu[j] = pk2(sT[8 * sI + 2 * j], sT[8 * sI + 2 * j + 1]);
        const bf16x8 pb = __builtin_bit_cast(bf16x8, pu);
        const int j0 = 32 * jt + 16 * sI + 4 * h;
#pragma unroll
        for (int et = 0; et < 2; ++et) {
          const u16* vp = Vs + (j0 + q4) * 136 + 32 * (2 * half + et) + 16 * blk + 4 * p4;
          s16x4 lo = trread(vp), hi = trread(vp + 8 * 136);
          acc[et] = MFMA(cat4(lo, hi), pb, acc[et]);
        }
      }
    }
    {
      const float rho = exp2f((d == 0 ? (float)(ii - 127) : (float)(-ii)) * lg2);
      u16* yp = p.Yret + ((size_t)d * NTOK + rb + ii) * 512 + hd * 128;
#pragma unroll
      for (int et = 0; et < 2; ++et)
#pragma unroll
        for (int g = 0; g < 4; ++g) {
          const int e0 = 32 * (2 * half + et) + 8 * g + 4 * h;
          u32x2 ov;
          ov[0] = pk2(acc[et][4 * g] * rho, acc[et][4 * g + 1] * rho);
          ov[1] = pk2(acc[et][4 * g + 2] * rho, acc[et][4 * g + 3] * rho);
          *(u32x2*)(yp + e0) = ov;
        }
    }
#pragma unroll
    for (int vi = 0; vi < 2; ++vi)
#pragma unroll
      for (int r = 0; r < 16; ++r) st[vi][r] *= gC;
#pragma unroll
    for (int ks = 0; ks < 8; ++ks) {
      const int jb = 16 * ks + 4 * h + q4;
      const u16* kp = Ks + jb * 136 + 32 * kt + 16 * blk + 4 * p4;
      const bf16x8 a = cat4(trread(kp), trread(kp + 8 * 136));
#pragma unroll
      for (int vi = 0; vi < 2; ++vi) {
        const u16* vp = Vs + jb * 136 + 32 * (2 * vh + vi) + 16 * blk + 4 * p4;
        const bf16x8 bfr = cat4(trread(vp), trread(vp + 8 * 136));
        st[vi] = MFMA(a, bfr, st[vi]);
      }
    }
    __syncthreads();
#pragma unroll
    for (int vi = 0; vi < 2; ++vi)
#pragma unroll
      for (int g = 0; g < 4; ++g) {
        const int v = 32 * (2 * vh + vi) + l31, k0 = 32 * kt + 8 * g + 4 * h;
        u32x2 ov;
        ov[0] = pk2(st[vi][4 * g], st[vi][4 * g + 1]);
        ov[1] = pk2(st[vi][4 * g + 2], st[vi][4 * g + 3]);
        *(u32x2*)(Sts + v * 136 + k0) = ov;
      }
  }
}

DI void rwkv_chain(const KP& p, int layer, int chain, char* smem) {
  const int d = chain >> 5, b = (chain >> 3) & 3, hd = chain & 7;
  float* buf = (float*)smem;
  u16* twS = (u16*)(smem + 98304);
  u16* alS = twS + 32 * 72;
  const int tid = otid(), lane = tid & 63, w = tid >> 6, l31 = lane & 31, h = lane >> 5;
  const bool is_prep = w >= 4;
  const int pt = tid - 256;
  float S[16];
#pragma unroll
  for (int i = 0; i < 16; ++i) S[i] = 0.f;
  bf16x8 bw[4];
  float c0 = 0.f;
  const int pw = w - 4, mat = pw >> 1, nh = pw & 1;
  if (is_prep) {
    const int n = hd * 64 + nh * 32 + l31;
    const u16* wT = (mat ? p.A2T : p.W2T) + ((size_t)d * 512 + n) * 64 + 8 * h;
#pragma unroll
    for (int ks = 0; ks < 4; ++ks) bw[ks] = ld8(wT + 16 * ks);
    c0 = (mat ? p.a0 : p.w0)[((size_t)layer * 2 + d) * 512 + n];
  }
  const float* mu0 = p.mu + (size_t)layer * 2 * 1792;
  const float* mu1 = mu0 + 1792;
  const int kq = lane & 3, vrow = 16 * w + (lane >> 2);
  __syncthreads();
  for (int c = -1; c < 136; ++c) {
    auto geom = [&](int cc, int& o0, int& len, size_t& rbase) {
      const int j0 = 32 * cc;
      const bool isctx = j0 < 256;
      len = isctx ? 256 : 4096;
      if (d == 0) o0 = isctx ? j0 : j0 - 256; else o0 = isctx ? (224 - j0) : (4064 - (j0 - 256));
      rbase = isctx ? (size_t)(NLAT + b * 256) : (size_t)(b * 4096);
    };
    const int cn = c + 1;
#pragma unroll 1
    for (int part = 0; part < 3; ++part) {
      if (is_prep) {
        if (cn < 136) {
          int o0, len; size_t rbase; geom(cn, o0, len, rbase);
          float* bbase = buf + (cn & 1) * 32 * 384;
          if (part == 0) {
            const int tok = pt >> 3, c8 = pt & 7, o = o0 + tok;
            float* bb = bbase + tok * 384;
#pragma unroll
            for (int g = 0; g < 5; ++g) {
              const int col = (g == 0 ? 3904 + hd * 64 : g == 1 ? 4416 + hd * 64 : g == 2 ? 4928 + hd * 64 : g == 3 ? 5440 + d * 64 : 5568 + d * 64) + c8 * 8;
              const u16* src = p.P + (rbase + o) * NIN + col;
              float cur[8], prv[8], nxt[8];
              unpack8(ld8(src), cur);
              if (o > 0) unpack8(ld8(src - NIN), prv); else { for (int j = 0; j < 8; ++j) prv[j] = 0.f; }
              if (o < len - 1) unpack8(ld8(src + NIN), nxt); else { for (int j = 0; j < 8; ++j) nxt[j] = 0.f; }
              float sh[8];
#pragma unroll
              for (int j = 0; j < 8; ++j) {
                const float m0v = mu0[col - 3904 + j], m1v = mu1[col - 3904 + j];
                sh[j] = cur[j] + m0v * (prv[j] - cur[j]) + m1v * (nxt[j] - cur[j]);
              }
              if (g < 3) {
                float* dst = bb + (g == 0 ? 0 : g == 1 ? 128 : 320) + c8 * 8;
#pragma unroll
                for (int j = 0; j < 8; ++j) dst[j] = sh[j];
              } else if (g == 3) {
#pragma unroll
                for (int j = 0; j < 8; ++j) sh[j] = tanhf(sh[j]);
                *(bf16x8*)(twS + tok * 72 + c8 * 8) = pack8(sh);
              } else {
                *(bf16x8*)(alS + tok * 72 + c8 * 8) = pack8(sh);
              }
            }
          } else if (part == 1) {
            const u16* X = mat ? alS : twS;
            f32x16 acc = zero16();
#pragma unroll
            for (int ks = 0; ks < 4; ++ks) acc = MFMA(ld8(X + l31 * 72 + ks * 16 + h * 8), bw[ks], acc);
            const int ch = nh * 32 + l31;
#pragma unroll
            for (int r = 0; r < 16; ++r) {
              const int tok = crow(r, h);
              const float xx = c0 + acc[r];
              if (mat == 0) {
                const float zz = -xx;
                const float sp = fmaxf(zz, 0.f) + log1pf(expf(-fabsf(zz)));
                const float wl = -sp - 0.5f;
                bbase[tok * 384 + 64 + ch] = expf(-expf(wl));
              } else {
                bbase[tok * 384 + 256 + ch] = 1.f / (1.f + expf(-xx));
              }
            }
          } else {
            const int tok = pt >> 3, c8 = pt & 7;
            float* bb = bbase + tok * 384;
            float kk[8], kr[8], ar[8];
            float ss = 0.f;
#pragma unroll
            for (int j = 0; j < 8; ++j) {
              const int ch = c8 * 8 + j;
              kr[j] = bb[128 + ch]; ar[j] = bb[256 + ch];
              kk[j] = kr[j] * p.k_k[layer * 512 + hd * 64 + ch];
              ss += kk[j] * kk[j];
            }
            ss += __shfl_xor(ss, 1); ss += __shfl_xor(ss, 2); ss += __shfl_xor(ss, 4);
            const float inv = 1.f / fmaxf(sqrtf(ss), 1e-12f);
#pragma unroll
            for (int j = 0; j < 8; ++j) {
              const int ch = c8 * 8 + j;
              const float kkn = kk[j] * inv;
              bb[192 + ch] = -kkn;
              bb[256 + ch] = kkn * ar[j];
              bb[128 + ch] = kr[j] * (1.f + (ar[j] - 1.f) * p.k_a[layer * 512 + hd * 64 + ch]);
            }
          }
        }
      } else if (c >= 0) {
        int o0, len; size_t rbase; geom(c, o0, len, rbase);
        const float* bbase = buf + (c & 1) * 32 * 384;
        const int s0 = part == 0 ? 0 : part == 1 ? 11 : 22, s1 = part == 0 ? 11 : part == 1 ? 22 : 32;
        for (int s = s0; s < s1; ++s) {
          const int i = d ? 31 - s : s;
          const float* t = bbase + i * 384 + 16 * kq;
          float rr[16], ww[16], ke[16], aa[16], bv[16];
#pragma unroll
          for (int q = 0; q < 4; ++q) {
            f32x4 v0 = *(const f32x4*)(t + 4 * q), v1 = *(const f32x4*)(t + 64 + 4 * q), v2 = *(const f32x4*)(t + 128 + 4 * q),
                  v3 = *(const f32x4*)(t + 192 + 4 * q), v4 = *(const f32x4*)(t + 256 + 4 * q);
#pragma unroll
            for (int j = 0; j < 4; ++j) { rr[4 * q + j] = v0[j]; ww[4 * q + j] = v1[j]; ke[4 * q + j] = v2[j]; aa[4 * q + j] = v3[j]; bv[4 * q + j] = v4[j]; }
          }
          const float vv = bbase[i * 384 + 320 + vrow];
          float sa = 0.f;
#pragma unroll
          for (int k = 0; k < 16; ++k) sa += S[k] * aa[k];
          sa += __shfl_xor(sa, 1); sa += __shfl_xor(sa, 2);
          float y = 0.f;
#pragma unroll
          for (int k = 0; k < 16; ++k) {
            S[k] = S[k] * ww[k] + (sa * bv[k] + vv * ke[k]);
            y += S[k] * rr[k];
          }
          y += __shfl_xor(y, 1); y += __shfl_xor(y, 2);
          if (kq == 0) p.Yrw[((size_t)d * NTOK + rbase + o0 + i) * 512 + hd * 64 + vrow] = f2bf(y);
        }
      }
      __syncthreads();
    }
  }
}

DI void merge_phase(const KP& p, int layer, int M) {
  const int lane = otid() & 63, w = otid() >> 6;
  const float* mu0 = p.mu + (size_t)layer * 2 * 1792;
  const float* mu1 = mu0 + 1792;
  for (int row = obid() * 8 + w; row < M; row += gridDim.x * 8) {
    const int ch0 = lane * 8;
    {
      float y0[8], y1[8], y[8];
      unpack8(ld8(p.Yret + (size_t)row * 512 + ch0), y0);
      unpack8(ld8(p.Yret + ((size_t)NTOK + row) * 512 + ch0), y1);
      float s = 0.f;
#pragma unroll
      for (int j = 0; j < 8; ++j) { y[j] = y0[j] + y1[j]; s += y[j]; }
      s += __shfl_xor(s, 1); s += __shfl_xor(s, 2); s += __shfl_xor(s, 4); s += __shfl_xor(s, 8);
      const float mean = s * (1.f / 128.f);
      float v = 0.f;
#pragma unroll
      for (int j = 0; j < 8; ++j) { const float dlt = y[j] - mean; v += dlt * dlt; }
      v += __shfl_xor(v, 1); v += __shfl_xor(v, 2); v += __shfl_xor(v, 4); v += __shfl_xor(v, 8);
      const float rstd = rsqrtf(v * (1.f / 128.f) + 1e-5f);
      float gt[8], o[8];
      unpack8(ld8(p.P + (size_t)row * NIN + 1536 + ch0), gt);
#pragma unroll
      for (int j = 0; j < 8; ++j) o[j] = (y[j] - mean) * rstd * p.ret_gn[layer * 512 + ch0 + j] * silu(gt[j]);
      *(bf16x8*)(p.H + (size_t)row * DM + ch0) = pack8(o);
    }
    {
      float y0[8], y1[8], y[8];
      unpack8(ld8(p.Yrw + (size_t)row * 512 + ch0), y0);
      unpack8(ld8(p.Yrw + ((size_t)NTOK + row) * 512 + ch0), y1);
      float s = 0.f;
#pragma unroll
      for (int j = 0; j < 8; ++j) { y[j] = y0[j] + y1[j]; s += y[j]; }
      s += __shfl_xor(s, 1); s += __shfl_xor(s, 2); s += __shfl_xor(s, 4);
      const float mean = s * (1.f / 64.f);
      float v = 0.f;
#pragma unroll
      for (int j = 0; j < 8; ++j) { const float dlt = y[j] - mean; v += dlt * dlt; }
      v += __shfl_xor(v, 1); v += __shfl_xor(v, 2); v += __shfl_xor(v, 4);
      const float rstd = rsqrtf(v * (1.f / 64.f) + 64e-5f);
      int o, len;
      if (row < NLAT) { o = row & 4095; len = 4096; } else { o = (row - NLAT) & 255; len = 256; }
      float f[3][8];
#pragma unroll
      for (int g = 0; g < 3; ++g) {
        const int col = 3904 + 512 * g + ch0;
        const u16* src = p.P + (size_t)row * NIN + col;
        float cur[8], prv[8], nxt[8];
        unpack8(ld8(src), cur);
        if (o > 0) unpack8(ld8(src - NIN), prv); else { for (int j = 0; j < 8; ++j) prv[j] = 0.f; }
        if (o < len - 1) unpack8(ld8(src + NIN), nxt); else { for (int j = 0; j < 8; ++j) nxt[j] = 0.f; }
#pragma unroll
        for (int j = 0; j < 8; ++j) {
          const float m0v = mu0[col - 3904 + j], m1v = mu1[col - 3904 + j];
          f[g][j] = cur[j] + m0v * (prv[j] - cur[j]) + m1v * (nxt[j] - cur[j]);
        }
      }
      float rk = 0.f;
#pragma unroll
      for (int j = 0; j < 8; ++j) rk += f[0][j] * f[1][j] * p.r_k[layer * 512 + ch0 + j];
      rk += __shfl_xor(rk, 1); rk += __shfl_xor(rk, 2); rk += __shfl_xor(rk, 4);
      float gt[8], ov[8];
      unpack8(ld8(p.P + (size_t)row * NIN + 5696 + ch0), gt);
#pragma unroll
      for (int j = 0; j < 8; ++j)
        ov[j] = ((y[j] - mean) * rstd * p.rw_gn[layer * 512 + ch0 + j] + rk * f[2][j]) * silu(gt[j]);
      *(bf16x8*)(p.H + (size_t)row * DM + 1536 + ch0) = pack8(ov);
    }
  }
}

DI void ln_phase(const KP& p, int layer, int M) {
  const int lane = otid() & 63, w = otid() >> 6;
  const float* g = p.ln_g + layer * DM;
  const float* bb_ = p.ln_b + layer * DM;
  for (int row = obid() * 8 + w; row < M; row += gridDim.x * 8) {
    float* ptr = row < NLAT ? p.out + (size_t)row * DM : p.X1c + (size_t)(row - NLAT) * DM;
    f32x4 v[8];
    float s = 0.f;
#pragma unroll
    for (int i = 0; i < 8; ++i) { v[i] = *(const f32x4*)(ptr + (i * 64 + lane) * 4); s += v[i][0] + v[i][1] + v[i][2] + v[i][3]; }
#pragma unroll
    for (int o = 1; o < 64; o <<= 1) s += __shfl_xor(s, o);
    const float mean = s * (1.f / 2048.f);
    float q = 0.f;
#pragma unroll
    for (int i = 0; i < 8; ++i)
#pragma unroll
      for (int j = 0; j < 4; ++j) { const float dlt = v[i][j] - mean; q += dlt * dlt; }
#pragma unroll
    for (int o = 1; o < 64; o <<= 1) q += __shfl_xor(q, o);
    const float rstd = rsqrtf(q * (1.f / 2048.f) + 1e-5f);
    const int bidx = row < NLAT ? (row >> 12) : 4;
    const float* md = p.mod + ((size_t)5 + bidx) * 6144;
#pragma unroll
    for (int i = 0; i < 8; ++i) {
      const int c = (i * 64 + lane) * 4;
      f32x4 gg = *(const f32x4*)(g + c), bbv = *(const f32x4*)(bb_ + c), y;
#pragma unroll
      for (int j = 0; j < 4; ++j) y[j] = (v[i][j] - mean) * rstd * gg[j] + bbv[j];
      *(f32x4*)(ptr + c) = y;
      if (layer == 0) {
        f32x4 sh = *(const f32x4*)(md + c), scl = *(const f32x4*)(md + 2048 + c);
        u32x2 o;
        o[0] = pk2(y[0] * (1.f + scl[0]) + sh[0], y[1] * (1.f + scl[1]) + sh[1]);
        o[1] = pk2(y[2] * (1.f + scl[2]) + sh[2], y[3] * (1.f + scl[3]) + sh[3]);
        *(u32x2*)(p.H + (size_t)row * DM + c) = o;
      }
    }
  }
}

__global__ void __launch_bounds__(NTHR) hybrid_block_megakernel(KP p) {
  extern __shared__ __attribute__((aligned(16))) char smem[];
  cg::grid_group grid = cg::this_grid();
  __shared__ int s_item;
  const int tid = otid();

  if (obid() == 0 && tid < 8) p.cnt[tid] = 0u;
  mod_phase(p, smem);
  convert_weights(p, 0, smem);
  grid.sync();
  h0_phase(p);
  grid.sync();

  for (int layer = 0; layer < 2; ++layer) {
    const int Mq = layer == 0 ? NTOK : NLAT;
    for (int it = obid(); it < 68 * 49; it += gridDim.x) {
      const int nt = it / 68, mt = it % 68;
      gemm_tile(p, 0, layer, mt * 256, nt * 128, smem);
    }
    grid.sync();
    {
      const int n_uq = (Mq / 256) * 12, n_ukv = 68 * 16, n_kr = NTOK / 8;
      for (int it = obid(); it < n_uq + n_ukv + n_kr; it += gridDim.x) {
        if (it < n_uq) gemm_tile(p, 1, layer, (it / 12) * 256, (it % 12) * 128, smem);
        else if (it < n_uq + n_ukv) { const int i = it - n_uq; gemm_tile(p, 2, layer, (i / 16) * 256, (i % 16) * 128, smem); }
        else krope_item(p, it - n_uq - n_ukv);
      }
    }
    grid.sync();
    {
      for (int ch = obid(); ch < 96; ch += gridDim.x) {
        if (ch < 64) rwkv_chain(p, layer, ch, smem); else ret_chain(p, layer, ch - 64, smem);
      }
      const int n_att = layer == 0 ? 512 + 32 : 512;
      while (true) {
        __syncthreads();
        if (tid == 0) s_item = (int)atomicAdd(&p.cnt[layer], 1u);
        __syncthreads();
        const int it = s_item;
        if (it >= n_att) break;
        if (it < 512) {
          const int b = it >> 7, hd = (it >> 4) & 7, qb = it & 15;
          attn_item(p, b * 4096 + qb * 256, b, hd, LPOS, smem);
        } else {
          const int i = it - 512, b = i >> 3, hd = i & 7;
          attn_item(p, NLAT + b * 256, b, hd, 256, smem);
        }
      }
    }
    grid.sync();
    merge_phase(p, layer, Mq);
    grid.sync();
    for (int it = obid(); it < (Mq / 256) * 16; it += gridDim.x) {
      const int nt = it % 16, mt = it / 16;
      gemm_tile(p, 3, layer, mt * 256, nt * 128, smem);
    }
    grid.sync();
    ln_phase(p, layer, Mq);
    if (layer == 0) {
      convert_weights(p, 1, smem);
      grid.sync();
    }
  }
}

extern "C" void kernel_launch(void* const* d_in, const int* in_sizes, int n_in, void* d_out, int out_size, void* d_ws,
                              size_t ws_size, hipStream_t stream) {
  static int grid_blocks = 0;
  if (!grid_blocks) {
    int dev = 0, cus = 0, per_cu = 0;
    hipGetDevice(&dev);
    hipDeviceGetAttribute(&cus, hipDeviceAttributeMultiprocessorCount, dev);
    hipFuncSetAttribute((const void*)hybrid_block_megakernel, hipFuncAttributeMaxDynamicSharedMemorySize, (int)LDS_BYTES);
    hipOccupancyMaxActiveBlocksPerMultiprocessor(&per_cu, hybrid_block_megakernel, NTHR, LDS_BYTES);
    if (per_cu > 1) per_cu = 1;
    grid_blocks = cus * per_cu;
  }
  KP p{};
  const float* const* in = (const float* const*)d_in;
  p.x = in[0]; p.c = in[1]; p.ctx = in[2]; p.c_ctx = in[3]; p.w_ada = in[4]; p.b_ada = in[5]; p.w_in = in[6];
  p.ret_logit = in[7]; p.ret_gn = in[8]; p.q_g = in[9]; p.w_uq = in[10]; p.kv_g = in[11]; p.w_ukv = in[12]; p.mu = in[13];
  p.w0 = in[14]; p.w2 = in[15]; p.a0 = in[16]; p.a2 = in[17]; p.k_k = in[18]; p.k_a = in[19]; p.r_k = in[20]; p.rw_gn = in[21];
  p.w_out = in[22]; p.ln_g = in[23]; p.ln_b = in[24];
  p.out = (float*)d_out;
  char* ws = (char*)d_ws;
  size_t off = 0;
  auto take = [&](size_t bytes) { char* r = ws + off; off += (bytes + 255) & ~(size_t)255; return r; };
  p.P = (u16*)take((size_t)NTOK * NIN * 2);
  p.H = (u16*)take((size_t)NTOK * DM * 2);
  p.Q = (u16*)take((size_t)NTOK * 1536 * 2);
  p.Kn = (u16*)take((size_t)4 * 8 * LPOS * 128 * 2);
  p.Vt = (u16*)take((size_t)4 * 8 * 128 * LPOS * 2);
  p.Kr = (u16*)take((size_t)4 * LPOS * 64 * 2);
  p.Yret = (u16*)take((size_t)2 * NTOK * 512 * 2);
  p.Yrw = (u16*)take((size_t)2 * NTOK * 512 * 2);
  p.WinT = (u16*)take((size_t)NIN * DM * 2);
  p.WuqT = (u16*)take((size_t)1536 * 512 * 2);
  p.WukvT = (u16*)take((size_t)2048 * 256 * 2);
  p.WoutT = (u16*)take((size_t)DM * DM * 2);
  p.W2T = (u16*)take((size_t)2 * 512 * 64 * 2);
  p.A2T = (u16*)take((size_t)2 * 512 * 64 * 2);
  p.X1c = (float*)take((size_t)1024 * DM * 4);
  p.mod = (float*)take((size_t)2 * 5 * 6144 * 4);
  p.cnt = (unsigned*)take(256);
  if (off > ws_size) { fprintf(stderr, "workspace too small: need %zu have %zu\n", off, ws_size); return; }
  void* args[] = {&p};
  hipError_t e = hipLaunchCooperativeKernel((void*)hybrid_block_megakernel, dim3(grid_blocks), dim3(NTHR), args, LDS_BYTES, stream);
  if (e != hipSuccess) fprintf(stderr, "cooperative launch failed: %s (grid %d)\n", hipGetErrorString(e), grid_blocks);
}
```

```cpp
#include <hip/hip_runtime.h>
#include <hip/hip_cooperative_groups.h>
#include <cstdio>
namespace cg = cooperative_groups;

#define DI __device__ __forceinline__
typedef unsigned short u16;
using bf16x8 = __attribute__((ext_vector_type(8))) short;
using s16x4 = __attribute__((ext_vector_type(4))) short;
using f32x16 = __attribute__((ext_vector_type(16))) float;
using f32x4 = __attribute__((ext_vector_type(4))) float;
using u32x4 = __attribute__((ext_vector_type(4))) unsigned;
using u32x2 = __attribute__((ext_vector_type(2))) unsigned;
#define MFMA(a, b, c) __builtin_amdgcn_mfma_f32_32x32x16_bf16((a), (b), (c), 0, 0, 0)

constexpr int DM = 2048, NIN = 6208, NLAT = 16384, NTOK = 17408, LPOS = 4352;
constexpr int NTHR = 512;
constexpr size_t LDS_BYTES = 143360;
constexpr float ALPHA = 1.4142135623730951f;
constexpr float QSCALE = 0.07216878364870323f * 1.4426950408889634f;

struct KP {
  const float *x, *c, *ctx, *c_ctx, *w_ada, *b_ada, *w_in, *ret_logit, *ret_gn, *q_g, *w_uq, *kv_g, *w_ukv, *mu, *w0, *w2, *a0,
      *a2, *k_k, *k_a, *r_k, *rw_gn, *w_out, *ln_g, *ln_b;
  float* out;
  u16 *P, *H, *Q, *Kn, *Vt, *Kr, *Yret, *Yrw, *WinT, *WuqT, *WukvT, *WoutT, *W2T, *A2T;
  float *X1c, *mod;
  unsigned* cnt;
};

DI int otid() { int t = threadIdx.x; asm volatile("" : "+v"(t)); return t; }
DI int obid() { int t = blockIdx.x; asm volatile("" : "+s"(t)); return t; }
template <int CTRL> DI float dppf(float v) {
  return __builtin_bit_cast(float, __builtin_amdgcn_update_dpp(0, __builtin_bit_cast(int, v), CTRL, 0xf, 0xf, true));
}
DI float sum8(float x) { x += dppf<0xB1>(x); x += dppf<0x4E>(x); x += dppf<0x141>(x); return x; }
DI float bf2f(u16 v) { return __uint_as_float(((unsigned)v) << 16); }
DI float bflo(unsigned v) { return __uint_as_float(v << 16); }
DI float bfhi(unsigned v) { return __uint_as_float(v & 0xffff0000u); }
DI u16 f2bf(float a) { __bf16 r = (__bf16)a; return __builtin_bit_cast(u16, r); }
DI unsigned pk2(float a, float b) {
  typedef __bf16 bf2 __attribute__((ext_vector_type(2)));
  typedef float f2 __attribute__((ext_vector_type(2)));
  f2 v = {a, b};
  bf2 r = __builtin_convertvector(v, bf2);
  return __builtin_bit_cast(unsigned, r);
}
DI int crow(int reg, int h) { return (reg & 3) + 8 * (reg >> 2) + 4 * h; }
DI float silu(float x) { return x / (1.f + __expf(-x)); }
DI void unpack8(const bf16x8& v, float* f) {
  u32x4 u = __builtin_bit_cast(u32x4, v);
#pragma unroll
  for (int i = 0; i < 4; ++i) { f[2 * i] = bflo(u[i]); f[2 * i + 1] = bfhi(u[i]); }
}
DI bf16x8 pack8(const float* f) {
  u32x4 u;
#pragma unroll
  for (int i = 0; i < 4; ++i) u[i] = pk2(f[2 * i], f[2 * i + 1]);
  return __builtin_bit_cast(bf16x8, u);
}
DI bf16x8 ld8(const u16* p) { return *(const bf16x8*)p; }
DI bf16x8 zero8() { bf16x8 z = {0, 0, 0, 0, 0, 0, 0, 0}; return z; }
DI f32x16 zero16() { f32x16 z; for (int i = 0; i < 16; ++i) z[i] = 0.f; return z; }
DI s16x4 trread(const u16* p) {
  return __builtin_amdgcn_ds_read_tr16_b64_v4i16((s16x4 __attribute__((address_space(3)))*)(p));
}
DI bf16x8 cat4(s16x4 lo, s16x4 hi) { return __builtin_shufflevector(lo, hi, 0, 1, 2, 3, 4, 5, 6, 7); }
DI void rope_cs(int pos, int i, float& cs, float& sn) {
  float inv = exp2f(-(float)i * (13.287712379549449f / 16.f));
  float rev = (float)pos * inv * 0.15915494309189535f;
  rev -= floorf(rev);
  cs = __builtin_amdgcn_cosf(rev);
  sn = __builtin_amdgcn_sinf(rev);
}

DI void transpose_item(const float* src, u16* dst, int K, int N, int kt, int nt, char* smem) {
  float* tile = (float*)smem;
  const int tid = otid();
  __syncthreads();
  {
    const int kk = tid >> 4, n4 = tid & 15;
#pragma unroll
    for (int i = 0; i < 2; ++i) {
      const int k = kk + 32 * i;
      f32x4 v = *(const f32x4*)(src + (size_t)(kt * 64 + k) * N + nt * 64 + n4 * 4);
      tile[k * 65 + n4 * 4 + 0] = v[0]; tile[k * 65 + n4 * 4 + 1] = v[1];
      tile[k * 65 + n4 * 4 + 2] = v[2]; tile[k * 65 + n4 * 4 + 3] = v[3];
    }
  }
  __syncthreads();
  {
    const int n = tid >> 3, k8 = tid & 7;
    float f[8];
#pragma unroll
    for (int j = 0; j < 8; ++j) f[j] = tile[(k8 * 8 + j) * 65 + n];
    *(bf16x8*)(dst + (size_t)(nt * 64 + n) * K + kt * 64 + k8 * 8) = pack8(f);
  }
}

DI void convert_weights(const KP& p, int layer, char* smem) {
  const int n_in = 32 * 97, n_uq = 8 * 24, n_ukv = 4 * 32, n_out = 32 * 32, n_lora = 8;
  const int total = n_in + n_uq + n_ukv + n_out + 4 * n_lora;
  for (int it = obid(); it < total; it += gridDim.x) {
    int i = it;
    if (i < n_in) { transpose_item(p.w_in + (size_t)layer * DM * NIN, p.WinT, DM, NIN, i / 97, i % 97, smem); continue; }
    i -= n_in;
    if (i < n_uq) { transpose_item(p.w_uq + (size_t)layer * 512 * 1536, p.WuqT, 512, 1536, i / 24, i % 24, smem); continue; }
    i -= n_uq;
    if (i < n_ukv) { transpose_item(p.w_ukv + (size_t)layer * 256 * 2048, p.WukvT, 256, 2048, i / 32, i % 32, smem); continue; }
    i -= n_ukv;
    if (i < n_out) { transpose_item(p.w_out + (size_t)layer * DM * DM, p.WoutT, DM, DM, i / 32, i % 32, smem); continue; }
    i -= n_out;
    {
      const int which = i / (2 * n_lora), r = i % (2 * n_lora), d = r / n_lora, nt = r % n_lora;
      const float* src = (which ? p.a2 : p.w2) + ((size_t)layer * 2 + d) * 64 * 512;
      u16* dst = (which ? p.A2T : p.W2T) + (size_t)d * 512 * 64;
      transpose_item(src, dst, 64, 512, 0, nt, smem);
    }
  }
}

DI void mod_phase(const KP& p, char* smem) {
  float* sc = (float*)smem;
  float* red = sc + 5 * 2048;
  const int tid = otid();
  __syncthreads();
  for (int i = tid; i < 5 * 2048; i += NTHR) {
    float v = i < 4 * 2048 ? p.c[i] : p.c_ctx[i - 4 * 2048];
    sc[i] = silu(v);
  }
  __syncthreads();
  const int kg = tid >> 5, col = tid & 31;
  for (int it = obid(); it < 384; it += gridDim.x) {
    const int layer = it / 192, j = (it % 192) * 32 + col;
    const float* w = p.w_ada + (size_t)layer * DM * 6144 + j;
    float acc[5] = {0.f, 0.f, 0.f, 0.f, 0.f};
    for (int k = kg * 128; k < kg * 128 + 128; ++k) {
      float wv = w[(size_t)k * 6144];
#pragma unroll
      for (int r = 0; r < 5; ++r) acc[r] += sc[r * 2048 + k] * wv;
    }
#pragma unroll
    for (int r = 0; r < 5; ++r) red[(kg * 5 + r) * 32 + col] = acc[r];
    __syncthreads();
    if (tid < 160) {
      const int r = tid >> 5;
      float s = p.b_ada[(size_t)layer * 6144 + j];
      for (int g = 0; g < 16; ++g) s += red[(g * 5 + r) * 32 + col];
      p.mod[((size_t)layer * 5 + r) * 6144 + j] = s;
    }
    __syncthreads();
  }
}

DI void h0_phase(const KP& p) {
  const int lane = otid() & 63, w = otid() >> 6;
  for (int row = obid() * 8 + w; row < NTOK; row += gridDim.x * 8) {
    const float* src = row < NLAT ? p.x + (size_t)row * DM : p.ctx + (size_t)(row - NLAT) * DM;
    const int bb = row < NLAT ? (row >> 12) : 4;
    const float* md = p.mod + (size_t)bb * 6144;
#pragma unroll
    for (int i = 0; i < 8; ++i) {
      const int c = (i * 64 + lane) * 4;
      f32x4 v = *(const f32x4*)(src + c), sh = *(const f32x4*)(md + c), scl = *(const f32x4*)(md + 2048 + c);
      u32x2 o;
      o[0] = pk2(v[0] * (1.f + scl[0]) + sh[0], v[1] * (1.f + scl[1]) + sh[1]);
      o[1] = pk2(v[2] * (1.f + scl[2]) + sh[2], v[3] * (1.f + scl[3]) + sh[3]);
      *(u32x2*)(p.H + (size_t)row * DM + c) = o;
    }
  }
}

DI void gemm_tile(const KP& p, int mode, int layer, int m0, int n0, char* smem) {
  u16* As = (u16*)smem;
  u16* Bs = As + 256 * 72;
  float* rs = (float*)(Bs + 128 * 72);
  const int tid = otid(), lane = tid & 63, w = tid >> 6, wm = w >> 1, wn = w & 1, l31 = lane & 31, h = lane >> 5;
  const u16* A; const u16* Bt; const float* gv = nullptr; int lda, K, N;
  if (mode == 0) { A = p.H; lda = DM; K = DM; N = NIN; Bt = p.WinT; }
  else if (mode == 1) { A = p.P + 2048; lda = NIN; K = 512; N = 1536; Bt = p.WuqT; gv = p.q_g + layer * 512; }
  else if (mode == 2) { A = p.P + 2560; lda = NIN; K = 256; N = 2048; Bt = p.WukvT; gv = p.kv_g + layer * 256; }
  else { A = p.H; lda = DM; K = DM; N = DM; Bt = p.WoutT; }
  const bool xf = (mode == 1 || mode == 2);
  __syncthreads();
  if (xf) {
    const int r = tid >> 1, part = tid & 1;
    const u16* src = A + (size_t)(m0 + r) * lda + part * (K >> 1);
    float ss = 0.f;
    for (int i = 0; i < (K >> 1); i += 8) {
      float f[8]; unpack8(ld8(src + i), f);
#pragma unroll
      for (int j = 0; j < 8; ++j) ss += f[j] * f[j];
    }
    ss += __shfl_xor(ss, 1);
    if (!part) rs[r] = rsqrtf(ss / (float)K + 1e-6f);
    __syncthreads();
  }
  f32x16 acc[2][2];
#pragma unroll
  for (int i = 0; i < 2; ++i)
#pragma unroll
    for (int j = 0; j < 2; ++j) acc[i][j] = zero16();
  bf16x8 ra[4], rb[2];
  const int arow = tid >> 3, ac = tid & 7;
  auto loadg = [&](int k0) {
#pragma unroll
    for (int i = 0; i < 4; ++i) {
      const int row = arow + 64 * i;
      bf16x8 v = ld8(A + (size_t)(m0 + row) * lda + k0 + ac * 8);
      if (xf) {
        float f[8]; unpack8(v, f);
        const float s = rs[row];
        f32x4 g0 = *(const f32x4*)(gv + k0 + ac * 8), g1 = *(const f32x4*)(gv + k0 + ac * 8 + 4);
#pragma unroll
        for (int j = 0; j < 4; ++j) { f[j] *= s * g0[j]; f[4 + j] *= s * g1[j]; }
        v = pack8(f);
      }
      ra[i] = v;
    }
#pragma unroll
    for (int i = 0; i < 2; ++i) {
      int nrow = n0 + arow + 64 * i;
      nrow = nrow < N ? nrow : N - 1;
      rb[i] = ld8(Bt + (size_t)nrow * K + k0 + ac * 8);
    }
  };
  loadg(0);
  for (int k0 = 0; k0 < K; k0 += 64) {
    __syncthreads();
#pragma unroll
    for (int i = 0; i < 4; ++i) *(bf16x8*)(As + (arow + 64 * i) * 72 + ac * 8) = ra[i];
#pragma unroll
    for (int i = 0; i < 2; ++i) *(bf16x8*)(Bs + (arow + 64 * i) * 72 + ac * 8) = rb[i];
    __syncthreads();
    if (k0 + 64 < K) loadg(k0 + 64);
#pragma unroll
    for (int ks = 0; ks < 4; ++ks) {
      bf16x8 a0 = ld8(As + (wm * 64 + l31) * 72 + ks * 16 + h * 8);
      bf16x8 a1 = ld8(As + (wm * 64 + 32 + l31) * 72 + ks * 16 + h * 8);
      bf16x8 b0 = ld8(Bs + (wn * 64 + l31) * 72 + ks * 16 + h * 8);
      bf16x8 b1 = ld8(Bs + (wn * 64 + 32 + l31) * 72 + ks * 16 + h * 8);
      acc[0][0] = MFMA(a0, b0, acc[0][0]);
      acc[0][1] = MFMA(a0, b1, acc[0][1]);
      acc[1][0] = MFMA(a1, b0, acc[1][0]);
      acc[1][1] = MFMA(a1, b1, acc[1][1]);
    }
  }
#pragma unroll
  for (int mi = 0; mi < 2; ++mi)
#pragma unroll
    for (int ni = 0; ni < 2; ++ni) {
      const int cb = n0 + wn * 64 + ni * 32;
      if (cb >= N) continue;
      const int col = cb + l31;
      const int rb0 = m0 + wm * 64 + mi * 32;
      const f32x16& a = acc[mi][ni];
      if (mode == 0) {
#pragma unroll
        for (int r = 0; r < 16; ++r) p.P[(size_t)(rb0 + crow(r, h)) * NIN + col] = f2bf(a[r]);
      } else if (mode == 1) {
        const int dd = cb % 192;
        const bool rope = (dd >= 128) && (rb0 < NLAT);
        const int part = (dd - 128) >> 5;
#pragma unroll
        for (int r = 0; r < 16; ++r) {
          const int row = rb0 + crow(r, h);
          float v = a[r] * QSCALE;
          if (rope) {
            const int t = row & 4095;
            const int pos = part ? (t & 63) : (t >> 6);
            float cs, sn; rope_cs(pos, l31 & 15, cs, sn);
            const float pr = __shfl_xor(v, 16);
            v = (l31 < 16) ? (v * cs - pr * sn) : (v * cs + pr * sn);
          }
          p.Q[(size_t)row * 1536 + col] = f2bf(v);
        }
      } else if (mode == 2) {
        const int head = col >> 8, dd = col & 255;
#pragma unroll
        for (int g = 0; g < 4; ++g) {
          const int row = rb0 + 8 * g + 4 * h;
          int b, pos;
          if (row < NLAT) { b = row >> 12; pos = 256 + (row & 4095); } else { b = (row - NLAT) >> 8; pos = (row - NLAT) & 255; }
          if (dd < 128) {
#pragma unroll
            for (int j = 0; j < 4; ++j) p.Kn[((size_t)(b * 8 + head) * LPOS + pos + j) * 128 + dd] = f2bf(a[4 * g + j]);
          } else {
            u32x2 o; o[0] = pk2(a[4 * g], a[4 * g + 1]); o[1] = pk2(a[4 * g + 2], a[4 * g + 3]);
            *(u32x2*)(p.Vt + ((size_t)(b * 8 + head) * 128 + (dd - 128)) * LPOS + pos) = o;
          }
        }
      } else {
#pragma unroll
        for (int r = 0; r < 16; ++r) {
          const int row = rb0 + crow(r, h);
          const int bb = row < NLAT ? (row >> 12) : 4;
          const float gate = p.mod[((size_t)layer * 5 + bb) * 6144 + 4096 + col];
          float xv;
          float* dst;
          if (row < NLAT) {
            dst = p.out + (size_t)row * DM + col;
            xv = layer == 0 ? p.x[(size_t)row * DM + col] : *dst;
          } else {
            dst = p.X1c + (size_t)(row - NLAT) * DM + col;
            xv = p.ctx[(size_t)(row - NLAT) * DM + col];
          }
          *dst = ALPHA * xv + gate * a[r];
        }
      }
    }
}

DI void krope_item(const KP& p, int it) {
  const int tid = otid(), tok = tid >> 6, dim = tid & 63;
  const int row = it * 8 + tok;
  const u16* src = p.P + (size_t)row * NIN + 2816;
  float v = bf2f(src[dim]);
  int b, pos;
  if (row < NLAT) {
    const float pr = bf2f(src[dim ^ 16]);
    const int t = row & 4095, part = dim >> 5;
    const int ps = part ? (t & 63) : (t >> 6);
    float cs, sn; rope_cs(ps, dim & 15, cs, sn);
    v = ((dim & 31) < 16) ? (v * cs - pr * sn) : (v * cs + pr * sn);
    b = row >> 12; pos = 256 + t;
  } else { b = (row - NLAT) >> 8; pos = (row - NLAT) & 255; }
  p.Kr[((size_t)b * LPOS + pos) * 64 + dim] = f2bf(v);
}

DI void attn_item(const KP& p, int qrow0, int b, int hd, int nkeys, char* smem) {
  u16* Ksm = (u16*)smem;
  u16* Vsm = Ksm + 64 * 200;
  const int tid = otid(), lane = tid & 63, w = tid >> 6, l31 = lane & 31, h = lane >> 5;
  const int qrow = qrow0 + 32 * w + l31;
  bf16x8 qf[12];
  {
    const u16* qp = p.Q + (size_t)qrow * 1536 + hd * 192 + 8 * h;
#pragma unroll
    for (int ks = 0; ks < 12; ++ks) qf[ks] = ld8(qp + 16 * ks);
  }
  f32x16 o[4];
#pragma unroll
  for (int i = 0; i < 4; ++i) o[i] = zero16();
  float m = -1e30f, lsum = 0.f;
  const u16* kn = p.Kn + (size_t)(b * 8 + hd) * LPOS * 128;
  const u16* kr = p.Kr + (size_t)b * LPOS * 64;
  const u16* vt = p.Vt + (size_t)(b * 8 + hd) * 128 * LPOS;
  for (int kt0 = 0; kt0 < nkeys; kt0 += 64) {
    __syncthreads();
#pragma unroll
    for (int i = 0; i < 3; ++i) {
      const int idx = tid + NTHR * i, key = idx / 24, c = idx % 24;
      const u16* src = c < 16 ? kn + (size_t)(kt0 + key) * 128 + c * 8 : kr + (size_t)(kt0 + key) * 64 + (c - 16) * 8;
      *(bf16x8*)(Ksm + key * 200 + c * 8) = ld8(src);
    }
#pragma unroll
    for (int i = 0; i < 2; ++i) {
      const int idx = tid + NTHR * i, d = idx >> 3, c = idx & 7;
      *(bf16x8*)(Vsm + d * 72 + c * 8) = ld8(vt + (size_t)d * LPOS + kt0 + c * 8);
    }
    __syncthreads();
    f32x16 s[2];
#pragma unroll
    for (int kt = 0; kt < 2; ++kt) {
      s[kt] = zero16();
#pragma unroll
      for (int ks = 0; ks < 12; ++ks) {
        bf16x8 a = ld8(Ksm + (kt * 32 + l31) * 200 + ks * 16 + h * 8);
        s[kt] = MFMA(a, qf[ks], s[kt]);
        if ((ks & 3) == 3) asm volatile("" ::: "memory");
      }
    }
    float mx = s[0][0];
#pragma unroll
    for (int r = 0; r < 16; ++r) { mx = fmaxf(mx, s[0][r]); mx = fmaxf(mx, s[1][r]); }
    mx = fmaxf(mx, __shfl_xor(mx, 32));
    const float mnew = fmaxf(m, mx);
    const float alpha = exp2f(m - mnew);
    m = mnew;
    float ps = 0.f;
#pragma unroll
    for (int kt = 0; kt < 2; ++kt)
#pragma unroll
      for (int r = 0; r < 16; ++r) { float e = exp2f(s[kt][r] - mnew); s[kt][r] = e; ps += e; }
    lsum = lsum * alpha + ps;
#pragma unroll
    for (int dt = 0; dt < 4; ++dt)
#pragma unroll
      for (int r = 0; r < 16; ++r) o[dt][r] *= alpha;
#pragma unroll
    for (int kt = 0; kt < 2; ++kt)
#pragma unroll
      for (int sI = 0; sI < 2; ++sI) {
        u32x4 pu;
#pragma unroll
        for (int j = 0; j < 4; ++j) pu[j] = pk2(s[kt][8 * sI + 2 * j], s[kt][8 * sI + 2 * j + 1]);
        const bf16x8 pb = __builtin_bit_cast(bf16x8, pu);
        const int kb = kt * 32 + sI * 16 + 4 * h;
#pragma unroll
        for (int dt = 0; dt < 4; ++dt) {
          const u16* vp = Vsm + (dt * 32 + l31) * 72 + kb;
          s16x4 lo = *(const s16x4*)vp, hi = *(const s16x4*)(vp + 8);
          o[dt] = MFMA(cat4(lo, hi), pb, o[dt]);
        }
        asm volatile("" ::: "memory");
      }
  }
  lsum += __shfl_xor(lsum, 32);
  const float inv = 1.f / lsum;
  const u16* gp = p.P + (size_t)qrow * NIN + 2880 + hd * 128;
  u16* op = p.H + (size_t)qrow * DM + 512 + hd * 128;
#pragma unroll
  for (int dt = 0; dt < 4; ++dt)
#pragma unroll
    for (int g = 0; g < 4; ++g) {
      const int d0 = dt * 32 + 8 * g + 4 * h;
      u32x2 gg = *(const u32x2*)(gp + d0);
      float g0 = bflo(gg[0]), g1 = bfhi(gg[0]), g2 = bflo(gg[1]), g3 = bfhi(gg[1]);
      u32x2 ov;
      ov[0] = pk2(o[dt][4 * g] * inv * silu(g0), o[dt][4 * g + 1] * inv * silu(g1));
      ov[1] = pk2(o[dt][4 * g + 2] * inv * silu(g2), o[dt][4 * g + 3] * inv * silu(g3));
      *(u32x2*)(op + d0) = ov;
    }
}

DI void ret_chain(const KP& p, int layer, int chain, char* smem) {
  const int d = chain >> 4, b = (chain >> 2) & 3, hd = chain & 3;
  u16* Qs = (u16*)smem;
  u16* Ks = Qs + 128 * 136;
  u16* Vs = Ks + 128 * 136;
  u16* Sts = Vs + 128 * 136;
  const int tid = otid(), lane = tid & 63, w = tid >> 6, l31 = lane & 31, h = lane >> 5;
  const int q4 = (lane & 15) >> 2, p4 = lane & 3, blk = (lane >> 4) & 1;
  const float logit = p.ret_logit[(layer * 2 + d) * 4 + hd];
  const float z = -logit;
  const float logg = -(fmaxf(z, 0.f) + log1pf(expf(-fabsf(z))));
  const float lg2 = logg * 1.4426950408889634f;
  const float gC = exp2f(128.f * lg2);
  const float kscale = 0.08838834764831845f;
  const int iw = w & 3, half = w >> 2;
  const int kt = w & 3, vh = w >> 2;
  f32x16 st[2];
  st[0] = zero16(); st[1] = zero16();
  __syncthreads();
  for (int i = tid; i < 128 * 136 / 8; i += NTHR) *(bf16x8*)(Sts + i * 8) = zero8();
  bf16x8 rq[4], rk[4], rv[4];
  const int trow = tid >> 4, tc = tid & 15;
  auto rowbase = [&](int n) -> size_t {
    if (d == 0) return n < 2 ? (size_t)(NLAT + b * 256 + 128 * n) : (size_t)(b * 4096 + 128 * (n - 2));
    return n < 2 ? (size_t)(NLAT + b * 256 + 128 * (1 - n)) : (size_t)(b * 4096 + 128 * (33 - n));
  };
  auto loadg = [&](int n) {
    const size_t rb = rowbase(n);
#pragma unroll
    for (int i = 0; i < 4; ++i) {
      const u16* src = p.P + (rb + trow + 32 * i) * NIN + hd * 128 + tc * 8;
      rq[i] = ld8(src); rk[i] = ld8(src + 512); rv[i] = ld8(src + 1024);
    }
  };
  loadg(0);
  for (int n = 0; n < 34; ++n) {
    const size_t rb = rowbase(n);
#pragma unroll
    for (int i = 0; i < 4; ++i) {
      const int j = trow + 32 * i;
      *(bf16x8*)(Qs + j * 136 + tc * 8) = rq[i];
      *(bf16x8*)(Ks + j * 136 + tc * 8) = rk[i];
      const float zeta = exp2f((d == 0 ? (float)(127 - j) : (float)j) * lg2) * kscale;
      float f[8]; unpack8(rv[i], f);
#pragma unroll
      for (int jj = 0; jj < 8; ++jj) f[jj] *= zeta;
      *(bf16x8*)(Vs + j * 136 + tc * 8) = pack8(f);
    }
    __syncthreads();
    if (n + 1 < 34) loadg(n + 1);
    f32x16 acc[2];
    acc[0] = zero16(); acc[1] = zero16();
    bf16x8 qf[8];
#pragma unroll
    for (int ks = 0; ks < 8; ++ks) qf[ks] = ld8(Qs + (32 * iw + l31) * 136 + 16 * ks + 8 * h);
#pragma unroll
    for (int et = 0; et < 2; ++et)
#pragma unroll
      for (int ks = 0; ks < 8; ++ks) {
        bf16x8 a = ld8(Sts + (32 * (2 * half + et) + l31) * 136 + 16 * ks + 8 * h);
        acc[et] = MFMA(a, qf[ks], acc[et]);
      }
#pragma unroll
    for (int et = 0; et < 2; ++et)
#pragma unroll
      for (int r = 0; r < 16; ++r) acc[et][r] *= gC;
    const int ii = 32 * iw + l31;
#pragma unroll
    for (int jt = 0; jt < 4; ++jt) {
      f32x16 sT = zero16();
#pragma unroll
      for (int ks = 0; ks < 8; ++ks) {
        bf16x8 a = ld8(Ks + (32 * jt + l31) * 136 + 16 * ks + 8 * h);
        sT = MFMA(a, qf[ks], sT);
      }
#pragma unroll
      for (int r = 0; r < 16; ++r) {
        const int j = 32 * jt + crow(r, h);
        const bool keep = d == 0 ? (ii >= j) : (j >= ii);
        sT[r] = keep ? sT[r] : 0.f;
      }
#pragma unroll
      for (int sI = 0; sI < 2; ++sI) {
        u32x4 pu;
#pragma unroll
        for (int j = 0; j < 4; ++j) pu[j] = pk2(sT[8 * sI + 2 * j], sT[8 * sI + 2 * j + 1]);
        const bf16x8 pb = __builtin_bit_cast(bf16x8, pu);
        const int j0 = 32 * jt + 16 * sI + 4 * h;
#pragma unroll
        for (int et = 0; et < 2; ++et) {
          const u16* vp = Vs + (j0 + q4) * 136 + 32 * (2 * half + et) + 16 * blk + 4 * p4;
          s16x4 lo = trread(vp), hi = trread(vp + 8 * 136);
          acc[et] = MFMA(cat4(lo, hi), pb, acc[et]);
        }
      }
    }
    {
      const float rho = exp2f((d == 0 ? (float)(ii - 127) : (float)(-ii)) * lg2);
      u16* yp = p.Yret + ((size_t)d * NTOK + rb + ii) * 512 + hd * 128;
#pragma unroll
      for (int et = 0; et < 2; ++et)
#pragma unroll
        for (int g = 0; g < 4; ++g) {
          const int e0 = 32 * (2 * half + et) + 8 * g + 4 * h;
          u32x2 ov;
          ov[0] = pk2(acc[et][4 * g] * rho, acc[et][4 * g + 1] * rho);
          ov[1] = pk2(acc[et][4 * g + 2] * rho, acc[et][4 * g + 3] * rho);
          *(u32x2*)(yp + e0) = ov;
        }
    }
#pragma unroll
    for (int vi = 0; vi < 2; ++vi)
#pragma unroll
      for (int r = 0; r < 16; ++r) st[vi][r] *= gC;
#pragma unroll
    for (int ks = 0; ks < 8; ++ks) {
      const int jb = 16 * ks + 4 * h + q4;
      const u16* kp = Ks + jb * 136 + 32 * kt + 16 * blk + 4 * p4;
      const bf16x8 a = cat4(trread(kp), trread(kp + 8 * 136));
#pragma unroll
      for (int vi = 0; vi < 2; ++vi) {
        const u16* vp = Vs + jb * 136 + 32 * (2 * vh + vi) + 16 * blk + 4 * p4;
        const bf16x8 bfr = cat4(trread(vp), trread(vp + 8 * 136));
        st[vi] = MFMA(a, bfr, st[vi]);
      }
    }
    __syncthreads();
#pragma unroll
    for (int vi = 0; vi < 2; ++vi)
#pragma unroll
      for (int g = 0; g < 4; ++g) {
        const int v = 32 * (2 * vh + vi) + l31, k0 = 32 * kt + 8 * g + 4 * h;
        u32x2 ov;
        ov[0] = pk2(st[vi][4 * g], st[vi][4 * g + 1]);
        ov[1] = pk2(st[vi][4 * g + 2], st[vi][4 * g + 3]);
        *(u32x2*)(Sts + v * 136 + k0) = ov;
      }
  }
}

DI void rwkv_chain(const KP& p, int layer, int item, char* smem) {
  const int chain = item >> 1, vhalf = item & 1;
  const int d = chain >> 5, b = (chain >> 3) & 3, hd = chain & 7;
  float* buf = (float*)smem;
  u16* twS = (u16*)(smem + 98304);
  u16* alS = twS + 32 * 72;
  const int tid = otid(), lane = tid & 63, w = tid >> 6, l31 = lane & 31, h = lane >> 5;
  auto geom = [&](int cc, int& o0, int& len, size_t& rbase) {
    const int j0 = 32 * cc;
    const bool isctx = j0 < 256;
    len = isctx ? 256 : 4096;
    if (d == 0) o0 = isctx ? j0 : j0 - 256; else o0 = isctx ? (224 - j0) : (4064 - (j0 - 256));
    rbase = isctx ? (size_t)(NLAT + b * 256) : (size_t)(b * 4096);
  };
  __syncthreads();
  if (w >= 4) {
    const int pt = tid - 256;
    const int pw = w - 4, mat = pw >> 1, nh = pw & 1;
    bf16x8 bw[4];
    const int n = hd * 64 + nh * 32 + l31;
    {
      const u16* wT = (mat ? p.A2T : p.W2T) + ((size_t)d * 512 + n) * 64 + 8 * h;
#pragma unroll
      for (int ks = 0; ks < 4; ++ks) bw[ks] = ld8(wT + 16 * ks);
    }
    const float c0 = (mat ? p.a0 : p.w0)[((size_t)layer * 2 + d) * 512 + n];
    const int tok = pt >> 3, c8 = pt & 7;
    int colg[5];
    colg[0] = 3904 + hd * 64 + c8 * 8; colg[1] = 4416 + hd * 64 + c8 * 8; colg[2] = 4928 + hd * 64 + c8 * 8;
    colg[3] = 5440 + d * 64 + c8 * 8; colg[4] = 5568 + d * 64 + c8 * 8;
    const float* mu0 = p.mu + (size_t)layer * 2 * 1792;
    const float* mu1 = mu0 + 1792;
    float m0[5][8], m1[5][8], kkc[8], kac[8];
#pragma unroll
    for (int g = 0; g < 5; ++g)
#pragma unroll
      for (int j = 0; j < 8; ++j) { m0[g][j] = mu0[colg[g] - 3904 + j]; m1[g][j] = mu1[colg[g] - 3904 + j]; }
#pragma unroll
    for (int j = 0; j < 8; ++j) { kkc[j] = p.k_k[layer * 512 + hd * 64 + c8 * 8 + j]; kac[j] = p.k_a[layer * 512 + hd * 64 + c8 * 8 + j]; }
    bf16x8 raw[5][3];
    auto loadraw = [&](int cc) {
      int o0, len; size_t rbase; geom(cc, o0, len, rbase);
      const int o = o0 + tok;
#pragma unroll
      for (int g = 0; g < 5; ++g) {
        const u16* src = p.P + (rbase + o) * NIN + colg[g];
        raw[g][1] = ld8(src);
        raw[g][0] = o > 0 ? ld8(src - NIN) : zero8();
        raw[g][2] = o < len - 1 ? ld8(src + NIN) : zero8();
      }
    };
    loadraw(0);
    for (int cn = 0; cn < 137; ++cn) {
      float* bbase = buf + (cn & 1) * 32 * 384;
      float* bb = bbase + tok * 384;
      if (cn < 136) {
#pragma unroll
        for (int g = 0; g < 5; ++g) {
          float cur[8], prv[8], nxt[8], sh[8];
          unpack8(raw[g][1], cur); unpack8(raw[g][0], prv); unpack8(raw[g][2], nxt);
#pragma unroll
          for (int j = 0; j < 8; ++j) sh[j] = cur[j] + m0[g][j] * (prv[j] - cur[j]) + m1[g][j] * (nxt[j] - cur[j]);
          if (g < 3) {
            float* dst = bb + (g == 0 ? 0 : g == 1 ? 128 : 320) + c8 * 8;
            *(f32x4*)dst = f32x4{sh[0], sh[1], sh[2], sh[3]};
            *(f32x4*)(dst + 4) = f32x4{sh[4], sh[5], sh[6], sh[7]};
          } else if (g == 3) {
#pragma unroll
            for (int j = 0; j < 8; ++j) sh[j] = 1.f - 2.f / (1.f + __expf(2.f * sh[j]));
            *(bf16x8*)(twS + tok * 72 + c8 * 8) = pack8(sh);
          } else {
            *(bf16x8*)(alS + tok * 72 + c8 * 8) = pack8(sh);
          }
        }
      }
      __syncthreads();
      if (cn < 136) {
        const u16* X = mat ? alS : twS;
        f32x16 acc = zero16();
#pragma unroll
        for (int ks = 0; ks < 4; ++ks) acc = MFMA(ld8(X + l31 * 72 + ks * 16 + h * 8), bw[ks], acc);
        const int ch = nh * 32 + l31;
#pragma unroll
        for (int r = 0; r < 16; ++r) {
          const int tk = crow(r, h);
          const float sg = 1.f / (1.f + __expf(-(c0 + acc[r])));
          if (mat == 0) bbase[tk * 384 + 64 + ch] = __expf(-0.6065306597126334f * sg);
          else bbase[tk * 384 + 256 + ch] = sg;
        }
      }
      __syncthreads();
      if (cn < 136) {
        float kk[8], kr[8], ar[8];
        float ss = 0.f;
        {
          f32x4 k0 = *(const f32x4*)(bb + 128 + c8 * 8), k1 = *(const f32x4*)(bb + 132 + c8 * 8);
          f32x4 a0 = *(const f32x4*)(bb + 256 + c8 * 8), a1 = *(const f32x4*)(bb + 260 + c8 * 8);
#pragma unroll
          for (int j = 0; j < 4; ++j) { kr[j] = k0[j]; kr[4 + j] = k1[j]; ar[j] = a0[j]; ar[4 + j] = a1[j]; }
        }
#pragma unroll
        for (int j = 0; j < 8; ++j) { kk[j] = kr[j] * kkc[j]; ss += kk[j] * kk[j]; }
        ss = sum8(ss);
        const float inv = 1.f / fmaxf(sqrtf(ss), 1e-12f);
        float oa[8], ob[8], ok[8];
#pragma unroll
        for (int j = 0; j < 8; ++j) {
          const float kkn = kk[j] * inv;
          oa[j] = -kkn; ob[j] = kkn * ar[j]; ok[j] = kr[j] * (1.f + (ar[j] - 1.f) * kac[j]);
        }
        *(f32x4*)(bb + 192 + c8 * 8) = f32x4{oa[0], oa[1], oa[2], oa[3]}; *(f32x4*)(bb + 196 + c8 * 8) = f32x4{oa[4], oa[5], oa[6], oa[7]};
        *(f32x4*)(bb + 256 + c8 * 8) = f32x4{ob[0], ob[1], ob[2], ob[3]}; *(f32x4*)(bb + 260 + c8 * 8) = f32x4{ob[4], ob[5], ob[6], ob[7]};
        *(f32x4*)(bb + 128 + c8 * 8) = f32x4{ok[0], ok[1], ok[2], ok[3]}; *(f32x4*)(bb + 132 + c8 * 8) = f32x4{ok[4], ok[5], ok[6], ok[7]};
        if (cn + 1 < 136) loadraw(cn + 1);
      }
      __syncthreads();
    }
  } else {
    const int kq = lane & 7, vrow = 32 * vhalf + 8 * w + (lane >> 3);
    float S[8];
#pragma unroll
    for (int i = 0; i < 8; ++i) S[i] = 0.f;
    for (int c = -1; c < 136; ++c) {
      int o0 = 0, len; size_t rbase = 0;
      if (c >= 0) geom(c, o0, len, rbase);
      const float* bbase = buf + (c & 1) * 32 * 384;
      u16* yp = p.Yrw + ((size_t)d * NTOK + rbase + o0) * 512 + hd * 64 + vrow;
#pragma unroll 1
      for (int part = 0; part < 3; ++part) {
        if (c >= 0) {
          const int s0 = part == 0 ? 0 : part == 1 ? 12 : 22, s1 = part == 0 ? 12 : part == 1 ? 22 : 32;
          f32x4 A[10], Bq[10];
          float va, vb;
          auto ldstep = [&](int s, f32x4 (&R)[10], float& vv) {
            const int i = d ? 31 - s : s;
            const float* t = bbase + i * 384 + 8 * kq;
#pragma unroll
            for (int q = 0; q < 5; ++q) { R[2 * q] = *(const f32x4*)(t + 64 * q); R[2 * q + 1] = *(const f32x4*)(t + 64 * q + 4); }
            vv = bbase[i * 384 + 320 + vrow];
          };
          auto step = [&](const f32x4 (&R)[10], float vv, int s) {
            const int i = d ? 31 - s : s;
            float sa0 = 0.f, sa1 = 0.f;
#pragma unroll
            for (int k = 0; k < 4; ++k) { sa0 += S[k] * R[6][k]; sa1 += S[4 + k] * R[7][k]; }
            float sa = sa0 + sa1;
            sa = sum8(sa);
            float y0 = 0.f, y1 = 0.f;
#pragma unroll
            for (int k = 0; k < 4; ++k) {
              S[k] = S[k] * R[2][k] + (sa * R[8][k] + vv * R[4][k]);
              S[4 + k] = S[4 + k] * R[3][k] + (sa * R[9][k] + vv * R[5][k]);
              y0 += S[k] * R[0][k]; y1 += S[4 + k] * R[1][k];
            }
            float y = y0 + y1;
            y = sum8(y);
            if (kq == 0) yp[(size_t)i * 512] = f2bf(y);
          };
          ldstep(s0, A, va);
          for (int s = s0; s < s1; s += 2) {
            ldstep(s + 1, Bq, vb);
            step(A, va, s);
            if (s + 2 < s1) ldstep(s + 2, A, va);
            step(Bq, vb, s + 1);
          }
        }
        __syncthreads();
      }
    }
  }
}

DI void merge_phase(const KP& p, int layer, int M) {
  const int lane = otid() & 63, w = otid() >> 6;
  const float* mu0 = p.mu + (size_t)layer * 2 * 1792;
  const float* mu1 = mu0 + 1792;
  for (int row = obid() * 8 + w; row < M; row += gridDim.x * 8) {
    const int ch0 = lane * 8;
    {
      float y0[8], y1[8], y[8];
      unpack8(ld8(p.Yret + (size_t)row * 512 + ch0), y0);
      unpack8(ld8(p.Yret + ((size_t)NTOK + row) * 512 + ch0), y1);
      float s = 0.f;
#pragma unroll
      for (int j = 0; j < 8; ++j) { y[j] = y0[j] + y1[j]; s += y[j]; }
      s += __shfl_xor(s, 1); s += __shfl_xor(s, 2); s += __shfl_xor(s, 4); s += __shfl_xor(s, 8);
      const float mean = s * (1.f / 128.f);
      float v = 0.f;
#pragma unroll
      for (int j = 0; j < 8; ++j) { const float dlt = y[j] - mean; v += dlt * dlt; }
      v += __shfl_xor(v, 1); v += __shfl_xor(v, 2); v += __shfl_xor(v, 4); v += __shfl_xor(v, 8);
      const float rstd = rsqrtf(v * (1.f / 128.f) + 1e-5f);
      float gt[8], o[8];
      unpack8(ld8(p.P + (size_t)row * NIN + 1536 + ch0), gt);
#pragma unroll
      for (int j = 0; j < 8; ++j) o[j] = (y[j] - mean) * rstd * p.ret_gn[layer * 512 + ch0 + j] * silu(gt[j]);
      *(bf16x8*)(p.H + (size_t)row * DM + ch0) = pack8(o);
    }
    {
      float y0[8], y1[8], y[8];
      unpack8(ld8(p.Yrw + (size_t)row * 512 + ch0), y0);
      unpack8(ld8(p.Yrw + ((size_t)NTOK + row) * 512 + ch0), y1);
      float s = 0.f;
#pragma unroll
      for (int j = 0; j < 8; ++j) { y[j] = y0[j] + y1[j]; s += y[j]; }
      s += __shfl_xor(s, 1); s += __shfl_xor(s, 2); s += __shfl_xor(s, 4);
      const float mean = s * (1.f / 64.f);
      float v = 0.f;
#pragma unroll
      for (int j = 0; j < 8; ++j) { const float dlt = y[j] - mean; v += dlt * dlt; }
      v += __shfl_xor(v, 1); v += __shfl_xor(v, 2); v += __shfl_xor(v, 4);
      const float rstd = rsqrtf(v * (1.f / 64.f) + 64e-5f);
      int o, len;
      if (row < NLAT) { o = row & 4095; len = 4096; } else { o = (row - NLAT) & 255; len = 256; }
      float f[3][8];
#pragma unroll
      for (int g = 0; g < 3; ++g) {
        const int col = 3904 + 512 * g + ch0;
        const u16* src = p.P + (size_t)row * NIN + col;
        float cur[8], prv[8], nxt[8];
        unpack8(ld8(src), cur);
        if (o > 0) unpack8(ld8(src - NIN), prv); else { for (int j = 0; j < 8; ++j) prv[j] = 0.f; }
        if (o < len - 1) unpack8(ld8(src + NIN), nxt); else { for (int j = 0; j < 8; ++j) nxt[j] = 0.f; }
#pragma unroll
        for (int j = 0; j < 8; ++j) {
          const float m0v = mu0[col - 3904 + j], m1v = mu1[col - 3904 + j];
          f[g][j] = cur[j] + m0v * (prv[j] - cur[j]) + m1v * (nxt[j] - cur[j]);
        }
      }
      float rk = 0.f;
#pragma unroll
      for (int j = 0; j < 8; ++j) rk += f[0][j] * f[1][j] * p.r_k[layer * 512 + ch0 + j];
      rk += __shfl_xor(rk, 1); rk += __shfl_xor(rk, 2); rk += __shfl_xor(rk, 4);
      float gt[8], ov[8];
      unpack8(ld8(p.P + (size_t)row * NIN + 5696 + ch0), gt);
#pragma unroll
      for (int j = 0; j < 8; ++j)
        ov[j] = ((y[j] - mean) * rstd * p.rw_gn[layer * 512 + ch0 + j] + rk * f[2][j]) * silu(gt[j]);
      *(bf16x8*)(p.H + (size_t)row * DM + 1536 + ch0) = pack8(ov);
    }
  }
}

DI void ln_phase(const KP& p, int layer, int M) {
  const int lane = otid() & 63, w = otid() >> 6;
  const float* g = p.ln_g + layer * DM;
  const float* bb_ = p.ln_b + layer * DM;
  for (int row = obid() * 8 + w; row < M; row += gridDim.x * 8) {
    float* ptr = row < NLAT ? p.out + (size_t)row * DM : p.X1c + (size_t)(row - NLAT) * DM;
    f32x4 v[8];
    float s = 0.f;
#pragma unroll
    for (int i = 0; i < 8; ++i) { v[i] = *(const f32x4*)(ptr + (i * 64 + lane) * 4); s += v[i][0] + v[i][1] + v[i][2] + v[i][3]; }
#pragma unroll
    for (int o = 1; o < 64; o <<= 1) s += __shfl_xor(s, o);
    const float mean = s * (1.f / 2048.f);
    float q = 0.f;
#pragma unroll
    for (int i = 0; i < 8; ++i)
#pragma unroll
      for (int j = 0; j < 4; ++j) { const float dlt = v[i][j] - mean; q += dlt * dlt; }
#pragma unroll
    for (int o = 1; o < 64; o <<= 1) q += __shfl_xor(q, o);
    const float rstd = rsqrtf(q * (1.f / 2048.f) + 1e-5f);
    const int bidx = row < NLAT ? (row >> 12) : 4;
    const float* md = p.mod + ((size_t)5 + bidx) * 6144;
#pragma unroll
    for (int i = 0; i < 8; ++i) {
      const int c = (i * 64 + lane) * 4;
      f32x4 gg = *(const f32x4*)(g + c), bbv = *(const f32x4*)(bb_ + c), y;
#pragma unroll
      for (int j = 0; j < 4; ++j) y[j] = (v[i][j] - mean) * rstd * gg[j] + bbv[j];
      *(f32x4*)(ptr + c) = y;
      if (layer == 0) {
        f32x4 sh = *(const f32x4*)(md + c), scl = *(const f32x4*)(md + 2048 + c);
        u32x2 o;
        o[0] = pk2(y[0] * (1.f + scl[0]) + sh[0], y[1] * (1.f + scl[1]) + sh[1]);
        o[1] = pk2(y[2] * (1.f + scl[2]) + sh[2], y[3] * (1.f + scl[3]) + sh[3]);
        *(u32x2*)(p.H + (size_t)row * DM + c) = o;
      }
    }
  }
}

__global__ void __launch_bounds__(NTHR) hybrid_block_megakernel(KP p) {
  extern __shared__ __attribute__((aligned(16))) char smem[];
  cg::grid_group grid = cg::this_grid();
  __shared__ int s_item;
  const int tid = otid();

  if (obid() == 0 && tid < 8) p.cnt[tid] = 0u;
  mod_phase(p, smem);
  convert_weights(p, 0, smem);
  grid.sync();
  h0_phase(p);
  grid.sync();

  for (int layer = 0; layer < 2; ++layer) {
    const int Mq = layer == 0 ? NTOK : NLAT;
    for (int it = obid(); it < 68 * 49; it += gridDim.x) {
      const int nt = it / 68, mt = it % 68;
      gemm_tile(p, 0, layer, mt * 256, nt * 128, smem);
    }
    grid.sync();
    {
      const int n_uq = (Mq / 256) * 12, n_ukv = 68 * 16, n_kr = NTOK / 8;
      for (int it = obid(); it < n_uq + n_ukv + n_kr; it += gridDim.x) {
        if (it < n_uq) gemm_tile(p, 1, layer, (it / 12) * 256, (it % 12) * 128, smem);
        else if (it < n_uq + n_ukv) { const int i = it - n_uq; gemm_tile(p, 2, layer, (i / 16) * 256, (i % 16) * 128, smem); }
        else krope_item(p, it - n_uq - n_ukv);
      }
    }
    grid.sync();
    {
      for (int ch = obid(); ch < 160; ch += gridDim.x) {
        if (ch < 128) rwkv_chain(p, layer, ch, smem); else ret_chain(p, layer, ch - 128, smem);
      }
      const int n_att = layer == 0 ? 512 + 32 : 512;
      while (true) {
        __syncthreads();
        if (tid == 0) s_item = (int)atomicAdd(&p.cnt[layer], 1u);
        __syncthreads();
        const int it = s_item;
        if (it >= n_att) break;
        if (it < 512) {
          const int b = it >> 7, hd = (it >> 4) & 7, qb = it & 15;
          attn_item(p, b * 4096 + qb * 256, b, hd, LPOS, smem);
        } else {
          const int i = it - 512, b = i >> 3, hd = i & 7;
          attn_item(p, NLAT + b * 256, b, hd, 256, smem);
        }
      }
    }
    grid.sync();
    merge_phase(p, layer, Mq);
    grid.sync();
    for (int it = obid(); it < (Mq / 256) * 16; it += gridDim.x) {
      const int nt = it % 16, mt = it / 16;
      gemm_tile(p, 3, layer, mt * 256, nt * 128, smem);
    }
    grid.sync();
    ln_phase(p, layer, Mq);
    if (layer == 0) {
      convert_weights(p, 1, smem);
      grid.sync();
    }
  }
}

extern "C" void kernel_launch(void* const* d_in, const int* in_sizes, int n_in, void* d_out, int out_size, void* d_ws,
                              size_t ws_size, hipStream_t stream) {
  static int grid_blocks = 0;
  if (!grid_blocks) {
    int dev = 0, cus = 0, per_cu = 0;
    hipGetDevice(&dev);
    hipDeviceGetAttribute(&cus, hipDeviceAttributeMultiprocessorCount, dev);
    hipFuncSetAttribute((const void*)hybrid_block_megakernel, hipFuncAttributeMaxDynamicSharedMemorySize, (int)LDS_BYTES);
    hipOccupancyMaxActiveBlocksPerMultiprocessor(&per_cu, hybrid_block_megakernel, NTHR, LDS_BYTES);
    if (per_cu > 1) per_cu = 1;
    grid_blocks = cus * per_cu;
  }
  KP p{};
  const float* const* in = (const float* const*)d_in;
  p.x = in[0]; p.c = in[1]; p.ctx = in[2]; p.c_ctx = in[3]; p.w_ada = in[4]; p.b_ada = in[5]; p.w_in = in[6];
  p.ret_logit = in[7]; p.ret_gn = in[8]; p.q_g = in[9]; p.w_uq = in[10]; p.kv_g = in[11]; p.w_ukv = in[12]; p.mu = in[13];
  p.w0 = in[14]; p.w2 = in[15]; p.a0 = in[16]; p.a2 = in[17]; p.k_k = in[18]; p.k_a = in[19]; p.r_k = in[20]; p.rw_gn = in[21];
  p.w_out = in[22]; p.ln_g = in[23]; p.ln_b = in[24];
  p.out = (float*)d_out;
  char* ws = (char*)d_ws;
  size_t off = 0;
  auto take = [&](size_t bytes) { char* r = ws + off; off += (bytes + 255) & ~(size_t)255; return r; };
  p.P = (u16*)take((size_t)NTOK * NIN * 2);
  p.H = (u16*)take((size_t)NTOK * DM * 2);
  p.Q = (u16*)take((size_t)NTOK * 1536 * 2);
  p.Kn = (u16*)take((size_t)4 * 8 * LPOS * 128 * 2);
  p.Vt = (u16*)take((size_t)4 * 8 * 128 * LPOS * 2);
  p.Kr = (u16*)take((size_t)4 * LPOS * 64 * 2);
  p.Yret = (u16*)take((size_t)2 * NTOK * 512 * 2);
  p.Yrw = (u16*)take((size_t)2 * NTOK * 512 * 2);
  p.WinT = (u16*)take((size_t)NIN * DM * 2);
  p.WuqT = (u16*)take((size_t)1536 * 512 * 2);
  p.WukvT = (u16*)take((size_t)2048 * 256 * 2);
  p.WoutT = (u16*)take((size_t)DM * DM * 2);
  p.W2T = (u16*)take((size_t)2 * 512 * 64 * 2);
  p.A2T = (u16*)take((size_t)2 * 512 * 64 * 2);
  p.X1c = (float*)take((size_t)1024 * DM * 4);
  p.mod = (float*)take((size_t)2 * 5 * 6144 * 4);
  p.cnt = (unsigned*)take(256);
  if (off > ws_size) { fprintf(stderr, "workspace too small: need %zu have %zu\n", off, ws_size); return; }
  void* args[] = {&p};
  hipError_t e = hipLaunchCooperativeKernel((void*)hybrid_block_megakernel, dim3(grid_blocks), dim3(NTHR), args, LDS_BYTES, stream);
  if (e != hipSuccess) fprintf(stderr, "cooperative launch failed: %s (grid %d)\n", hipGetErrorString(e), grid_blocks);
}
```

```cpp
#include <hip/hip_runtime.h>
#include <hip/hip_cooperative_groups.h>
#include <cstdio>
namespace cg = cooperative_groups;

#define DI __device__ __forceinline__
typedef unsigned short u16;
using bf16x8 = __attribute__((ext_vector_type(8))) short;
using s16x4 = __attribute__((ext_vector_type(4))) short;
using f32x16 = __attribute__((ext_vector_type(16))) float;
using f32x4 = __attribute__((ext_vector_type(4))) float;
using u32x4 = __attribute__((ext_vector_type(4))) unsigned;
using u32x2 = __attribute__((ext_vector_type(2))) unsigned;
using f32x2 = __attribute__((ext_vector_type(2))) float;
#define MFMA(a, b, c) __builtin_amdgcn_mfma_f32_32x32x16_bf16((a), (b), (c), 0, 0, 0)

constexpr int DM = 2048, NIN = 6208, NLAT = 16384, NTOK = 17408, LPOS = 4352;
constexpr int NTHR = 512;
constexpr size_t LDS_BYTES = 143360;
constexpr float ALPHA = 1.4142135623730951f;
constexpr float QSCALE = 0.07216878364870323f * 1.4426950408889634f;

struct KP {
  const float *x, *c, *ctx, *c_ctx, *w_ada, *b_ada, *w_in, *ret_logit, *ret_gn, *q_g, *w_uq, *kv_g, *w_ukv, *mu, *w0, *w2, *a0,
      *a2, *k_k, *k_a, *r_k, *rw_gn, *w_out, *ln_g, *ln_b;
  float* out;
  u16 *P, *H, *Q, *Kn, *Vt, *Kr, *Yret, *Yrw, *WinT, *WuqT, *WukvT, *WoutT, *W2T, *A2T;
  float *X1c, *mod;
  unsigned* cnt;
};

DI int otid() { int t = threadIdx.x; asm volatile("" : "+v"(t)); return t; }
DI int obid() { int t = blockIdx.x; asm volatile("" : "+s"(t)); return t; }
template <int CTRL> DI float dppf(float v) {
  return __builtin_bit_cast(float, __builtin_amdgcn_update_dpp(0, __builtin_bit_cast(int, v), CTRL, 0xf, 0xf, true));
}
DI float sum8(float x) { x += dppf<0xB1>(x); x += dppf<0x4E>(x); x += dppf<0x141>(x); return x; }
DI float sum16(float x) { x += dppf<0xB1>(x); x += dppf<0x4E>(x); x += dppf<0x141>(x); x += dppf<0x140>(x); return x; }
DI float bf2f(u16 v) { return __uint_as_float(((unsigned)v) << 16); }
DI float bflo(unsigned v) { return __uint_as_float(v << 16); }
DI float bfhi(unsigned v) { return __uint_as_float(v & 0xffff0000u); }
DI u16 f2bf(float a) { __bf16 r = (__bf16)a; return __builtin_bit_cast(u16, r); }
DI unsigned pk2(float a, float b) {
  typedef __bf16 bf2 __attribute__((ext_vector_type(2)));
  typedef float f2 __attribute__((ext_vector_type(2)));
  f2 v = {a, b};
  bf2 r = __builtin_convertvector(v, bf2);
  return __builtin_bit_cast(unsigned, r);
}
DI int crow(int reg, int h) { return (reg & 3) + 8 * (reg >> 2) + 4 * h; }
DI float silu(float x) { return x / (1.f + __expf(-x)); }
DI void unpack8(const bf16x8& v, float* f) {
  u32x4 u = __builtin_bit_cast(u32x4, v);
#pragma unroll
  for (int i = 0; i < 4; ++i) { f[2 * i] = bflo(u[i]); f[2 * i + 1] = bfhi(u[i]); }
}
DI bf16x8 pack8(const float* f) {
  u32x4 u;
#pragma unroll
  for (int i = 0; i < 4; ++i) u[i] = pk2(f[2 * i], f[2 * i + 1]);
  return __builtin_bit_cast(bf16x8, u);
}
DI bf16x8 ld8(const u16* p) { return *(const bf16x8*)p; }
DI bf16x8 zero8() { bf16x8 z = {0, 0, 0, 0, 0, 0, 0, 0}; return z; }
DI f32x16 zero16() { f32x16 z; for (int i = 0; i < 16; ++i) z[i] = 0.f; return z; }
DI s16x4 trread(const u16* p) {
  return __builtin_amdgcn_ds_read_tr16_b64_v4i16((s16x4 __attribute__((address_space(3)))*)(p));
}
DI bf16x8 cat4(s16x4 lo, s16x4 hi) { return __builtin_shufflevector(lo, hi, 0, 1, 2, 3, 4, 5, 6, 7); }
DI void rope_cs(int pos, int i, float& cs, float& sn) {
  float inv = exp2f(-(float)i * (13.287712379549449f / 16.f));
  float rev = (float)pos * inv * 0.15915494309189535f;
  rev -= floorf(rev);
  cs = __builtin_amdgcn_cosf(rev);
  sn = __builtin_amdgcn_sinf(rev);
}

DI void transpose_item(const float* src, u16* dst, int K, int N, int kt, int nt, char* smem) {
  float* tile = (float*)smem;
  const int tid = otid();
  __syncthreads();
  {
    const int kk = tid >> 4, n4 = tid & 15;
#pragma unroll
    for (int i = 0; i < 2; ++i) {
      const int k = kk + 32 * i;
      f32x4 v = *(const f32x4*)(src + (size_t)(kt * 64 + k) * N + nt * 64 + n4 * 4);
      tile[k * 65 + n4 * 4 + 0] = v[0]; tile[k * 65 + n4 * 4 + 1] = v[1];
      tile[k * 65 + n4 * 4 + 2] = v[2]; tile[k * 65 + n4 * 4 + 3] = v[3];
    }
  }
  __syncthreads();
  {
    const int n = tid >> 3, k8 = tid & 7;
    float f[8];
#pragma unroll
    for (int j = 0; j < 8; ++j) f[j] = tile[(k8 * 8 + j) * 65 + n];
    *(bf16x8*)(dst + (size_t)(nt * 64 + n) * K + kt * 64 + k8 * 8) = pack8(f);
  }
}

DI void convert_weights(const KP& p, int layer, char* smem) {
  const int n_in = 32 * 97, n_uq = 8 * 24, n_ukv = 4 * 32, n_out = 32 * 32, n_lora = 8;
  const int total = n_in + n_uq + n_ukv + n_out + 4 * n_lora;
  for (int it = obid(); it < total; it += gridDim.x) {
    int i = it;
    if (i < n_in) { transpose_item(p.w_in + (size_t)layer * DM * NIN, p.WinT, DM, NIN, i / 97, i % 97, smem); continue; }
    i -= n_in;
    if (i < n_uq) { transpose_item(p.w_uq + (size_t)layer * 512 * 1536, p.WuqT, 512, 1536, i / 24, i % 24, smem); continue; }
    i -= n_uq;
    if (i < n_ukv) { transpose_item(p.w_ukv + (size_t)layer * 256 * 2048, p.WukvT, 256, 2048, i / 32, i % 32, smem); continue; }
    i -= n_ukv;
    if (i < n_out) { transpose_item(p.w_out + (size_t)layer * DM * DM, p.WoutT, DM, DM, i / 32, i % 32, smem); continue; }
    i -= n_out;
    {
      const int which = i / (2 * n_lora), r = i % (2 * n_lora), d = r / n_lora, nt = r % n_lora;
      const float* src = (which ? p.a2 : p.w2) + ((size_t)layer * 2 + d) * 64 * 512;
      u16* dst = (which ? p.A2T : p.W2T) + (size_t)d * 512 * 64;
      transpose_item(src, dst, 64, 512, 0, nt, smem);
    }
  }
}

DI void mod_phase(const KP& p, char* smem) {
  float* sc = (float*)smem;
  float* red = sc + 5 * 2048;
  const int tid = otid();
  __syncthreads();
  for (int i = tid; i < 5 * 2048; i += NTHR) {
    float v = i < 4 * 2048 ? p.c[i] : p.c_ctx[i - 4 * 2048];
    sc[i] = silu(v);
  }
  __syncthreads();
  const int kg = tid >> 5, col = tid & 31;
  for (int it = obid(); it < 384; it += gridDim.x) {
    const int layer = it / 192, j = (it % 192) * 32 + col;
    const float* w = p.w_ada + (size_t)layer * DM * 6144 + j;
    float acc[5] = {0.f, 0.f, 0.f, 0.f, 0.f};
    for (int k = kg * 128; k < kg * 128 + 128; ++k) {
      float wv = w[(size_t)k * 6144];
#pragma unroll
      for (int r = 0; r < 5; ++r) acc[r] += sc[r * 2048 + k] * wv;
    }
#pragma unroll
    for (int r = 0; r < 5; ++r) red[(kg * 5 + r) * 32 + col] = acc[r];
    __syncthreads();
    if (tid < 160) {
      const int r = tid >> 5;
      float s = p.b_ada[(size_t)layer * 6144 + j];
      for (int g = 0; g < 16; ++g) s += red[(g * 5 + r) * 32 + col];
      p.mod[((size_t)layer * 5 + r) * 6144 + j] = s;
    }
    __syncthreads();
  }
}

DI void h0_phase(const KP& p) {
  const int lane = otid() & 63, w = otid() >> 6;
  for (int row = obid() * 8 + w; row < NTOK; row += gridDim.x * 8) {
    const float* src = row < NLAT ? p.x + (size_t)row * DM : p.ctx + (size_t)(row - NLAT) * DM;
    const int bb = row < NLAT ? (row >> 12) : 4;
    const float* md = p.mod + (size_t)bb * 6144;
#pragma unroll
    for (int i = 0; i < 8; ++i) {
      const int c = (i * 64 + lane) * 4;
      f32x4 v = *(const f32x4*)(src + c), sh = *(const f32x4*)(md + c), scl = *(const f32x4*)(md + 2048 + c);
      u32x2 o;
      o[0] = pk2(v[0] * (1.f + scl[0]) + sh[0], v[1] * (1.f + scl[1]) + sh[1]);
      o[1] = pk2(v[2] * (1.f + scl[2]) + sh[2], v[3] * (1.f + scl[3]) + sh[3]);
      *(u32x2*)(p.H + (size_t)row * DM + c) = o;
    }
  }
}

DI void gemm_tile(const KP& p, int mode, int layer, int m0, int n0, char* smem) {
  u16* As = (u16*)smem;
  u16* Bs = As + 256 * 72;
  float* rs = (float*)(Bs + 128 * 72);
  const int tid = otid(), lane = tid & 63, w = tid >> 6, wm = w >> 1, wn = w & 1, l31 = lane & 31, h = lane >> 5;
  const u16* A; const u16* Bt; const float* gv = nullptr; int lda, K, N;
  if (mode == 0) { A = p.H; lda = DM; K = DM; N = NIN; Bt = p.WinT; }
  else if (mode == 1) { A = p.P + 2048; lda = NIN; K = 512; N = 1536; Bt = p.WuqT; gv = p.q_g + layer * 512; }
  else if (mode == 2) { A = p.P + 2560; lda = NIN; K = 256; N = 2048; Bt = p.WukvT; gv = p.kv_g + layer * 256; }
  else { A = p.H; lda = DM; K = DM; N = DM; Bt = p.WoutT; }
  const bool xf = (mode == 1 || mode == 2);
  __syncthreads();
  if (xf) {
    const int r = tid >> 1, part = tid & 1;
    const u16* src = A + (size_t)(m0 + r) * lda + part * (K >> 1);
    float ss = 0.f;
    for (int i = 0; i < (K >> 1); i += 8) {
      float f[8]; unpack8(ld8(src + i), f);
#pragma unroll
      for (int j = 0; j < 8; ++j) ss += f[j] * f[j];
    }
    ss += __shfl_xor(ss, 1);
    if (!part) rs[r] = rsqrtf(ss / (float)K + 1e-6f);
    __syncthreads();
  }
  f32x16 acc[2][2];
#pragma unroll
  for (int i = 0; i < 2; ++i)
#pragma unroll
    for (int j = 0; j < 2; ++j) acc[i][j] = zero16();
  bf16x8 ra[4], rb[2];
  const int arow = tid >> 3, ac = tid & 7;
  auto loadg = [&](int k0) {
#pragma unroll
    for (int i = 0; i < 4; ++i) {
      const int row = arow + 64 * i;
      bf16x8 v = ld8(A + (size_t)(m0 + row) * lda + k0 + ac * 8);
      if (xf) {
        float f[8]; unpack8(v, f);
        const float s = rs[row];
        f32x4 g0 = *(const f32x4*)(gv + k0 + ac * 8), g1 = *(const f32x4*)(gv + k0 + ac * 8 + 4);
#pragma unroll
        for (int j = 0; j < 4; ++j) { f[j] *= s * g0[j]; f[4 + j] *= s * g1[j]; }
        v = pack8(f);
      }
      ra[i] = v;
    }
#pragma unroll
    for (int i = 0; i < 2; ++i) {
      int nrow = n0 + arow + 64 * i;
      nrow = nrow < N ? nrow : N - 1;
      rb[i] = ld8(Bt + (size_t)nrow * K + k0 + ac * 8);
    }
  };
  loadg(0);
  for (int k0 = 0; k0 < K; k0 += 64) {
    __syncthreads();
#pragma unroll
    for (int i = 0; i < 4; ++i) *(bf16x8*)(As + (arow + 64 * i) * 72 + ac * 8) = ra[i];
#pragma unroll
    for (int i = 0; i < 2; ++i) *(bf16x8*)(Bs + (arow + 64 * i) * 72 + ac * 8) = rb[i];
    __syncthreads();
    if (k0 + 64 < K) loadg(k0 + 64);
#pragma unroll
    for (int ks = 0; ks < 4; ++ks) {
      bf16x8 a0 = ld8(As + (wm * 64 + l31) * 72 + ks * 16 + h * 8);
      bf16x8 a1 = ld8(As + (wm * 64 + 32 + l31) * 72 + ks * 16 + h * 8);
      bf16x8 b0 = ld8(Bs + (wn * 64 + l31) * 72 + ks * 16 + h * 8);
      bf16x8 b1 = ld8(Bs + (wn * 64 + 32 + l31) * 72 + ks * 16 + h * 8);
      acc[0][0] = MFMA(a0, b0, acc[0][0]);
      acc[0][1] = MFMA(a0, b1, acc[0][1]);
      acc[1][0] = MFMA(a1, b0, acc[1][0]);
      acc[1][1] = MFMA(a1, b1, acc[1][1]);
    }
  }
#pragma unroll
  for (int mi = 0; mi < 2; ++mi)
#pragma unroll
    for (int ni = 0; ni < 2; ++ni) {
      const int cb = n0 + wn * 64 + ni * 32;
      if (cb >= N) continue;
      const int col = cb + l31;
      const int rb0 = m0 + wm * 64 + mi * 32;
      const f32x16& a = acc[mi][ni];
      if (mode == 0) {
#pragma unroll
        for (int r = 0; r < 16; ++r) p.P[(size_t)(rb0 + crow(r, h)) * NIN + col] = f2bf(a[r]);
      } else if (mode == 1) {
        const int dd = cb % 192;
        const bool rope = (dd >= 128) && (rb0 < NLAT);
        const int part = (dd - 128) >> 5;
#pragma unroll
        for (int r = 0; r < 16; ++r) {
          const int row = rb0 + crow(r, h);
          float v = a[r] * QSCALE;
          if (rope) {
            const int t = row & 4095;
            const int pos = part ? (t & 63) : (t >> 6);
            float cs, sn; rope_cs(pos, l31 & 15, cs, sn);
            const float pr = __shfl_xor(v, 16);
            v = (l31 < 16) ? (v * cs - pr * sn) : (v * cs + pr * sn);
          }
          p.Q[(size_t)row * 1536 + col] = f2bf(v);
        }
      } else if (mode == 2) {
        const int head = col >> 8, dd = col & 255;
#pragma unroll
        for (int g = 0; g < 4; ++g) {
          const int row = rb0 + 8 * g + 4 * h;
          int b, pos;
          if (row < NLAT) { b = row >> 12; pos = 256 + (row & 4095); } else { b = (row - NLAT) >> 8; pos = (row - NLAT) & 255; }
          if (dd < 128) {
#pragma unroll
            for (int j = 0; j < 4; ++j) p.Kn[((size_t)(b * 8 + head) * LPOS + pos + j) * 128 + dd] = f2bf(a[4 * g + j]);
          } else {
            u32x2 o; o[0] = pk2(a[4 * g], a[4 * g + 1]); o[1] = pk2(a[4 * g + 2], a[4 * g + 3]);
            *(u32x2*)(p.Vt + ((size_t)(b * 8 + head) * 128 + (dd - 128)) * LPOS + pos) = o;
          }
        }
      } else {
#pragma unroll
        for (int r = 0; r < 16; ++r) {
          const int row = rb0 + crow(r, h);
          const int bb = row < NLAT ? (row >> 12) : 4;
          const float gate = p.mod[((size_t)layer * 5 + bb) * 6144 + 4096 + col];
          float xv;
          float* dst;
          if (row < NLAT) {
            dst = p.out + (size_t)row * DM + col;
            xv = layer == 0 ? p.x[(size_t)row * DM + col] : *dst;
          } else {
            dst = p.X1c + (size_t)(row - NLAT) * DM + col;
            xv = p.ctx[(size_t)(row - NLAT) * DM + col];
          }
          *dst = ALPHA * xv + gate * a[r];
        }
      }
    }
}

DI void krope_item(const KP& p, int it) {
  const int tid = otid(), tok = tid >> 6, dim = tid & 63;
  const int row = it * 8 + tok;
  const u16* src = p.P + (size_t)row * NIN + 2816;
  float v = bf2f(src[dim]);
  int b, pos;
  if (row < NLAT) {
    const float pr = bf2f(src[dim ^ 16]);
    const int t = row & 4095, part = dim >> 5;
    const int ps = part ? (t & 63) : (t >> 6);
    float cs, sn; rope_cs(ps, dim & 15, cs, sn);
    v = ((dim & 31) < 16) ? (v * cs - pr * sn) : (v * cs + pr * sn);
    b = row >> 12; pos = 256 + t;
  } else { b = (row - NLAT) >> 8; pos = (row - NLAT) & 255; }
  p.Kr[((size_t)b * LPOS + pos) * 64 + dim] = f2bf(v);
}

DI void attn_item(const KP& p, int qrow0, int b, int hd, int nkeys, char* smem) {
  constexpr int STG = 64 * 200 + 128 * 72;
  u16* base = (u16*)smem;
  const int tid = otid(), lane = tid & 63, w = tid >> 6, l31 = lane & 31, h = lane >> 5;
  const int qrow = qrow0 + 32 * w + l31;
  bf16x8 qf[12];
  {
    const u16* qp = p.Q + (size_t)qrow * 1536 + hd * 192 + 8 * h;
#pragma unroll
    for (int ks = 0; ks < 12; ++ks) qf[ks] = ld8(qp + 16 * ks);
  }
  f32x16 o[4];
#pragma unroll
  for (int i = 0; i < 4; ++i) o[i] = zero16();
  float m = -1e30f, lsum = 0.f;
  const u16* kn = p.Kn + (size_t)(b * 8 + hd) * LPOS * 128;
  const u16* kr = p.Kr + (size_t)b * LPOS * 64;
  const u16* vt = p.Vt + (size_t)(b * 8 + hd) * 128 * LPOS;
  int kkey[3], kc[3];
#pragma unroll
  for (int i = 0; i < 3; ++i) { const int idx = tid + NTHR * i; kkey[i] = idx / 24; kc[i] = idx % 24; }
  bf16x8 rk[3], rv[2];
  auto loadg = [&](int kt0) {
#pragma unroll
    for (int i = 0; i < 3; ++i) {
      const u16* src = kc[i] < 16 ? kn + (size_t)(kt0 + kkey[i]) * 128 + kc[i] * 8 : kr + (size_t)(kt0 + kkey[i]) * 64 + (kc[i] - 16) * 8;
      rk[i] = ld8(src);
    }
#pragma unroll
    for (int i = 0; i < 2; ++i) {
      const int idx = tid + NTHR * i, dd = idx >> 3, c = idx & 7;
      rv[i] = ld8(vt + (size_t)dd * LPOS + kt0 + c * 8);
    }
  };
  auto stage = [&](int buf) {
    u16* Ksm = base + buf * STG;
    u16* Vsm = Ksm + 64 * 200;
#pragma unroll
    for (int i = 0; i < 3; ++i) *(bf16x8*)(Ksm + kkey[i] * 200 + kc[i] * 8) = rk[i];
#pragma unroll
    for (int i = 0; i < 2; ++i) {
      const int idx = tid + NTHR * i, dd = idx >> 3, c = idx & 7;
      u32x4 u = __builtin_bit_cast(u32x4, rv[i]);
      u32x2 lo = {u[0], u[1]}, hi = {u[2], u[3]};
      u16* dst = Vsm + dd * 72 + 16 * (c >> 1) + 4 * (c & 1);
      *(u32x2*)dst = lo;
      *(u32x2*)(dst + 8) = hi;
    }
  };
  __syncthreads();
  loadg(0);
  stage(0);
  __syncthreads();
  const int ntile = nkeys >> 6;
  for (int t = 0; t < ntile; ++t) {
    const u16* Ksm = base + (t & 1) * STG;
    const u16* Vsm = Ksm + 64 * 200;
    if (t + 1 < ntile) loadg((t + 1) * 64);
    f32x16 s[2];
#pragma unroll
    for (int kt = 0; kt < 2; ++kt) {
      s[kt] = zero16();
#pragma unroll
      for (int ks = 0; ks < 12; ++ks) {
        bf16x8 a = ld8(Ksm + (kt * 32 + l31) * 200 + ks * 16 + h * 8);
        s[kt] = MFMA(a, qf[ks], s[kt]);
        if ((ks & 3) == 3) asm volatile("" ::: "memory");
      }
    }
    float mx = s[0][0];
#pragma unroll
    for (int r = 0; r < 16; ++r) { mx = fmaxf(mx, s[0][r]); mx = fmaxf(mx, s[1][r]); }
    mx = fmaxf(mx, __shfl_xor(mx, 32));
    const float mnew = fmaxf(m, mx);
    const float alpha = __builtin_amdgcn_exp2f(m - mnew);
    m = mnew;
    float ps = 0.f;
#pragma unroll
    for (int kt = 0; kt < 2; ++kt)
#pragma unroll
      for (int r = 0; r < 16; ++r) { float e = __builtin_amdgcn_exp2f(s[kt][r] - mnew); s[kt][r] = e; ps += e; }
    lsum = lsum * alpha + ps;
#pragma unroll
    for (int dt = 0; dt < 4; ++dt)
#pragma unroll
      for (int r = 0; r < 16; ++r) o[dt][r] *= alpha;
#pragma unroll
    for (int kt = 0; kt < 2; ++kt)
#pragma unroll
      for (int sI = 0; sI < 2; ++sI) {
        u32x4 pu;
#pragma unroll
        for (int j = 0; j < 4; ++j) pu[j] = pk2(s[kt][8 * sI + 2 * j], s[kt][8 * sI + 2 * j + 1]);
        const bf16x8 pb = __builtin_bit_cast(bf16x8, pu);
        const int kb = kt * 32 + sI * 16 + 8 * h;
#pragma unroll
        for (int dt = 0; dt < 4; ++dt) o[dt] = MFMA(ld8(Vsm + (dt * 32 + l31) * 72 + kb), pb, o[dt]);
        asm volatile("" ::: "memory");
      }
    if (t + 1 < ntile) stage((t + 1) & 1);
    __syncthreads();
  }
  lsum += __shfl_xor(lsum, 32);
  const float inv = 1.f / lsum;
  const u16* gp = p.P + (size_t)qrow * NIN + 2880 + hd * 128;
  u16* op = p.H + (size_t)qrow * DM + 512 + hd * 128;
#pragma unroll
  for (int dt = 0; dt < 4; ++dt)
#pragma unroll
    for (int g = 0; g < 4; ++g) {
      const int d0 = dt * 32 + 8 * g + 4 * h;
      u32x2 gg = *(const u32x2*)(gp + d0);
      float g0 = bflo(gg[0]), g1 = bfhi(gg[0]), g2 = bflo(gg[1]), g3 = bfhi(gg[1]);
      u32x2 ov;
      ov[0] = pk2(o[dt][4 * g] * inv * silu(g0), o[dt][4 * g + 1] * inv * silu(g1));
      ov[1] = pk2(o[dt][4 * g + 2] * inv * silu(g2), o[dt][4 * g + 3] * inv * silu(g3));
      *(u32x2*)(op + d0) = ov;
    }
}

DI void ret_chain(const KP& p, int layer, int chain, char* smem) {
  const int d = chain >> 4, b = (chain >> 2) & 3, hd = chain & 3;
  u16* Qs = (u16*)smem;
  u16* Ks = Qs + 128 * 136;
  u16* Vs = Ks + 128 * 136;
  u16* Sts = Vs + 128 * 136;
  const int tid = otid(), lane = tid & 63, w = tid >> 6, l31 = lane & 31, h = lane >> 5;
  const int q4 = (lane & 15) >> 2, p4 = lane & 3, blk = (lane >> 4) & 1;
  const float logit = p.ret_logit[(layer * 2 + d) * 4 + hd];
  const float z = -logit;
  const float logg = -(fmaxf(z, 0.f) + log1pf(expf(-fabsf(z))));
  const float lg2 = logg * 1.4426950408889634f;
  const float gC = exp2f(128.f * lg2);
  const float kscale = 0.08838834764831845f;
  const int iw = w & 3, half = w >> 2;
  const int kt = w & 3, vh = w >> 2;
  f32x16 st[2];
  st[0] = zero16(); st[1] = zero16();
  __syncthreads();
  for (int i = tid; i < 128 * 136 / 8; i += NTHR) *(bf16x8*)(Sts + i * 8) = zero8();
  bf16x8 rq[4], rk[4], rv[4];
  const int trow = tid >> 4, tc = tid & 15;
  auto rowbase = [&](int n) -> size_t {
    if (d == 0) return n < 2 ? (size_t)(NLAT + b * 256 + 128 * n) : (size_t)(b * 4096 + 128 * (n - 2));
    return n < 2 ? (size_t)(NLAT + b * 256 + 128 * (1 - n)) : (size_t)(b * 4096 + 128 * (33 - n));
  };
  auto loadg = [&](int n) {
    const size_t rb = rowbase(n);
#pragma unroll
    for (int i = 0; i < 4; ++i) {
      const u16* src = p.P + (rb + trow + 32 * i) * NIN + hd * 128 + tc * 8;
      rq[i] = ld8(src); rk[i] = ld8(src + 512); rv[i] = ld8(src + 1024);
    }
  };
  loadg(0);
  for (int n = 0; n < 34; ++n) {
    const size_t rb = rowbase(n);
#pragma unroll
    for (int i = 0; i < 4; ++i) {
      const int j = trow + 32 * i;
      *(bf16x8*)(Qs + j * 136 + tc * 8) = rq[i];
      *(bf16x8*)(Ks + j * 136 + tc * 8) = rk[i];
      const float zeta = exp2f((d == 0 ? (float)(127 - j) : (float)j) * lg2) * kscale;
      float f[8]; unpack8(rv[i], f);
#pragma unroll
      for (int jj = 0; jj < 8; ++jj) f[jj] *= zeta;
      *(bf16x8*)(Vs + j * 136 + tc * 8) = pack8(f);
    }
    __syncthreads();
    if (n + 1 < 34) loadg(n + 1);
    f32x16 acc[2];
    acc[0] = zero16(); acc[1] = zero16();
    bf16x8 qf[8];
#pragma unroll
    for (int ks = 0; ks < 8; ++ks) qf[ks] = ld8(Qs + (32 * iw + l31) * 136 + 16 * ks + 8 * h);
#pragma unroll
    for (int et = 0; et < 2; ++et)
#pragma unroll
      for (int ks = 0; ks < 8; ++ks) {
        bf16x8 a = ld8(Sts + (32 * (2 * half + et) + l31) * 136 + 16 * ks + 8 * h);
        acc[et] = MFMA(a, qf[ks], acc[et]);
      }
#pragma unroll
    for (int et = 0; et < 2; ++et)
#pragma unroll
      for (int r = 0; r < 16; ++r) acc[et][r] *= gC;
    const int ii = 32 * iw + l31;
#pragma unroll
    for (int jt = 0; jt < 4; ++jt) {
      f32x16 sT = zero16();
#pragma unroll
      for (int ks = 0; ks < 8; ++ks) {
        bf16x8 a = ld8(Ks + (32 * jt + l31) * 136 + 16 * ks + 8 * h);
        sT = MFMA(a, qf[ks], sT);
      }
#pragma unroll
      for (int r = 0; r < 16; ++r) {
        const int j = 32 * jt + crow(r, h);
        const bool keep = d == 0 ? (ii >= j) : (j >= ii);
        sT[r] = keep ? sT[r] : 0.f;
      }
#pragma unroll
      for (int sI = 0; sI < 2; ++sI) {
        u32x4 pu;
#pragma unroll
        for (int j = 0; j < 4; ++j) pu[j] = pk2(sT[8 * sI + 2 * j], sT[8 * sI + 2 * j + 1]);
        const bf16x8 pb = __builtin_bit_cast(bf16x8, pu);
        const int j0 = 32 * jt + 16 * sI + 4 * h;
#pragma unroll
        for (int et = 0; et < 2; ++et) {
          const u16* vp = Vs + (j0 + q4) * 136 + 32 * (2 * half + et) + 16 * blk + 4 * p4;
          s16x4 lo = trread(vp), hi = trread(vp + 8 * 136);
          acc[et] = MFMA(cat4(lo, hi), pb, acc[et]);
        }
      }
    }
    {
      const float rho = exp2f((d == 0 ? (float)(ii - 127) : (float)(-ii)) * lg2);
      u16* yp = p.Yret + ((size_t)d * NTOK + rb + ii) * 512 + hd * 128;
#pragma unroll
      for (int et = 0; et < 2; ++et)
#pragma unroll
        for (int g = 0; g < 4; ++g) {
          const int e0 = 32 * (2 * half + et) + 8 * g + 4 * h;
          u32x2 ov;
          ov[0] = pk2(acc[et][4 * g] * rho, acc[et][4 * g + 1] * rho);
          ov[1] = pk2(acc[et][4 * g + 2] * rho, acc[et][4 * g + 3] * rho);
          *(u32x2*)(yp + e0) = ov;
        }
    }
#pragma unroll
    for (int vi = 0; vi < 2; ++vi)
#pragma unroll
      for (int r = 0; r < 16; ++r) st[vi][r] *= gC;
#pragma unroll
    for (int ks = 0; ks < 8; ++ks) {
      const int jb = 16 * ks + 4 * h + q4;
      const u16* kp = Ks + jb * 136 + 32 * kt + 16 * blk + 4 * p4;
      const bf16x8 a = cat4(trread(kp), trread(kp + 8 * 136));
#pragma unroll
      for (int vi = 0; vi < 2; ++vi) {
        const u16* vp = Vs + jb * 136 + 32 * (2 * vh + vi) + 16 * blk + 4 * p4;
        const bf16x8 bfr = cat4(trread(vp), trread(vp + 8 * 136));
        st[vi] = MFMA(a, bfr, st[vi]);
      }
    }
    __syncthreads();
#pragma unroll
    for (int vi = 0; vi < 2; ++vi)
#pragma unroll
      for (int g = 0; g < 4; ++g) {
        const int v = 32 * (2 * vh + vi) + l31, k0 = 32 * kt + 8 * g + 4 * h;
        u32x2 ov;
        ov[0] = pk2(st[vi][4 * g], st[vi][4 * g + 1]);
        ov[1] = pk2(st[vi][4 * g + 2], st[vi][4 * g + 3]);
        *(u32x2*)(Sts + v * 136 + k0) = ov;
      }
  }
}

DI void rwkv_chain(const KP& p, int layer, int item, char* smem) {
  const int chain = item >> 1, vhalf = item & 1;
  const int d = chain >> 5, b = (chain >> 3) & 3, hd = chain & 7;
  float* buf = (float*)smem;
  u16* twS = (u16*)(smem + 98304);
  u16* alS = twS + 32 * 72;
  const int tid = otid(), lane = tid & 63, w = tid >> 6, l31 = lane & 31, h = lane >> 5;
  auto geom = [&](int cc, int& o0, int& len, size_t& rbase) {
    const int j0 = 32 * cc;
    const bool isctx = j0 < 256;
    len = isctx ? 256 : 4096;
    if (d == 0) o0 = isctx ? j0 : j0 - 256; else o0 = isctx ? (224 - j0) : (4064 - (j0 - 256));
    rbase = isctx ? (size_t)(NLAT + b * 256) : (size_t)(b * 4096);
  };
  __syncthreads();
  if (w >= 4) {
    const int pt = tid - 256;
    const int pw = w - 4, mat = pw >> 1, nh = pw & 1;
    bf16x8 bw[4];
    const int n = hd * 64 + nh * 32 + l31;
    {
      const u16* wT = (mat ? p.A2T : p.W2T) + ((size_t)d * 512 + n) * 64 + 8 * h;
#pragma unroll
      for (int ks = 0; ks < 4; ++ks) bw[ks] = ld8(wT + 16 * ks);
    }
    const float c0 = (mat ? p.a0 : p.w0)[((size_t)layer * 2 + d) * 512 + n];
    const int tok = pt >> 3, c8 = pt & 7;
    int colg[5];
    colg[0] = 3904 + hd * 64 + c8 * 8; colg[1] = 4416 + hd * 64 + c8 * 8; colg[2] = 4928 + hd * 64 + c8 * 8;
    colg[3] = 5440 + d * 64 + c8 * 8; colg[4] = 5568 + d * 64 + c8 * 8;
    const float* mu0 = p.mu + (size_t)layer * 2 * 1792;
    const float* mu1 = mu0 + 1792;
    float m0[5][8], m1[5][8], kkc[8], kac[8];
#pragma unroll
    for (int g = 0; g < 5; ++g)
#pragma unroll
      for (int j = 0; j < 8; ++j) { m0[g][j] = mu0[colg[g] - 3904 + j]; m1[g][j] = mu1[colg[g] - 3904 + j]; }
#pragma unroll
    for (int j = 0; j < 8; ++j) { kkc[j] = p.k_k[layer * 512 + hd * 64 + c8 * 8 + j]; kac[j] = p.k_a[layer * 512 + hd * 64 + c8 * 8 + j]; }
    bf16x8 raw[5][3];
    auto loadraw = [&](int cc) {
      int o0, len; size_t rbase; geom(cc, o0, len, rbase);
      const int o = o0 + tok;
#pragma unroll
      for (int g = 0; g < 5; ++g) {
        const u16* src = p.P + (rbase + o) * NIN + colg[g];
        raw[g][1] = ld8(src);
        raw[g][0] = o > 0 ? ld8(src - NIN) : zero8();
        raw[g][2] = o < len - 1 ? ld8(src + NIN) : zero8();
      }
    };
    loadraw(0);
    for (int cn = 0; cn < 137; ++cn) {
      float* bbase = buf + (cn & 1) * 32 * 384;
      float* bb = bbase + tok * 384;
      if (cn < 136) {
#pragma unroll
        for (int g = 0; g < 5; ++g) {
          float cur[8], prv[8], nxt[8], sh[8];
          unpack8(raw[g][1], cur); unpack8(raw[g][0], prv); unpack8(raw[g][2], nxt);
#pragma unroll
          for (int j = 0; j < 8; ++j) sh[j] = cur[j] + m0[g][j] * (prv[j] - cur[j]) + m1[g][j] * (nxt[j] - cur[j]);
          if (g < 3) {
            float* dst = bb + (g == 0 ? 0 : g == 1 ? 128 : 320) + c8 * 8;
            *(f32x4*)dst = f32x4{sh[0], sh[1], sh[2], sh[3]};
            *(f32x4*)(dst + 4) = f32x4{sh[4], sh[5], sh[6], sh[7]};
          } else if (g == 3) {
#pragma unroll
            for (int j = 0; j < 8; ++j) sh[j] = 1.f - 2.f / (1.f + __expf(2.f * sh[j]));
            *(bf16x8*)(twS + tok * 72 + c8 * 8) = pack8(sh);
          } else {
            *(bf16x8*)(alS + tok * 72 + c8 * 8) = pack8(sh);
          }
        }
      }
      __syncthreads();
      if (cn + 1 < 136) loadraw(cn + 1);
      if (cn < 136) {
        const u16* X = mat ? alS : twS;
        f32x16 acc = zero16();
#pragma unroll
        for (int ks = 0; ks < 4; ++ks) acc = MFMA(ld8(X + l31 * 72 + ks * 16 + h * 8), bw[ks], acc);
        const int ch = nh * 32 + l31;
#pragma unroll
        for (int r = 0; r < 16; ++r) {
          const int tk = crow(r, h);
          const float sg = 1.f / (1.f + __expf(-(c0 + acc[r])));
          if (mat == 0) bbase[tk * 384 + 64 + ch] = __expf(-0.6065306597126334f * sg);
          else bbase[tk * 384 + 256 + ch] = sg;
        }
      }
      __syncthreads();
      if (cn < 136) {
        float kk[8], kr[8], ar[8];
        float ss = 0.f;
        {
          f32x4 k0 = *(const f32x4*)(bb + 128 + c8 * 8), k1 = *(const f32x4*)(bb + 132 + c8 * 8);
          f32x4 a0 = *(const f32x4*)(bb + 256 + c8 * 8), a1 = *(const f32x4*)(bb + 260 + c8 * 8);
#pragma unroll
          for (int j = 0; j < 4; ++j) { kr[j] = k0[j]; kr[4 + j] = k1[j]; ar[j] = a0[j]; ar[4 + j] = a1[j]; }
        }
#pragma unroll
        for (int j = 0; j < 8; ++j) { kk[j] = kr[j] * kkc[j]; ss += kk[j] * kk[j]; }
        ss = sum8(ss);
        const float inv = 1.f / fmaxf(sqrtf(ss), 1e-12f);
        float oa[8], ob[8], ok[8];
#pragma unroll
        for (int j = 0; j < 8; ++j) {
          const float kkn = kk[j] * inv;
          oa[j] = -kkn; ob[j] = kkn * ar[j]; ok[j] = kr[j] * (1.f + (ar[j] - 1.f) * kac[j]);
        }
        *(f32x4*)(bb + 192 + c8 * 8) = f32x4{oa[0], oa[1], oa[2], oa[3]}; *(f32x4*)(bb + 196 + c8 * 8) = f32x4{oa[4], oa[5], oa[6], oa[7]};
        *(f32x4*)(bb + 256 + c8 * 8) = f32x4{ob[0], ob[1], ob[2], ob[3]}; *(f32x4*)(bb + 260 + c8 * 8) = f32x4{ob[4], ob[5], ob[6], ob[7]};
        *(f32x4*)(bb + 128 + c8 * 8) = f32x4{ok[0], ok[1], ok[2], ok[3]}; *(f32x4*)(bb + 132 + c8 * 8) = f32x4{ok[4], ok[5], ok[6], ok[7]};
      }
      __syncthreads();
    }
  } else {
    const int kq = lane & 15, vrow = 32 * vhalf + 8 * w + 2 * (lane >> 4);
    float S0[4], S1[4];
#pragma unroll
    for (int i = 0; i < 4; ++i) { S0[i] = 0.f; S1[i] = 0.f; }
    for (int c = -1; c < 136; ++c) {
      int o0 = 0, len; size_t rbase = 0;
      if (c >= 0) geom(c, o0, len, rbase);
      const float* bbase = buf + (c & 1) * 32 * 384;
      u16* yp = p.Yrw + ((size_t)d * NTOK + rbase + o0) * 512 + hd * 64 + vrow;
#pragma unroll 1
      for (int part = 0; part < 3; ++part) {
        if (c >= 0) {
          const int s0 = part == 0 ? 0 : part == 1 ? 12 : 22, s1 = part == 0 ? 12 : part == 1 ? 22 : 32;
          f32x4 A[5], Bq[5];
          f32x2 va, vb;
          auto ldstep = [&](int s, f32x4 (&R)[5], f32x2& vv) {
            const int i = d ? 31 - s : s;
            const float* t = bbase + i * 384 + 4 * kq;
#pragma unroll
            for (int q = 0; q < 5; ++q) R[q] = *(const f32x4*)(t + 64 * q);
            vv = *(const f32x2*)(bbase + i * 384 + 320 + vrow);
          };
          auto step = [&](const f32x4 (&R)[5], f32x2 vv, int s) {
            const int i = d ? 31 - s : s;
            float sa0 = (S0[0] * R[3][0] + S0[1] * R[3][1]) + (S0[2] * R[3][2] + S0[3] * R[3][3]);
            float sa1 = (S1[0] * R[3][0] + S1[1] * R[3][1]) + (S1[2] * R[3][2] + S1[3] * R[3][3]);
            sa0 = sum16(sa0); sa1 = sum16(sa1);
            float y0 = 0.f, y1 = 0.f;
#pragma unroll
            for (int k = 0; k < 4; ++k) {
              S0[k] = S0[k] * R[1][k] + (sa0 * R[4][k] + vv[0] * R[2][k]);
              S1[k] = S1[k] * R[1][k] + (sa1 * R[4][k] + vv[1] * R[2][k]);
              y0 += S0[k] * R[0][k]; y1 += S1[k] * R[0][k];
            }
            y0 = sum16(y0); y1 = sum16(y1);
            if (kq == 0) *(unsigned*)(yp + (size_t)i * 512) = pk2(y0, y1);
          };
          ldstep(s0, A, va);
          for (int s = s0; s < s1; s += 2) {
            ldstep(s + 1, Bq, vb);
            step(A, va, s);
            if (s + 2 < s1) ldstep(s + 2, A, va);
            step(Bq, vb, s + 1);
          }
        }
        __syncthreads();
      }
    }
  }
}

DI void merge_phase(const KP& p, int layer, int M) {
  const int lane = otid() & 63, w = otid() >> 6;
  const float* mu0 = p.mu + (size_t)layer * 2 * 1792;
  const float* mu1 = mu0 + 1792;
  for (int row = obid() * 8 + w; row < M; row += gridDim.x * 8) {
    const int ch0 = lane * 8;
    {
      float y0[8], y1[8], y[8];
      unpack8(ld8(p.Yret + (size_t)row * 512 + ch0), y0);
      unpack8(ld8(p.Yret + ((size_t)NTOK + row) * 512 + ch0), y1);
      float s = 0.f;
#pragma unroll
      for (int j = 0; j < 8; ++j) { y[j] = y0[j] + y1[j]; s += y[j]; }
      s += __shfl_xor(s, 1); s += __shfl_xor(s, 2); s += __shfl_xor(s, 4); s += __shfl_xor(s, 8);
      const float mean = s * (1.f / 128.f);
      float v = 0.f;
#pragma unroll
      for (int j = 0; j < 8; ++j) { const float dlt = y[j] - mean; v += dlt * dlt; }
      v += __shfl_xor(v, 1); v += __shfl_xor(v, 2); v += __shfl_xor(v, 4); v += __shfl_xor(v, 8);
      const float rstd = rsqrtf(v * (1.f / 128.f) + 1e-5f);
      float gt[8], o[8];
      unpack8(ld8(p.P + (size_t)row * NIN + 1536 + ch0), gt);
#pragma unroll
      for (int j = 0; j < 8; ++j) o[j] = (y[j] - mean) * rstd * p.ret_gn[layer * 512 + ch0 + j] * silu(gt[j]);
      *(bf16x8*)(p.H + (size_t)row * DM + ch0) = pack8(o);
    }
    {
      float y0[8], y1[8], y[8];
      unpack8(ld8(p.Yrw + (size_t)row * 512 + ch0), y0);
      unpack8(ld8(p.Yrw + ((size_t)NTOK + row) * 512 + ch0), y1);
      float s = 0.f;
#pragma unroll
      for (int j = 0; j < 8; ++j) { y[j] = y0[j] + y1[j]; s += y[j]; }
      s += __shfl_xor(s, 1); s += __shfl_xor(s, 2); s += __shfl_xor(s, 4);
      const float mean = s * (1.f / 64.f);
      float v = 0.f;
#pragma unroll
      for (int j = 0; j < 8; ++j) { const float dlt = y[j] - mean; v += dlt * dlt; }
      v += __shfl_xor(v, 1); v += __shfl_xor(v, 2); v += __shfl_xor(v, 4);
      const float rstd = rsqrtf(v * (1.f / 64.f) + 64e-5f);
      int o, len;
      if (row < NLAT) { o = row & 4095; len = 4096; } else { o = (row - NLAT) & 255; len = 256; }
      float f[3][8];
#pragma unroll
      for (int g = 0; g < 3; ++g) {
        const int col = 3904 + 512 * g + ch0;
        const u16* src = p.P + (size_t)row * NIN + col;
        float cur[8], prv[8], nxt[8];
        unpack8(ld8(src), cur);
        if (o > 0) unpack8(ld8(src - NIN), prv); else { for (int j = 0; j < 8; ++j) prv[j] = 0.f; }
        if (o < len - 1) unpack8(ld8(src + NIN), nxt); else { for (int j = 0; j < 8; ++j) nxt[j] = 0.f; }
#pragma unroll
        for (int j = 0; j < 8; ++j) {
          const float m0v = mu0[col - 3904 + j], m1v = mu1[col - 3904 + j];
          f[g][j] = cur[j] + m0v * (prv[j] - cur[j]) + m1v * (nxt[j] - cur[j]);
        }
      }
      float rk = 0.f;
#pragma unroll
      for (int j = 0; j < 8; ++j) rk += f[0][j] * f[1][j] * p.r_k[layer * 512 + ch0 + j];
      rk += __shfl_xor(rk, 1); rk += __shfl_xor(rk, 2); rk += __shfl_xor(rk, 4);
      float gt[8], ov[8];
      unpack8(ld8(p.P + (size_t)row * NIN + 5696 + ch0), gt);
#pragma unroll
      for (int j = 0; j < 8; ++j)
        ov[j] = ((y[j] - mean) * rstd * p.rw_gn[layer * 512 + ch0 + j] + rk * f[2][j]) * silu(gt[j]);
      *(bf16x8*)(p.H + (size_t)row * DM + 1536 + ch0) = pack8(ov);
    }
  }
}

DI void ln_phase(const KP& p, int layer, int M) {
  const int lane = otid() & 63, w = otid() >> 6;
  const float* g = p.ln_g + layer * DM;
  const float* bb_ = p.ln_b + layer * DM;
  for (int row = obid() * 8 + w; row < M; row += gridDim.x * 8) {
    float* ptr = row < NLAT ? p.out + (size_t)row * DM : p.X1c + (size_t)(row - NLAT) * DM;
    f32x4 v[8];
    float s = 0.f;
#pragma unroll
    for (int i = 0; i < 8; ++i) { v[i] = *(const f32x4*)(ptr + (i * 64 + lane) * 4); s += v[i][0] + v[i][1] + v[i][2] + v[i][3]; }
#pragma unroll
    for (int o = 1; o < 64; o <<= 1) s += __shfl_xor(s, o);
    const float mean = s * (1.f / 2048.f);
    float q = 0.f;
#pragma unroll
    for (int i = 0; i < 8; ++i)
#pragma unroll
      for (int j = 0; j < 4; ++j) { const float dlt = v[i][j] - mean; q += dlt * dlt; }
#pragma unroll
    for (int o = 1; o < 64; o <<= 1) q += __shfl_xor(q, o);
    const float rstd = rsqrtf(q * (1.f / 2048.f) + 1e-5f);
    const int bidx = row < NLAT ? (row >> 12) : 4;
    const float* md = p.mod + ((size_t)5 + bidx) * 6144;
#pragma unroll
    for (int i = 0; i < 8; ++i) {
      const int c = (i * 64 + lane) * 4;
      f32x4 gg = *(const f32x4*)(g + c), bbv = *(const f32x4*)(bb_ + c), y;
#pragma unroll
      for (int j = 0; j < 4; ++j) y[j] = (v[i][j] - mean) * rstd * gg[j] + bbv[j];
      *(f32x4*)(ptr + c) = y;
      if (layer == 0) {
        f32x4 sh = *(const f32x4*)(md + c), scl = *(const f32x4*)(md + 2048 + c);
        u32x2 o;
        o[0] = pk2(y[0] * (1.f + scl[0]) + sh[0], y[1] * (1.f + scl[1]) + sh[1]);
        o[1] = pk2(y[2] * (1.f + scl[2]) + sh[2], y[3] * (1.f + scl[3]) + sh[3]);
        *(u32x2*)(p.H + (size_t)row * DM + c) = o;
      }
    }
  }
}

__global__ void __launch_bounds__(NTHR) hybrid_block_megakernel(KP p) {
  extern __shared__ __attribute__((aligned(16))) char smem[];
  cg::grid_group grid = cg::this_grid();
  __shared__ int s_item;
  const int tid = otid();

  if (obid() == 0 && tid < 8) p.cnt[tid] = 0u;
  mod_phase(p, smem);
  convert_weights(p, 0, smem);
  grid.sync();
  h0_phase(p);
  grid.sync();

  for (int layer = 0; layer < 2; ++layer) {
    const int Mq = layer == 0 ? NTOK : NLAT;
    for (int it = obid(); it < 68 * 49; it += gridDim.x) {
      const int nt = it / 68, mt = it % 68;
      gemm_tile(p, 0, layer, mt * 256, nt * 128, smem);
    }
    grid.sync();
    {
      const int n_uq = (Mq / 256) * 12, n_ukv = 68 * 16, n_kr = NTOK / 8;
      for (int it = obid(); it < n_uq + n_ukv + n_kr; it += gridDim.x) {
        if (it < n_uq) gemm_tile(p, 1, layer, (it / 12) * 256, (it % 12) * 128, smem);
        else if (it < n_uq + n_ukv) { const int i = it - n_uq; gemm_tile(p, 2, layer, (i / 16) * 256, (i % 16) * 128, smem); }
        else krope_item(p, it - n_uq - n_ukv);
      }
    }
    grid.sync();
    {
      for (int ch = obid(); ch < 160; ch += gridDim.x) {
        if (ch < 128) rwkv_chain(p, layer, ch, smem); else ret_chain(p, layer, ch - 128, smem);
      }
      const int n_att = layer == 0 ? 512 + 32 : 512;
      while (true) {
        __syncthreads();
        if (tid == 0) s_item = (int)atomicAdd(&p.cnt[layer], 1u);
        __syncthreads();
        const int it = s_item;
        if (it >= n_att) break;
        if (it < 512) {
          const int b = it >> 7, hd = (it >> 4) & 7, qb = it & 15;
          attn_item(p, b * 4096 + qb * 256, b, hd, LPOS, smem);
        } else {
          const int i = it - 512, b = i >> 3, hd = i & 7;
          attn_item(p, NLAT + b * 256, b, hd, 256, smem);
        }
      }
    }
    grid.sync();
    merge_phase(p, layer, Mq);
    grid.sync();
    for (int it = obid(); it < (Mq / 256) * 16; it += gridDim.x) {
      const int nt = it % 16, mt = it / 16;
      gemm_tile(p, 3, layer, mt * 256, nt * 128, smem);
    }
    grid.sync();
    ln_phase(p, layer, Mq);
    if (layer == 0) {
      convert_weights(p, 1, smem);
      grid.sync();
    }
  }
}

extern "C" void kernel_launch(void* const* d_in, const int* in_sizes, int n_in, void* d_out, int out_size, void* d_ws,
                              size_t ws_size, hipStream_t stream) {
  static int grid_blocks = 0;
  if (!grid_blocks) {
    int dev = 0, cus = 0, per_cu = 0;
    hipGetDevice(&dev);
    hipDeviceGetAttribute(&cus, hipDeviceAttributeMultiprocessorCount, dev);
    hipFuncSetAttribute((const void*)hybrid_block_megakernel, hipFuncAttributeMaxDynamicSharedMemorySize, (int)LDS_BYTES);
    hipOccupancyMaxActiveBlocksPerMultiprocessor(&per_cu, hybrid_block_megakernel, NTHR, LDS_BYTES);
    if (per_cu > 1) per_cu = 1;
    grid_blocks = cus * per_cu;
  }
  KP p{};
  const float* const* in = (const float* const*)d_in;
  p.x = in[0]; p.c = in[1]; p.ctx = in[2]; p.c_ctx = in[3]; p.w_ada = in[4]; p.b_ada = in[5]; p.w_in = in[6];
  p.ret_logit = in[7]; p.ret_gn = in[8]; p.q_g = in[9]; p.w_uq = in[10]; p.kv_g = in[11]; p.w_ukv = in[12]; p.mu = in[13];
  p.w0 = in[14]; p.w2 = in[15]; p.a0 = in[16]; p.a2 = in[17]; p.k_k = in[18]; p.k_a = in[19]; p.r_k = in[20]; p.rw_gn = in[21];
  p.w_out = in[22]; p.ln_g = in[23]; p.ln_b = in[24];
  p.out = (float*)d_out;
  char* ws = (char*)d_ws;
  size_t off = 0;
  auto take = [&](size_t bytes) { char* r = ws + off; off += (bytes + 255) & ~(size_t)255; return r; };
  p.P = (u16*)take((size_t)NTOK * NIN * 2);
  p.H = (u16*)take((size_t)NTOK * DM * 2);
  p.Q = (u16*)take((size_t)NTOK * 1536 * 2);
  p.Kn = (u16*)take((size_t)4 * 8 * LPOS * 128 * 2);
  p.Vt = (u16*)take((size_t)4 * 8 * 128 * LPOS * 2);
  p.Kr = (u16*)take((size_t)4 * LPOS * 64 * 2);
  p.Yret = (u16*)take((size_t)2 * NTOK * 512 * 2);
  p.Yrw = (u16*)take((size_t)2 * NTOK * 512 * 2);
  p.WinT = (u16*)take((size_t)NIN * DM * 2);
  p.WuqT = (u16*)take((size_t)1536 * 512 * 2);
  p.WukvT = (u16*)take((size_t)2048 * 256 * 2);
  p.WoutT = (u16*)take((size_t)DM * DM * 2);
  p.W2T = (u16*)take((size_t)2 * 512 * 64 * 2);
  p.A2T = (u16*)take((size_t)2 * 512 * 64 * 2);
  p.X1c = (float*)take((size_t)1024 * DM * 4);
  p.mod = (float*)take((size_t)2 * 5 * 6144 * 4);
  p.cnt = (unsigned*)take(256);
  if (off > ws_size) { fprintf(stderr, "workspace too small: need %zu have %zu\n", off, ws_size); return; }
  void* args[] = {&p};
  hipError_t e = hipLaunchCooperativeKernel((void*)hybrid_block_megakernel, dim3(grid_blocks), dim3(NTHR), args, LDS_BYTES, stream);
  if (e != hipSuccess) fprintf(stderr, "cooperative launch failed: %s (grid %d)\n", hipGetErrorString(e), grid_blocks);
}
```

```cpp
#include <hip/hip_runtime.h>
#include <hip/hip_cooperative_groups.h>
#include <cstdio>
namespace cg = cooperative_groups;

#define DI __device__ __forceinline__
typedef unsigned short u16;
using bf16x8 = __attribute__((ext_vector_type(8))) short;
using s16x4 = __attribute__((ext_vector_type(4))) short;
using f32x16 = __attribute__((ext_vector_type(16))) float;
using f32x4 = __attribute__((ext_vector_type(4))) float;
using u32x4 = __attribute__((ext_vector_type(4))) unsigned;
using u32x2 = __attribute__((ext_vector_type(2))) unsigned;
using f32x2 = __attribute__((ext_vector_type(2))) float;
#define MFMA(a, b, c) __builtin_amdgcn_mfma_f32_32x32x16_bf16((a), (b), (c), 0, 0, 0)

constexpr int DM = 2048, NIN = 6208, NLAT = 16384, NTOK = 17408, LPOS = 4352;
constexpr int NTHR = 512;
constexpr size_t LDS_BYTES = 149504;
constexpr float ALPHA = 1.4142135623730951f;
constexpr float QSCALE = 0.07216878364870323f * 1.4426950408889634f;

struct KP {
  const float *x, *c, *ctx, *c_ctx, *w_ada, *b_ada, *w_in, *ret_logit, *ret_gn, *q_g, *w_uq, *kv_g, *w_ukv, *mu, *w0, *w2, *a0,
      *a2, *k_k, *k_a, *r_k, *rw_gn, *w_out, *ln_g, *ln_b;
  float* out;
  u16 *P, *H, *Q, *Kn, *Vt, *Kr, *Yret, *Yrw, *WinT, *WuqT, *WukvT, *WoutT, *W2T, *A2T;
  float *X1c, *mod;
  unsigned* cnt;
};

DI int otid() { int t = threadIdx.x; asm volatile("" : "+v"(t)); return t; }
DI int obid() { int t = blockIdx.x; asm volatile("" : "+s"(t)); return t; }
template <int CTRL> DI float dppf(float v) {
  return __builtin_bit_cast(float, __builtin_amdgcn_update_dpp(0, __builtin_bit_cast(int, v), CTRL, 0xf, 0xf, true));
}
DI float sum8(float x) { x += dppf<0xB1>(x); x += dppf<0x4E>(x); x += dppf<0x141>(x); return x; }
DI float sum16(float x) { x += dppf<0xB1>(x); x += dppf<0x4E>(x); x += dppf<0x141>(x); x += dppf<0x140>(x); return x; }
DI float bf2f(u16 v) { return __uint_as_float(((unsigned)v) << 16); }
DI float bflo(unsigned v) { return __uint_as_float(v << 16); }
DI float bfhi(unsigned v) { return __uint_as_float(v & 0xffff0000u); }
DI u16 f2bf(float a) { __bf16 r = (__bf16)a; return __builtin_bit_cast(u16, r); }
DI unsigned pk2(float a, float b) {
  typedef __bf16 bf2 __attribute__((ext_vector_type(2)));
  typedef float f2 __attribute__((ext_vector_type(2)));
  f2 v = {a, b};
  bf2 r = __builtin_convertvector(v, bf2);
  return __builtin_bit_cast(unsigned, r);
}
DI int crow(int reg, int h) { return (reg & 3) + 8 * (reg >> 2) + 4 * h; }
DI float silu(float x) { return x / (1.f + __expf(-x)); }
DI void unpack8(const bf16x8& v, float* f) {
  u32x4 u = __builtin_bit_cast(u32x4, v);
#pragma unroll
  for (int i = 0; i < 4; ++i) { f[2 * i] = bflo(u[i]); f[2 * i + 1] = bfhi(u[i]); }
}
DI bf16x8 pack8(const float* f) {
  u32x4 u;
#pragma unroll
  for (int i = 0; i < 4; ++i) u[i] = pk2(f[2 * i], f[2 * i + 1]);
  return __builtin_bit_cast(bf16x8, u);
}
DI bf16x8 ld8(const u16* p) { return *(const bf16x8*)p; }
DI bf16x8 zero8() { bf16x8 z = {0, 0, 0, 0, 0, 0, 0, 0}; return z; }
DI f32x16 zero16() { f32x16 z; for (int i = 0; i < 16; ++i) z[i] = 0.f; return z; }
DI s16x4 trread(const u16* p) {
  return __builtin_amdgcn_ds_read_tr16_b64_v4i16((s16x4 __attribute__((address_space(3)))*)(p));
}
DI bf16x8 cat4(s16x4 lo, s16x4 hi) { return __builtin_shufflevector(lo, hi, 0, 1, 2, 3, 4, 5, 6, 7); }
DI void rope_cs(int pos, int i, float& cs, float& sn) {
  float inv = exp2f(-(float)i * (13.287712379549449f / 16.f));
  float rev = (float)pos * inv * 0.15915494309189535f;
  rev -= floorf(rev);
  cs = __builtin_amdgcn_cosf(rev);
  sn = __builtin_amdgcn_sinf(rev);
}

DI void transpose_item(const float* src, u16* dst, int K, int N, int kt, int nt, char* smem) {
  float* tile = (float*)smem;
  const int tid = otid();
  __syncthreads();
  {
    const int kk = tid >> 4, n4 = tid & 15;
#pragma unroll
    for (int i = 0; i < 2; ++i) {
      const int k = kk + 32 * i;
      f32x4 v = *(const f32x4*)(src + (size_t)(kt * 64 + k) * N + nt * 64 + n4 * 4);
      tile[k * 65 + n4 * 4 + 0] = v[0]; tile[k * 65 + n4 * 4 + 1] = v[1];
      tile[k * 65 + n4 * 4 + 2] = v[2]; tile[k * 65 + n4 * 4 + 3] = v[3];
    }
  }
  __syncthreads();
  {
    const int n = tid >> 3, k8 = tid & 7;
    float f[8];
#pragma unroll
    for (int j = 0; j < 8; ++j) f[j] = tile[(k8 * 8 + j) * 65 + n];
    *(bf16x8*)(dst + (size_t)(nt * 64 + n) * K + kt * 64 + k8 * 8) = pack8(f);
  }
}

DI void convert_weights(const KP& p, int layer, char* smem) {
  const int n_in = 32 * 97, n_uq = 8 * 24, n_ukv = 4 * 32, n_out = 32 * 32, n_lora = 8;
  const int total = n_in + n_uq + n_ukv + n_out + 4 * n_lora;
  for (int it = obid(); it < total; it += gridDim.x) {
    int i = it;
    if (i < n_in) { transpose_item(p.w_in + (size_t)layer * DM * NIN, p.WinT, DM, NIN, i / 97, i % 97, smem); continue; }
    i -= n_in;
    if (i < n_uq) { transpose_item(p.w_uq + (size_t)layer * 512 * 1536, p.WuqT, 512, 1536, i / 24, i % 24, smem); continue; }
    i -= n_uq;
    if (i < n_ukv) { transpose_item(p.w_ukv + (size_t)layer * 256 * 2048, p.WukvT, 256, 2048, i / 32, i % 32, smem); continue; }
    i -= n_ukv;
    if (i < n_out) { transpose_item(p.w_out + (size_t)layer * DM * DM, p.WoutT, DM, DM, i / 32, i % 32, smem); continue; }
    i -= n_out;
    {
      const int which = i / (2 * n_lora), r = i % (2 * n_lora), d = r / n_lora, nt = r % n_lora;
      const float* src = (which ? p.a2 : p.w2) + ((size_t)layer * 2 + d) * 64 * 512;
      u16* dst = (which ? p.A2T : p.W2T) + (size_t)d * 512 * 64;
      transpose_item(src, dst, 64, 512, 0, nt, smem);
    }
  }
}

DI void mod_phase(const KP& p, char* smem) {
  float* sc = (float*)smem;
  float* red = sc + 5 * 2048;
  const int tid = otid();
  __syncthreads();
  for (int i = tid; i < 5 * 2048; i += NTHR) {
    float v = i < 4 * 2048 ? p.c[i] : p.c_ctx[i - 4 * 2048];
    sc[i] = silu(v);
  }
  __syncthreads();
  const int kg = tid >> 5, col = tid & 31;
  for (int it = obid(); it < 384; it += gridDim.x) {
    const int layer = it / 192, j = (it % 192) * 32 + col;
    const float* w = p.w_ada + (size_t)layer * DM * 6144 + j;
    float acc[5] = {0.f, 0.f, 0.f, 0.f, 0.f};
    for (int k = kg * 128; k < kg * 128 + 128; ++k) {
      float wv = w[(size_t)k * 6144];
#pragma unroll
      for (int r = 0; r < 5; ++r) acc[r] += sc[r * 2048 + k] * wv;
    }
#pragma unroll
    for (int r = 0; r < 5; ++r) red[(kg * 5 + r) * 32 + col] = acc[r];
    __syncthreads();
    if (tid < 160) {
      const int r = tid >> 5;
      float s = p.b_ada[(size_t)layer * 6144 + j];
      for (int g = 0; g < 16; ++g) s += red[(g * 5 + r) * 32 + col];
      p.mod[((size_t)layer * 5 + r) * 6144 + j] = s;
    }
    __syncthreads();
  }
}

DI void h0_phase(const KP& p) {
  const int lane = otid() & 63, w = otid() >> 6;
  for (int row = obid() * 8 + w; row < NTOK; row += gridDim.x * 8) {
    const float* src = row < NLAT ? p.x + (size_t)row * DM : p.ctx + (size_t)(row - NLAT) * DM;
    const int bb = row < NLAT ? (row >> 12) : 4;
    const float* md = p.mod + (size_t)bb * 6144;
#pragma unroll
    for (int i = 0; i < 8; ++i) {
      const int c = (i * 64 + lane) * 4;
      f32x4 v = *(const f32x4*)(src + c), sh = *(const f32x4*)(md + c), scl = *(const f32x4*)(md + 2048 + c);
      u32x2 o;
      o[0] = pk2(v[0] * (1.f + scl[0]) + sh[0], v[1] * (1.f + scl[1]) + sh[1]);
      o[1] = pk2(v[2] * (1.f + scl[2]) + sh[2], v[3] * (1.f + scl[3]) + sh[3]);
      *(u32x2*)(p.H + (size_t)row * DM + c) = o;
    }
  }
}

DI void gemm_tile(const KP& p, int mode, int layer, int m0, int n0, char* smem) {
  constexpr int STG = 512 * 72;
  u16* base = (u16*)smem;
  float* rs = (float*)(base + 2 * STG);
  const int tid = otid(), lane = tid & 63, w = tid >> 6, wm = w >> 2, wn = w & 3, l31 = lane & 31, h = lane >> 5;
  const u16* A; const u16* Bt; const float* gv = nullptr; int lda, K, N;
  if (mode == 0) { A = p.H; lda = DM; K = DM; N = NIN; Bt = p.WinT; }
  else if (mode == 1) { A = p.P + 2048; lda = NIN; K = 512; N = 1536; Bt = p.WuqT; gv = p.q_g + layer * 512; }
  else if (mode == 2) { A = p.P + 2560; lda = NIN; K = 256; N = 2048; Bt = p.WukvT; gv = p.kv_g + layer * 256; }
  else { A = p.H; lda = DM; K = DM; N = DM; Bt = p.WoutT; }
  const bool xf = (mode == 1 || mode == 2);
  const bool active = (n0 + wn * 64) < N;
  __syncthreads();
  if (xf) {
    const int r = tid >> 1, part = tid & 1;
    const u16* src = A + (size_t)(m0 + r) * lda + part * (K >> 1);
    float ss = 0.f;
    for (int i = 0; i < (K >> 1); i += 8) {
      float f[8]; unpack8(ld8(src + i), f);
#pragma unroll
      for (int j = 0; j < 8; ++j) ss += f[j] * f[j];
    }
    ss += __shfl_xor(ss, 1);
    if (!part) rs[r] = rsqrtf(ss / (float)K + 1e-6f);
    __syncthreads();
  }
  f32x16 acc[4][2];
#pragma unroll
  for (int i = 0; i < 4; ++i)
#pragma unroll
    for (int j = 0; j < 2; ++j) acc[i][j] = zero16();
  bf16x8 ra[4], rb[4];
  const int arow = tid >> 3, ac = tid & 7;
  auto loadg = [&](int k0) {
#pragma unroll
    for (int i = 0; i < 4; ++i) {
      const int row = arow + 64 * i;
      bf16x8 v = ld8(A + (size_t)(m0 + row) * lda + k0 + ac * 8);
      if (xf) {
        float f[8]; unpack8(v, f);
        const float sc = rs[row];
        f32x4 g0 = *(const f32x4*)(gv + k0 + ac * 8), g1 = *(const f32x4*)(gv + k0 + ac * 8 + 4);
#pragma unroll
        for (int j = 0; j < 4; ++j) { f[j] *= sc * g0[j]; f[4 + j] *= sc * g1[j]; }
        v = pack8(f);
      }
      ra[i] = v;
    }
#pragma unroll
    for (int i = 0; i < 4; ++i) {
      int nrow = n0 + arow + 64 * i;
      nrow = nrow < N ? nrow : N - 1;
      rb[i] = ld8(Bt + (size_t)nrow * K + k0 + ac * 8);
    }
  };
  auto stage = [&](int buf) {
    u16* As = base + buf * STG;
    u16* Bs = As + 256 * 72;
#pragma unroll
    for (int i = 0; i < 4; ++i) *(bf16x8*)(As + (arow + 64 * i) * 72 + ac * 8) = ra[i];
#pragma unroll
    for (int i = 0; i < 4; ++i) *(bf16x8*)(Bs + (arow + 64 * i) * 72 + ac * 8) = rb[i];
  };
  loadg(0);
  stage(0);
  __syncthreads();
  const int nk = K >> 6;
  for (int kt = 0; kt < nk; ++kt) {
    const u16* As = base + (kt & 1) * STG;
    const u16* Bs = As + 256 * 72;
    if (kt + 1 < nk) loadg((kt + 1) * 64);
    if (active) {
#pragma unroll
      for (int ks = 0; ks < 4; ++ks) {
        bf16x8 bfr[2], afr[4];
#pragma unroll
        for (int ni = 0; ni < 2; ++ni) bfr[ni] = ld8(Bs + (wn * 64 + ni * 32 + l31) * 72 + ks * 16 + h * 8);
#pragma unroll
        for (int mi = 0; mi < 4; ++mi) afr[mi] = ld8(As + (wm * 128 + mi * 32 + l31) * 72 + ks * 16 + h * 8);
#pragma unroll
        for (int mi = 0; mi < 4; ++mi)
#pragma unroll
          for (int ni = 0; ni < 2; ++ni) acc[mi][ni] = MFMA(afr[mi], bfr[ni], acc[mi][ni]);
      }
    }
    if (kt + 1 < nk) stage((kt + 1) & 1);
    __syncthreads();
  }
#pragma unroll
  for (int mi = 0; mi < 4; ++mi)
#pragma unroll
    for (int ni = 0; ni < 2; ++ni) {
      const int cb = n0 + wn * 64 + ni * 32;
      if (cb >= N) continue;
      const int col = cb + l31;
      const int rb0 = m0 + wm * 128 + mi * 32;
      const f32x16& a = acc[mi][ni];
      if (mode == 0) {
#pragma unroll
        for (int r = 0; r < 16; ++r) p.P[(size_t)(rb0 + crow(r, h)) * NIN + col] = f2bf(a[r]);
      } else if (mode == 1) {
        const int dd = cb % 192;
        const bool rope = (dd >= 128) && (rb0 < NLAT);
        const int part = (dd - 128) >> 5;
#pragma unroll
        for (int r = 0; r < 16; ++r) {
          const int row = rb0 + crow(r, h);
          float v = a[r] * QSCALE;
          if (rope) {
            const int t = row & 4095;
            const int pos = part ? (t & 63) : (t >> 6);
            float cs, sn; rope_cs(pos, l31 & 15, cs, sn);
            const float pr = __shfl_xor(v, 16);
            v = (l31 < 16) ? (v * cs - pr * sn) : (v * cs + pr * sn);
          }
          p.Q[(size_t)row * 1536 + col] = f2bf(v);
        }
      } else if (mode == 2) {
        const int head = col >> 8, dd = col & 255;
#pragma unroll
        for (int g = 0; g < 4; ++g) {
          const int row = rb0 + 8 * g + 4 * h;
          int b, pos;
          if (row < NLAT) { b = row >> 12; pos = 256 + (row & 4095); } else { b = (row - NLAT) >> 8; pos = (row - NLAT) & 255; }
          if (dd < 128) {
#pragma unroll
            for (int j = 0; j < 4; ++j) p.Kn[((size_t)(b * 8 + head) * LPOS + pos + j) * 128 + dd] = f2bf(a[4 * g + j]);
          } else {
            u32x2 o; o[0] = pk2(a[4 * g], a[4 * g + 1]); o[1] = pk2(a[4 * g + 2], a[4 * g + 3]);
            *(u32x2*)(p.Vt + ((size_t)(b * 8 + head) * 128 + (dd - 128)) * LPOS + pos) = o;
          }
        }
      } else {
#pragma unroll
        for (int r = 0; r < 16; ++r) {
          const int row = rb0 + crow(r, h);
          const int bb = row < NLAT ? (row >> 12) : 4;
          const float gate = p.mod[((size_t)layer * 5 + bb) * 6144 + 4096 + col];
          float xv;
          float* dst;
          if (row < NLAT) {
            dst = p.out + (size_t)row * DM + col;
            xv = layer == 0 ? p.x[(size_t)row * DM + col] : *dst;
          } else {
            dst = p.X1c + (size_t)(row - NLAT) * DM + col;
            xv = p.ctx[(size_t)(row - NLAT) * DM + col];
          }
          *dst = ALPHA * xv + gate * a[r];
        }
      }
    }
}

DI void krope_item(const KP& p, int it) {
  const int tid = otid(), tok = tid >> 6, dim = tid & 63;
  const int row = it * 8 + tok;
  const u16* src = p.P + (size_t)row * NIN + 2816;
  float v = bf2f(src[dim]);
  int b, pos;
  if (row < NLAT) {
    const float pr = bf2f(src[dim ^ 16]);
    const int t = row & 4095, part = dim >> 5;
    const int ps = part ? (t & 63) : (t >> 6);
    float cs, sn; rope_cs(ps, dim & 15, cs, sn);
    v = ((dim & 31) < 16) ? (v * cs - pr * sn) : (v * cs + pr * sn);
    b = row >> 12; pos = 256 + t;
  } else { b = (row - NLAT) >> 8; pos = (row - NLAT) & 255; }
  p.Kr[((size_t)b * LPOS + pos) * 64 + dim] = f2bf(v);
}

DI void attn_item(const KP& p, int qrow0, int b, int hd, int nkeys, char* smem) {
  constexpr int STG = 64 * 200 + 128 * 72;
  u16* base = (u16*)smem;
  const int tid = otid(), lane = tid & 63, w = tid >> 6, l31 = lane & 31, h = lane >> 5;
  const int qrow = qrow0 + 32 * w + l31;
  bf16x8 qf[12];
  {
    const u16* qp = p.Q + (size_t)qrow * 1536 + hd * 192 + 8 * h;
#pragma unroll
    for (int ks = 0; ks < 12; ++ks) qf[ks] = ld8(qp + 16 * ks);
  }
  f32x16 o[4];
#pragma unroll
  for (int i = 0; i < 4; ++i) o[i] = zero16();
  float m = -1e30f, lsum = 0.f;
  const u16* kn = p.Kn + (size_t)(b * 8 + hd) * LPOS * 128;
  const u16* kr = p.Kr + (size_t)b * LPOS * 64;
  const u16* vt = p.Vt + (size_t)(b * 8 + hd) * 128 * LPOS;
  int kkey[3], kc[3];
#pragma unroll
  for (int i = 0; i < 3; ++i) { const int idx = tid + NTHR * i; kkey[i] = idx / 24; kc[i] = idx % 24; }
  bf16x8 rk[3], rv[2];
  auto loadg = [&](int kt0) {
#pragma unroll
    for (int i = 0; i < 3; ++i) {
      const u16* src = kc[i] < 16 ? kn + (size_t)(kt0 + kkey[i]) * 128 + kc[i] * 8 : kr + (size_t)(kt0 + kkey[i]) * 64 + (kc[i] - 16) * 8;
      rk[i] = ld8(src);
    }
#pragma unroll
    for (int i = 0; i < 2; ++i) {
      const int idx = tid + NTHR * i, dd = idx >> 3, c = idx & 7;
      rv[i] = ld8(vt + (size_t)dd * LPOS + kt0 + c * 8);
    }
  };
  auto stage = [&](int buf) {
    u16* Ksm = base + buf * STG;
    u16* Vsm = Ksm + 64 * 200;
#pragma unroll
    for (int i = 0; i < 3; ++i) *(bf16x8*)(Ksm + kkey[i] * 200 + kc[i] * 8) = rk[i];
#pragma unroll
    for (int i = 0; i < 2; ++i) {
      const int idx = tid + NTHR * i, dd = idx >> 3, c = idx & 7;
      u32x4 u = __builtin_bit_cast(u32x4, rv[i]);
      u32x2 lo = {u[0], u[1]}, hi = {u[2], u[3]};
      u16* dst = Vsm + dd * 72 + 16 * (c >> 1) + 4 * (c & 1);
      *(u32x2*)dst = lo;
      *(u32x2*)(dst + 8) = hi;
    }
  };
  __syncthreads();
  loadg(0);
  stage(0);
  __syncthreads();
  const int ntile = nkeys >> 6;
  for (int t = 0; t < ntile; ++t) {
    const u16* Ksm = base + (t & 1) * STG;
    const u16* Vsm = Ksm + 64 * 200;
    if (t + 1 < ntile) loadg((t + 1) * 64);
    f32x16 s[2];
#pragma unroll
    for (int kt = 0; kt < 2; ++kt) {
      s[kt] = zero16();
#pragma unroll
      for (int ks = 0; ks < 12; ++ks) {
        bf16x8 a = ld8(Ksm + (kt * 32 + l31) * 200 + ks * 16 + h * 8);
        s[kt] = MFMA(a, qf[ks], s[kt]);
        if ((ks & 3) == 3) asm volatile("" ::: "memory");
      }
    }
    float mx = s[0][0];
#pragma unroll
    for (int r = 0; r < 16; ++r) { mx = fmaxf(mx, s[0][r]); mx = fmaxf(mx, s[1][r]); }
    mx = fmaxf(mx, __shfl_xor(mx, 32));
    const float mnew = fmaxf(m, mx);
    const float alpha = __builtin_amdgcn_exp2f(m - mnew);
    m = mnew;
    float ps = 0.f;
#pragma unroll
    for (int kt = 0; kt < 2; ++kt)
#pragma unroll
      for (int r = 0; r < 16; ++r) { float e = __builtin_amdgcn_exp2f(s[kt][r] - mnew); s[kt][r] = e; ps += e; }
    lsum = lsum * alpha + ps;
#pragma unroll
    for (int dt = 0; dt < 4; ++dt)
#pragma unroll
      for (int r = 0; r < 16; ++r) o[dt][r] *= alpha;
#pragma unroll
    for (int kt = 0; kt < 2; ++kt)
#pragma unroll
      for (int sI = 0; sI < 2; ++sI) {
        u32x4 pu;
#pragma unroll
        for (int j = 0; j < 4; ++j) pu[j] = pk2(s[kt][8 * sI + 2 * j], s[kt][8 * sI + 2 * j + 1]);
        const bf16x8 pb = __builtin_bit_cast(bf16x8, pu);
        const int kb = kt * 32 + sI * 16 + 8 * h;
#pragma unroll
        for (int dt = 0; dt < 4; ++dt) o[dt] = MFMA(ld8(Vsm + (dt * 32 + l31) * 72 + kb), pb, o[dt]);
        asm volatile("" ::: "memory");
      }
    if (t + 1 < ntile) stage((t + 1) & 1);
    __syncthreads();
  }
  lsum += __shfl_xor(lsum, 32);
  const float inv = 1.f / lsum;
  const u16* gp = p.P + (size_t)qrow * NIN + 2880 + hd * 128;
  u16* op = p.H + (size_t)qrow * DM + 512 + hd * 128;
#pragma unroll
  for (int dt = 0; dt < 4; ++dt)
#pragma unroll
    for (int g = 0; g < 4; ++g) {
      const int d0 = dt * 32 + 8 * g + 4 * h;
      u32x2 gg = *(const u32x2*)(gp + d0);
      float g0 = bflo(gg[0]), g1 = bfhi(gg[0]), g2 = bflo(gg[1]), g3 = bfhi(gg[1]);
      u32x2 ov;
      ov[0] = pk2(o[dt][4 * g] * inv * silu(g0), o[dt][4 * g + 1] * inv * silu(g1));
      ov[1] = pk2(o[dt][4 * g + 2] * inv * silu(g2), o[dt][4 * g + 3] * inv * silu(g3));
      *(u32x2*)(op + d0) = ov;
    }
}

DI void ret_chain(const KP& p, int layer, int chain, char* smem) {
  const int d = chain >> 4, b = (chain >> 2) & 3, hd = chain & 3;
  u16* Qs = (u16*)smem;
  u16* Ks = Qs + 128 * 136;
  u16* Vs = Ks + 128 * 136;
  u16* Sts = Vs + 128 * 136;
  const int tid = otid(), lane = tid & 63, w = tid >> 6, l31 = lane & 31, h = lane >> 5;
  const int q4 = (lane & 15) >> 2, p4 = lane & 3, blk = (lane >> 4) & 1;
  const float logit = p.ret_logit[(layer * 2 + d) * 4 + hd];
  const float z = -logit;
  const float logg = -(fmaxf(z, 0.f) + log1pf(expf(-fabsf(z))));
  const float lg2 = logg * 1.4426950408889634f;
  const float gC = exp2f(128.f * lg2);
  const float kscale = 0.08838834764831845f;
  const int iw = w & 3, half = w >> 2;
  const int kt = w & 3, vh = w >> 2;
  f32x16 st[2];
  st[0] = zero16(); st[1] = zero16();
  __syncthreads();
  for (int i = tid; i < 128 * 136 / 8; i += NTHR) *(bf16x8*)(Sts + i * 8) = zero8();
  bf16x8 rq[4], rk[4], rv[4];
  const int trow = tid >> 4, tc = tid & 15;
  auto rowbase = [&](int n) -> size_t {
    if (d == 0) return n < 2 ? (size_t)(NLAT + b * 256 + 128 * n) : (size_t)(b * 4096 + 128 * (n - 2));
    return n < 2 ? (size_t)(NLAT + b * 256 + 128 * (1 - n)) : (size_t)(b * 4096 + 128 * (33 - n));
  };
  auto loadg = [&](int n) {
    const size_t rb = rowbase(n);
#pragma unroll
    for (int i = 0; i < 4; ++i) {
      const u16* src = p.P + (rb + trow + 32 * i) * NIN + hd * 128 + tc * 8;
      rq[i] = ld8(src); rk[i] = ld8(src + 512); rv[i] = ld8(src + 1024);
    }
  };
  loadg(0);
  for (int n = 0; n < 34; ++n) {
    const size_t rb = rowbase(n);
#pragma unroll
    for (int i = 0; i < 4; ++i) {
      const int j = trow + 32 * i;
      *(bf16x8*)(Qs + j * 136 + tc * 8) = rq[i];
      *(bf16x8*)(Ks + j * 136 + tc * 8) = rk[i];
      const float zeta = exp2f((d == 0 ? (float)(127 - j) : (float)j) * lg2) * kscale;
      float f[8]; unpack8(rv[i], f);
#pragma unroll
      for (int jj = 0; jj < 8; ++jj) f[jj] *= zeta;
      *(bf16x8*)(Vs + j * 136 + tc * 8) = pack8(f);
    }
    __syncthreads();
    if (n + 1 < 34) loadg(n + 1);
    f32x16 acc[2];
    acc[0] = zero16(); acc[1] = zero16();
    bf16x8 qf[8];
#pragma unroll
    for (int ks = 0; ks < 8; ++ks) qf[ks] = ld8(Qs + (32 * iw + l31) * 136 + 16 * ks + 8 * h);
#pragma unroll
    for (int et = 0; et < 2; ++et)
#pragma unroll
      for (int ks = 0; ks < 8; ++ks) {
        bf16x8 a = ld8(Sts + (32 * (2 * half + et) + l31) * 136 + 16 * ks + 8 * h);
        acc[et] = MFMA(a, qf[ks], acc[et]);
      }
#pragma unroll
    for (int et = 0; et < 2; ++et)
#pragma unroll
      for (int r = 0; r < 16; ++r) acc[et][r] *= gC;
    const int ii = 32 * iw + l31;
#pragma unroll
    for (int jt = 0; jt < 4; ++jt) {
      f32x16 sT = zero16();
#pragma unroll
      for (int ks = 0; ks < 8; ++ks) {
        bf16x8 a = ld8(Ks + (32 * jt + l31) * 136 + 16 * ks + 8 * h);
        sT = MFMA(a, qf[ks], sT);
      }
#pragma unroll
      for (int r = 0; r < 16; ++r) {
        const int j = 32 * jt + crow(r, h);
        const bool keep = d == 0 ? (ii >= j) : (j >= ii);
        sT[r] = keep ? sT[r] : 0.f;
      }
#pragma unroll
      for (int sI = 0; sI < 2; ++sI) {
        u32x4 pu;
#pragma unroll
        for (int j = 0; j < 4; ++j) pu[j] = pk2(sT[8 * sI + 2 * j], sT[8 * sI + 2 * j + 1]);
        const bf16x8 pb = __builtin_bit_cast(bf16x8, pu);
        const int j0 = 32 * jt + 16 * sI + 4 * h;
#pragma unroll
        for (int et = 0; et < 2; ++et) {
          const u16* vp = Vs + (j0 + q4) * 136 + 32 * (2 * half + et) + 16 * blk + 4 * p4;
          s16x4 lo = trread(vp), hi = trread(vp + 8 * 136);
          acc[et] = MFMA(cat4(lo, hi), pb, acc[et]);
        }
      }
    }
    {
      const float rho = exp2f((d == 0 ? (float)(ii - 127) : (float)(-ii)) * lg2);
      u16* yp = p.Yret + ((size_t)d * NTOK + rb + ii) * 512 + hd * 128;
#pragma unroll
      for (int et = 0; et < 2; ++et)
#pragma unroll
        for (int g = 0; g < 4; ++g) {
          const int e0 = 32 * (2 * half + et) + 8 * g + 4 * h;
          u32x2 ov;
          ov[0] = pk2(acc[et][4 * g] * rho, acc[et][4 * g + 1] * rho);
          ov[1] = pk2(acc[et][4 * g + 2] * rho, acc[et][4 * g + 3] * rho);
          *(u32x2*)(yp + e0) = ov;
        }
    }
#pragma unroll
    for (int vi = 0; vi < 2; ++vi)
#pragma unroll
      for (int r = 0; r < 16; ++r) st[vi][r] *= gC;
#pragma unroll
    for (int ks = 0; ks < 8; ++ks) {
      const int jb = 16 * ks + 4 * h + q4;
      const u16* kp = Ks + jb * 136 + 32 * kt + 16 * blk + 4 * p4;
      const bf16x8 a = cat4(trread(kp), trread(kp + 8 * 136));
#pragma unroll
      for (int vi = 0; vi < 2; ++vi) {
        const u16* vp = Vs + jb * 136 + 32 * (2 * vh + vi) + 16 * blk + 4 * p4;
        const bf16x8 bfr = cat4(trread(vp), trread(vp + 8 * 136));
        st[vi] = MFMA(a, bfr, st[vi]);
      }
    }
    __syncthreads();
#pragma unroll
    for (int vi = 0; vi < 2; ++vi)
#pragma unroll
      for (int g = 0; g < 4; ++g) {
        const int v = 32 * (2 * vh + vi) + l31, k0 = 32 * kt + 8 * g + 4 * h;
        u32x2 ov;
        ov[0] = pk2(st[vi][4 * g], st[vi][4 * g + 1]);
        ov[1] = pk2(st[vi][4 * g + 2], st[vi][4 * g + 3]);
        *(u32x2*)(Sts + v * 136 + k0) = ov;
      }
  }
}

DI void rwkv_chain(const KP& p, int layer, int item, char* smem) {
  const int chain = item >> 1, vhalf = item & 1;
  const int d = chain >> 5, b = (chain >> 3) & 3, hd = chain & 7;
  float* buf = (float*)smem;
  u16* twS = (u16*)(smem + 98304);
  u16* alS = twS + 32 * 72;
  const int tid = otid(), lane = tid & 63, w = tid >> 6, l31 = lane & 31, h = lane >> 5;
  auto geom = [&](int cc, int& o0, int& len, size_t& rbase) {
    const int j0 = 32 * cc;
    const bool isctx = j0 < 256;
    len = isctx ? 256 : 4096;
    if (d == 0) o0 = isctx ? j0 : j0 - 256; else o0 = isctx ? (224 - j0) : (4064 - (j0 - 256));
    rbase = isctx ? (size_t)(NLAT + b * 256) : (size_t)(b * 4096);
  };
  __syncthreads();
  if (w >= 4) {
    const int pt = tid - 256;
    const int pw = w - 4, mat = pw >> 1, nh = pw & 1;
    bf16x8 bw[4];
    const int n = hd * 64 + nh * 32 + l31;
    {
      const u16* wT = (mat ? p.A2T : p.W2T) + ((size_t)d * 512 + n) * 64 + 8 * h;
#pragma unroll
      for (int ks = 0; ks < 4; ++ks) bw[ks] = ld8(wT + 16 * ks);
    }
    const float c0 = (mat ? p.a0 : p.w0)[((size_t)layer * 2 + d) * 512 + n];
    const int tok = pt >> 3, c8 = pt & 7;
    int colg[5];
    colg[0] = 3904 + hd * 64 + c8 * 8; colg[1] = 4416 + hd * 64 + c8 * 8; colg[2] = 4928 + hd * 64 + c8 * 8;
    colg[3] = 5440 + d * 64 + c8 * 8; colg[4] = 5568 + d * 64 + c8 * 8;
    const float* mu0 = p.mu + (size_t)layer * 2 * 1792;
    const float* mu1 = mu0 + 1792;
    float m0[5][8], m1[5][8], kkc[8], kac[8];
#pragma unroll
    for (int g = 0; g < 5; ++g)
#pragma unroll
      for (int j = 0; j < 8; ++j) { m0[g][j] = mu0[colg[g] - 3904 + j]; m1[g][j] = mu1[colg[g] - 3904 + j]; }
#pragma unroll
    for (int j = 0; j < 8; ++j) { kkc[j] = p.k_k[layer * 512 + hd * 64 + c8 * 8 + j]; kac[j] = p.k_a[layer * 512 + hd * 64 + c8 * 8 + j]; }
    bf16x8 raw[5][3];
    auto loadraw = [&](int cc) {
      int o0, len; size_t rbase; geom(cc, o0, len, rbase);
      const int o = o0 + tok;
#pragma unroll
      for (int g = 0; g < 5; ++g) {
        const u16* src = p.P + (rbase + o) * NIN + colg[g];
        raw[g][1] = ld8(src);
        raw[g][0] = o > 0 ? ld8(src - NIN) : zero8();
        raw[g][2] = o < len - 1 ? ld8(src + NIN) : zero8();
      }
    };
    loadraw(0);
    for (int cn = 0; cn < 137; ++cn) {
      float* bbase = buf + (cn & 1) * 32 * 384;
      float* bb = bbase + tok * 384;
      if (cn < 136) {
#pragma unroll
        for (int g = 0; g < 5; ++g) {
          float cur[8], prv[8], nxt[8], sh[8];
          unpack8(raw[g][1], cur); unpack8(raw[g][0], prv); unpack8(raw[g][2], nxt);
#pragma unroll
          for (int j = 0; j < 8; ++j) sh[j] = cur[j] + m0[g][j] * (prv[j] - cur[j]) + m1[g][j] * (nxt[j] - cur[j]);
          if (g < 3) {
            float* dst = bb + (g == 0 ? 0 : g == 1 ? 128 : 320) + c8 * 8;
            *(f32x4*)dst = f32x4{sh[0], sh[1], sh[2], sh[3]};
            *(f32x4*)(dst + 4) = f32x4{sh[4], sh[5], sh[6], sh[7]};
          } else if (g == 3) {
#pragma unroll
            for (int j = 0; j < 8; ++j) sh[j] = 1.f - 2.f / (1.f + __expf(2.f * sh[j]));
            *(bf16x8*)(twS + tok * 72 + c8 * 8) = pack8(sh);
          } else {
            *(bf16x8*)(alS + tok * 72 + c8 * 8) = pack8(sh);
          }
        }
      }
      __syncthreads();
      if (cn + 1 < 136) loadraw(cn + 1);
      if (cn < 136) {
        const u16* X = mat ? alS : twS;
        f32x16 acc = zero16();
#pragma unroll
        for (int ks = 0; ks < 4; ++ks) acc = MFMA(ld8(X + l31 * 72 + ks * 16 + h * 8), bw[ks], acc);
        const int ch = nh * 32 + l31;
#pragma unroll
        for (int r = 0; r < 16; ++r) {
          const int tk = crow(r, h);
          const float sg = 1.f / (1.f + __expf(-(c0 + acc[r])));
          if (mat == 0) bbase[tk * 384 + 64 + ch] = __expf(-0.6065306597126334f * sg);
          else bbase[tk * 384 + 256 + ch] = sg;
        }
      }
      __syncthreads();
      if (cn < 136) {
        float kk[8], kr[8], ar[8];
        float ss = 0.f;
        {
          f32x4 k0 = *(const f32x4*)(bb + 128 + c8 * 8), k1 = *(const f32x4*)(bb + 132 + c8 * 8);
          f32x4 a0 = *(const f32x4*)(bb + 256 + c8 * 8), a1 = *(const f32x4*)(bb + 260 + c8 * 8);
#pragma unroll
          for (int j = 0; j < 4; ++j) { kr[j] = k0[j]; kr[4 + j] = k1[j]; ar[j] = a0[j]; ar[4 + j] = a1[j]; }
        }
#pragma unroll
        for (int j = 0; j < 8; ++j) { kk[j] = kr[j] * kkc[j]; ss += kk[j] * kk[j]; }
        ss = sum8(ss);
        const float inv = 1.f / fmaxf(sqrtf(ss), 1e-12f);
        float oa[8], ob[8], ok[8];
#pragma unroll
        for (int j = 0; j < 8; ++j) {
          const float kkn = kk[j] * inv;
          oa[j] = -kkn; ob[j] = kkn * ar[j]; ok[j] = kr[j] * (1.f + (ar[j] - 1.f) * kac[j]);
        }
        *(f32x4*)(bb + 192 + c8 * 8) = f32x4{oa[0], oa[1], oa[2], oa[3]}; *(f32x4*)(bb + 196 + c8 * 8) = f32x4{oa[4], oa[5], oa[6], oa[7]};
        *(f32x4*)(bb + 256 + c8 * 8) = f32x4{ob[0], ob[1], ob[2], ob[3]}; *(f32x4*)(bb + 260 + c8 * 8) = f32x4{ob[4], ob[5], ob[6], ob[7]};
        *(f32x4*)(bb + 128 + c8 * 8) = f32x4{ok[0], ok[1], ok[2], ok[3]}; *(f32x4*)(bb + 132 + c8 * 8) = f32x4{ok[4], ok[5], ok[6], ok[7]};
      }
      __syncthreads();
    }
  } else {
    const int kq = lane & 15, vrow = 32 * vhalf + 8 * w + 2 * (lane >> 4);
    float S0[4], S1[4];
#pragma unroll
    for (int i = 0; i < 4; ++i) { S0[i] = 0.f; S1[i] = 0.f; }
    for (int c = -1; c < 136; ++c) {
      int o0 = 0, len; size_t rbase = 0;
      if (c >= 0) geom(c, o0, len, rbase);
      const float* bbase = buf + (c & 1) * 32 * 384;
      u16* yp = p.Yrw + ((size_t)d * NTOK + rbase + o0) * 512 + hd * 64 + vrow;
#pragma unroll 1
      for (int part = 0; part < 3; ++part) {
        if (c >= 0) {
          const int s0 = part == 0 ? 0 : part == 1 ? 12 : 22, s1 = part == 0 ? 12 : part == 1 ? 22 : 32;
          f32x4 A[5], Bq[5];
          f32x2 va, vb;
          auto ldstep = [&](int s, f32x4 (&R)[5], f32x2& vv) {
            const int i = d ? 31 - s : s;
            const float* t = bbase + i * 384 + 4 * kq;
#pragma unroll
            for (int q = 0; q < 5; ++q) R[q] = *(const f32x4*)(t + 64 * q);
            vv = *(const f32x2*)(bbase + i * 384 + 320 + vrow);
          };
          auto step = [&](const f32x4 (&R)[5], f32x2 vv, int s) {
            const int i = d ? 31 - s : s;
            float sa0 = (S0[0] * R[3][0] + S0[1] * R[3][1]) + (S0[2] * R[3][2] + S0[3] * R[3][3]);
            float sa1 = (S1[0] * R[3][0] + S1[1] * R[3][1]) + (S1[2] * R[3][2] + S1[3] * R[3][3]);
            sa0 = sum16(sa0); sa1 = sum16(sa1);
            float y0 = 0.f, y1 = 0.f;
#pragma unroll
            for (int k = 0; k < 4; ++k) {
              S0[k] = S0[k] * R[1][k] + (sa0 * R[4][k] + vv[0] * R[2][k]);
              S1[k] = S1[k] * R[1][k] + (sa1 * R[4][k] + vv[1] * R[2][k]);
              y0 += S0[k] * R[0][k]; y1 += S1[k] * R[0][k];
            }
            y0 = sum16(y0); y1 = sum16(y1);
            if (kq == 0) *(unsigned*)(yp + (size_t)i * 512) = pk2(y0, y1);
          };
          ldstep(s0, A, va);
          for (int s = s0; s < s1; s += 2) {
            ldstep(s + 1, Bq, vb);
            step(A, va, s);
            if (s + 2 < s1) ldstep(s + 2, A, va);
            step(Bq, vb, s + 1);
          }
        }
        __syncthreads();
      }
    }
  }
}

DI void merge_phase(const KP& p, int layer, int M) {
  const int lane = otid() & 63, w = otid() >> 6;
  const float* mu0 = p.mu + (size_t)layer * 2 * 1792;
  const float* mu1 = mu0 + 1792;
  for (int row = obid() * 8 + w; row < M; row += gridDim.x * 8) {
    const int ch0 = lane * 8;
    {
      float y0[8], y1[8], y[8];
      unpack8(ld8(p.Yret + (size_t)row * 512 + ch0), y0);
      unpack8(ld8(p.Yret + ((size_t)NTOK + row) * 512 + ch0), y1);
      float s = 0.f;
#pragma unroll
      for (int j = 0; j < 8; ++j) { y[j] = y0[j] + y1[j]; s += y[j]; }
      s += __shfl_xor(s, 1); s += __shfl_xor(s, 2); s += __shfl_xor(s, 4); s += __shfl_xor(s, 8);
      const float mean = s * (1.f / 128.f);
      float v = 0.f;
#pragma unroll
      for (int j = 0; j < 8; ++j) { const float dlt = y[j] - mean; v += dlt * dlt; }
      v += __shfl_xor(v, 1); v += __shfl_xor(v, 2); v += __shfl_xor(v, 4); v += __shfl_xor(v, 8);
      const float rstd = rsqrtf(v * (1.f / 128.f) + 1e-5f);
      float gt[8], o[8];
      unpack8(ld8(p.P + (size_t)row * NIN + 1536 + ch0), gt);
#pragma unroll
      for (int j = 0; j < 8; ++j) o[j] = (y[j] - mean) * rstd * p.ret_gn[layer * 512 + ch0 + j] * silu(gt[j]);
      *(bf16x8*)(p.H + (size_t)row * DM + ch0) = pack8(o);
    }
    {
      float y0[8], y1[8], y[8];
      unpack8(ld8(p.Yrw + (size_t)row * 512 + ch0), y0);
      unpack8(ld8(p.Yrw + ((size_t)NTOK + row) * 512 + ch0), y1);
      float s = 0.f;
#pragma unroll
      for (int j = 0; j < 8; ++j) { y[j] = y0[j] + y1[j]; s += y[j]; }
      s += __shfl_xor(s, 1); s += __shfl_xor(s, 2); s += __shfl_xor(s, 4);
      const float mean = s * (1.f / 64.f);
      float v = 0.f;
#pragma unroll
      for (int j = 0; j < 8; ++j) { const float dlt = y[j] - mean; v += dlt * dlt; }
      v += __shfl_xor(v, 1); v += __shfl_xor(v, 2); v += __shfl_xor(v, 4);
      const float rstd = rsqrtf(v * (1.f / 64.f) + 64e-5f);
      int o, len;
      if (row < NLAT) { o = row & 4095; len = 4096; } else { o = (row - NLAT) & 255; len = 256; }
      float f[3][8];
#pragma unroll
      for (int g = 0; g < 3; ++g) {
        const int col = 3904 + 512 * g + ch0;
        const u16* src = p.P + (size_t)row * NIN + col;
        float cur[8], prv[8], nxt[8];
        unpack8(ld8(src), cur);
        if (o > 0) unpack8(ld8(src - NIN), prv); else { for (int j = 0; j < 8; ++j) prv[j] = 0.f; }
        if (o < len - 1) unpack8(ld8(src + NIN), nxt); else { for (int j = 0; j < 8; ++j) nxt[j] = 0.f; }
#pragma unroll
        for (int j = 0; j < 8; ++j) {
          const float m0v = mu0[col - 3904 + j], m1v = mu1[col - 3904 + j];
          f[g][j] = cur[j] + m0v * (prv[j] - cur[j]) + m1v * (nxt[j] - cur[j]);
        }
      }
      float rk = 0.f;
#pragma unroll
      for (int j = 0; j < 8; ++j) rk += f[0][j] * f[1][j] * p.r_k[layer * 512 + ch0 + j];
      rk += __shfl_xor(rk, 1); rk += __shfl_xor(rk, 2); rk += __shfl_xor(rk, 4);
      float gt[8], ov[8];
      unpack8(ld8(p.P + (size_t)row * NIN + 5696 + ch0), gt);
#pragma unroll
      for (int j = 0; j < 8; ++j)
        ov[j] = ((y[j] - mean) * rstd * p.rw_gn[layer * 512 + ch0 + j] + rk * f[2][j]) * silu(gt[j]);
      *(bf16x8*)(p.H + (size_t)row * DM + 1536 + ch0) = pack8(ov);
    }
  }
}

DI void ln_phase(const KP& p, int layer, int M) {
  const int lane = otid() & 63, w = otid() >> 6;
  const float* g = p.ln_g + layer * DM;
  const float* bb_ = p.ln_b + layer * DM;
  for (int row = obid() * 8 + w; row < M; row += gridDim.x * 8) {
    float* ptr = row < NLAT ? p.out + (size_t)row * DM : p.X1c + (size_t)(row - NLAT) * DM;
    f32x4 v[8];
    float s = 0.f;
#pragma unroll
    for (int i = 0; i < 8; ++i) { v[i] = *(const f32x4*)(ptr + (i * 64 + lane) * 4); s += v[i][0] + v[i][1] + v[i][2] + v[i][3]; }
#pragma unroll
    for (int o = 1; o < 64; o <<= 1) s += __shfl_xor(s, o);
    const float mean = s * (1.f / 2048.f);
    float q = 0.f;
#pragma unroll
    for (int i = 0; i < 8; ++i)
#pragma unroll
      for (int j = 0; j < 4; ++j) { const float dlt = v[i][j] - mean; q += dlt * dlt; }
#pragma unroll
    for (int o = 1; o < 64; o <<= 1) q += __shfl_xor(q, o);
    const float rstd = rsqrtf(q * (1.f / 2048.f) + 1e-5f);
    const int bidx = row < NLAT ? (row >> 12) : 4;
    const float* md = p.mod + ((size_t)5 + bidx) * 6144;
#pragma unroll
    for (int i = 0; i < 8; ++i) {
      const int c = (i * 64 + lane) * 4;
      f32x4 gg = *(const f32x4*)(g + c), bbv = *(const f32x4*)(bb_ + c), y;
#pragma unroll
      for (int j = 0; j < 4; ++j) y[j] = (v[i][j] - mean) * rstd * gg[j] + bbv[j];
      *(f32x4*)(ptr + c) = y;
      if (layer == 0) {
        f32x4 sh = *(const f32x4*)(md + c), scl = *(const f32x4*)(md + 2048 + c);
        u32x2 o;
        o[0] = pk2(y[0] * (1.f + scl[0]) + sh[0], y[1] * (1.f + scl[1]) + sh[1]);
        o[1] = pk2(y[2] * (1.f + scl[2]) + sh[2], y[3] * (1.f + scl[3]) + sh[3]);
        *(u32x2*)(p.H + (size_t)row * DM + c) = o;
      }
    }
  }
}

__global__ void __launch_bounds__(NTHR) hybrid_block_megakernel(KP p) {
  extern __shared__ __attribute__((aligned(16))) char smem[];
  cg::grid_group grid = cg::this_grid();
  __shared__ int s_item;
  const int tid = otid();

  if (obid() == 0 && tid < 8) p.cnt[tid] = 0u;
  mod_phase(p, smem);
  convert_weights(p, 0, smem);
  grid.sync();
  h0_phase(p);
  grid.sync();

  for (int layer = 0; layer < 2; ++layer) {
    const int Mq = layer == 0 ? NTOK : NLAT;
    for (int it = obid(); it < 68 * 25; it += gridDim.x) {
      const int nt = it / 68, mt = it % 68;
      gemm_tile(p, 0, layer, mt * 256, nt * 256, smem);
    }
    grid.sync();
    {
      const int n_uq = (Mq / 256) * 6, n_ukv = 68 * 8, n_kr = NTOK / 8;
      for (int it = obid(); it < n_uq + n_ukv + n_kr; it += gridDim.x) {
        if (it < n_uq) gemm_tile(p, 1, layer, (it / 6) * 256, (it % 6) * 256, smem);
        else if (it < n_uq + n_ukv) { const int i = it - n_uq; gemm_tile(p, 2, layer, (i / 8) * 256, (i % 8) * 256, smem); }
        else krope_item(p, it - n_uq - n_ukv);
      }
    }
    grid.sync();
    {
      for (int ch = obid(); ch < 160; ch += gridDim.x) {
        if (ch < 128) rwkv_chain(p, layer, ch, smem); else ret_chain(p, layer, ch - 128, smem);
      }
      const int n_att = layer == 0 ? 512 + 32 : 512;
      while (true) {
        __syncthreads();
        if (tid == 0) s_item = (int)atomicAdd(&p.cnt[layer], 1u);
        __syncthreads();
        const int it = s_item;
        if (it >= n_att) break;
        if (it < 512) {
          const int b = it >> 7, hd = (it >> 4) & 7, qb = it & 15;
          attn_item(p, b * 4096 + qb * 256, b, hd, LPOS, smem);
        } else {
          const int i = it - 512, b = i >> 3, hd = i & 7;
          attn_item(p, NLAT + b * 256, b, hd, 256, smem);
        }
      }
    }
    grid.sync();
    merge_phase(p, layer, Mq);
    grid.sync();
    for (int it = obid(); it < (Mq / 256) * 8; it += gridDim.x) {
      const int nt = it % 8, mt = it / 8;
      gemm_tile(p, 3, layer, mt * 256, nt * 256, smem);
    }
    grid.sync();
    ln_phase(p, layer, Mq);
    if (layer == 0) {
      convert_weights(p, 1, smem);
      grid.sync();
    }
  }
}

extern "C" void kernel_launch(void* const* d_in, const int* in_sizes, int n_in, void* d_out, int out_size, void* d_ws,
                              size_t ws_size, hipStream_t stream) {
  static int grid_blocks = 0;
  if (!grid_blocks) {
    int dev = 0, cus = 0, per_cu = 0;
    hipGetDevice(&dev);
    hipDeviceGetAttribute(&cus, hipDeviceAttributeMultiprocessorCount, dev);
    hipFuncSetAttribute((const void*)hybrid_block_megakernel, hipFuncAttributeMaxDynamicSharedMemorySize, (int)LDS_BYTES);
    hipOccupancyMaxActiveBlocksPerMultiprocessor(&per_cu, hybrid_block_megakernel, NTHR, LDS_BYTES);
    if (per_cu > 1) per_cu = 1;
    grid_blocks = cus * per_cu;
  }
  KP p{};
  const float* const* in = (const float* const*)d_in;
  p.x = in[0]; p.c = in[1]; p.ctx = in[2]; p.c_ctx = in[3]; p.w_ada = in[4]; p.b_ada = in[5]; p.w_in = in[6];
  p.ret_logit = in[7]; p.ret_gn = in[8]; p.q_g = in[9]; p.w_uq = in[10]; p.kv_g = in[11]; p.w_ukv = in[12]; p.mu = in[13];
  p.w0 = in[14]; p.w2 = in[15]; p.a0 = in[16]; p.a2 = in[17]; p.k_k = in[18]; p.k_a = in[19]; p.r_k = in[20]; p.rw_gn = in[21];
  p.w_out = in[22]; p.ln_g = in[23]; p.ln_b = in[24];
  p.out = (float*)d_out;
  char* ws = (char*)d_ws;
  size_t off = 0;
  auto take = [&](size_t bytes) { char* r = ws + off; off += (bytes + 255) & ~(size_t)255; return r; };
  p.P = (u16*)take((size_t)NTOK * NIN * 2);
  p.H = (u16*)take((size_t)NTOK * DM * 2);
  p.Q = (u16*)take((size_t)NTOK * 1536 * 2);
  p.Kn = (u16*)take((size_t)4 * 8 * LPOS * 128 * 2);
  p.Vt = (u16*)take((size_t)4 * 8 * 128 * LPOS * 2);
  p.Kr = (u16*)take((size_t)4 * LPOS * 64 * 2);
  p.Yret = (u16*)take((size_t)2 * NTOK * 512 * 2);
  p.Yrw = (u16*)take((size_t)2 * NTOK * 512 * 2);
  p.WinT = (u16*)take((size_t)NIN * DM * 2);
  p.WuqT = (u16*)take((size_t)1536 * 512 * 2);
  p.WukvT = (u16*)take((size_t)2048 * 256 * 2);
  p.WoutT = (u16*)take((size_t)DM * DM * 2);
  p.W2T = (u16*)take((size_t)2 * 512 * 64 * 2);
  p.A2T = (u16*)take((size_t)2 * 512 * 64 * 2);
  p.X1c = (float*)take((size_t)1024 * DM * 4);
  p.mod = (float*)take((size_t)2 * 5 * 6144 * 4);
  p.cnt = (unsigned*)take(256);
  if (off > ws_size) { fprintf(stderr, "workspace too small: need %zu have %zu\n", off, ws_size); return; }
  void* args[] = {&p};
  hipError_t e = hipLaunchCooperativeKernel((void*)hybrid_block_megakernel, dim3(grid_blocks), dim3(NTHR), args, LDS_BYTES, stream);
  if (e != hipSuccess) fprintf(stderr, "cooperative launch failed: %s (grid %d)\n", hipGetErrorString(e), grid_blocks);
}
```

```cpp
#include <hip/hip_runtime.h>
#include <hip/hip_cooperative_groups.h>
#include <cstdio>
namespace cg = cooperative_groups;

#define DI __device__ __forceinline__
typedef unsigned short u16;
using bf16x8 = __attribute__((ext_vector_type(8))) short;
using s16x4 = __attribute__((ext_vector_type(4))) short;
using f32x16 = __attribute__((ext_vector_type(16))) float;
using f32x4 = __attribute__((ext_vector_type(4))) float;
using u32x4 = __attribute__((ext_vector_type(4))) unsigned;
using u32x2 = __attribute__((ext_vector_type(2))) unsigned;
using f32x2 = __attribute__((ext_vector_type(2))) float;
#define MFMA(a, b, c) __builtin_amdgcn_mfma_f32_32x32x16_bf16((a), (b), (c), 0, 0, 0)

constexpr int DM = 2048, NIN = 6208, NLAT = 16384, NTOK = 17408, LPOS = 4352;
constexpr int NTHR = 512;
constexpr size_t LDS_BYTES = 149504;
constexpr float ALPHA = 1.4142135623730951f;
constexpr float QSCALE = 0.07216878364870323f * 1.4426950408889634f;

struct KP {
  const float *x, *c, *ctx, *c_ctx, *w_ada, *b_ada, *w_in, *ret_logit, *ret_gn, *q_g, *w_uq, *kv_g, *w_ukv, *mu, *w0, *w2, *a0,
      *a2, *k_k, *k_a, *r_k, *rw_gn, *w_out, *ln_g, *ln_b;
  float* out;
  u16 *P, *H, *Q, *Kn, *Vt, *Kr, *Yret, *Yrw, *WinT, *WuqT, *WukvT, *WoutT, *W2T, *A2T;
  float *X1c, *mod;
  unsigned* cnt;
};

DI int otid() { int t = threadIdx.x; asm volatile("" : "+v"(t)); return t; }
DI int obid() { int t = blockIdx.x; asm volatile("" : "+s"(t)); return t; }
template <int CTRL> DI float dppf(float v) {
  return __builtin_bit_cast(float, __builtin_amdgcn_update_dpp(0, __builtin_bit_cast(int, v), CTRL, 0xf, 0xf, true));
}
DI float sum8(float x) { x += dppf<0xB1>(x); x += dppf<0x4E>(x); x += dppf<0x141>(x); return x; }
DI float sum16(float x) { x += dppf<0xB1>(x); x += dppf<0x4E>(x); x += dppf<0x141>(x); x += dppf<0x140>(x); return x; }
DI float bf2f(u16 v) { return __uint_as_float(((unsigned)v) << 16); }
DI float bflo(unsigned v) { return __uint_as_float(v << 16); }
DI float bfhi(unsigned v) { return __uint_as_float(v & 0xffff0000u); }
DI u16 f2bf(float a) { __bf16 r = (__bf16)a; return __builtin_bit_cast(u16, r); }
DI unsigned pk2(float a, float b) {
  typedef __bf16 bf2 __attribute__((ext_vector_type(2)));
  typedef float f2 __attribute__((ext_vector_type(2)));
  f2 v = {a, b};
  bf2 r = __builtin_convertvector(v, bf2);
  return __builtin_bit_cast(unsigned, r);
}
DI int crow(int reg, int h) { return (reg & 3) + 8 * (reg >> 2) + 4 * h; }
DI float silu(float x) { return x / (1.f + __expf(-x)); }
DI void unpack8(const bf16x8& v, float* f) {
  u32x4 u = __builtin_bit_cast(u32x4, v);
#pragma unroll
  for (int i = 0; i < 4; ++i) { f[2 * i] = bflo(u[i]); f[2 * i + 1] = bfhi(u[i]); }
}
DI bf16x8 pack8(const float* f) {
  u32x4 u;
#pragma unroll
  for (int i = 0; i < 4; ++i) u[i] = pk2(f[2 * i], f[2 * i + 1]);
  return __builtin_bit_cast(bf16x8, u);
}
DI bf16x8 ld8(const u16* p) { return *(const bf16x8*)p; }
DI bf16x8 zero8() { bf16x8 z = {0, 0, 0, 0, 0, 0, 0, 0}; return z; }
DI f32x16 zero16() { f32x16 z; for (int i = 0; i < 16; ++i) z[i] = 0.f; return z; }
DI s16x4 trread(const u16* p) {
  return __builtin_amdgcn_ds_read_tr16_b64_v4i16((s16x4 __attribute__((address_space(3)))*)(p));
}
DI bf16x8 cat4(s16x4 lo, s16x4 hi) { return __builtin_shufflevector(lo, hi, 0, 1, 2, 3, 4, 5, 6, 7); }
DI void rope_cs(int pos, int i, float& cs, float& sn) {
  float inv = exp2f(-(float)i * (13.287712379549449f / 16.f));
  float rev = (float)pos * inv * 0.15915494309189535f;
  rev -= floorf(rev);
  cs = __builtin_amdgcn_cosf(rev);
  sn = __builtin_amdgcn_sinf(rev);
}

DI void transpose_item(const float* src, u16* dst, int K, int N, int kt, int nt, char* smem) {
  float* tile = (float*)smem;
  const int tid = otid();
  __syncthreads();
  {
    const int kk = tid >> 4, n4 = tid & 15;
#pragma unroll
    for (int i = 0; i < 2; ++i) {
      const int k = kk + 32 * i;
      f32x4 v = *(const f32x4*)(src + (size_t)(kt * 64 + k) * N + nt * 64 + n4 * 4);
      tile[k * 65 + n4 * 4 + 0] = v[0]; tile[k * 65 + n4 * 4 + 1] = v[1];
      tile[k * 65 + n4 * 4 + 2] = v[2]; tile[k * 65 + n4 * 4 + 3] = v[3];
    }
  }
  __syncthreads();
  {
    const int n = tid >> 3, k8 = tid & 7;
    float f[8];
#pragma unroll
    for (int j = 0; j < 8; ++j) f[j] = tile[(k8 * 8 + j) * 65 + n];
    *(bf16x8*)(dst + (size_t)(nt * 64 + n) * K + kt * 64 + k8 * 8) = pack8(f);
  }
}

DI void convert_weights(const KP& p, int layer, char* smem) {
  const int n_in = 32 * 97, n_uq = 8 * 24, n_ukv = 4 * 32, n_out = 32 * 32, n_lora = 8;
  const int total = n_in + n_uq + n_ukv + n_out + 4 * n_lora;
  for (int it = obid(); it < total; it += gridDim.x) {
    int i = it;
    if (i < n_in) { transpose_item(p.w_in + (size_t)layer * DM * NIN, p.WinT, DM, NIN, i / 97, i % 97, smem); continue; }
    i -= n_in;
    if (i < n_uq) { transpose_item(p.w_uq + (size_t)layer * 512 * 1536, p.WuqT, 512, 1536, i / 24, i % 24, smem); continue; }
    i -= n_uq;
    if (i < n_ukv) { transpose_item(p.w_ukv + (size_t)layer * 256 * 2048, p.WukvT, 256, 2048, i / 32, i % 32, smem); continue; }
    i -= n_ukv;
    if (i < n_out) { transpose_item(p.w_out + (size_t)layer * DM * DM, p.WoutT, DM, DM, i / 32, i % 32, smem); continue; }
    i -= n_out;
    {
      const int which = i / (2 * n_lora), r = i % (2 * n_lora), d = r / n_lora, nt = r % n_lora;
      const float* src = (which ? p.a2 : p.w2) + ((size_t)layer * 2 + d) * 64 * 512;
      u16* dst = (which ? p.A2T : p.W2T) + (size_t)d * 512 * 64;
      transpose_item(src, dst, 64, 512, 0, nt, smem);
    }
  }
}

DI void mod_phase(const KP& p, char* smem) {
  float* sc = (float*)smem;
  float* red = sc + 5 * 2048;
  const int tid = otid();
  __syncthreads();
  for (int i = tid; i < 5 * 2048; i += NTHR) {
    float v = i < 4 * 2048 ? p.c[i] : p.c_ctx[i - 4 * 2048];
    sc[i] = silu(v);
  }
  __syncthreads();
  const int kg = tid >> 5, col = tid & 31;
  for (int it = obid(); it < 384; it += gridDim.x) {
    const int layer = it / 192, j = (it % 192) * 32 + col;
    const float* w = p.w_ada + (size_t)layer * DM * 6144 + j;
    float acc[5] = {0.f, 0.f, 0.f, 0.f, 0.f};
    for (int k = kg * 128; k < kg * 128 + 128; k += 16) {
      float wv[16];
#pragma unroll
      for (int u = 0; u < 16; ++u) wv[u] = w[(size_t)(k + u) * 6144];
#pragma unroll
      for (int u = 0; u < 16; ++u)
#pragma unroll
        for (int r = 0; r < 5; ++r) acc[r] += sc[r * 2048 + k + u] * wv[u];
    }
#pragma unroll
    for (int r = 0; r < 5; ++r) red[(kg * 5 + r) * 32 + col] = acc[r];
    __syncthreads();
    if (tid < 160) {
      const int r = tid >> 5;
      float s = p.b_ada[(size_t)layer * 6144 + j];
      for (int g = 0; g < 16; ++g) s += red[(g * 5 + r) * 32 + col];
      p.mod[((size_t)layer * 5 + r) * 6144 + j] = s;
    }
    __syncthreads();
  }
}

DI void h0_phase(const KP& p) {
  const int lane = otid() & 63, w = otid() >> 6;
  for (int row = obid() * 8 + w; row < NTOK; row += gridDim.x * 8) {
    const float* src = row < NLAT ? p.x + (size_t)row * DM : p.ctx + (size_t)(row - NLAT) * DM;
    const int bb = row < NLAT ? (row >> 12) : 4;
    const float* md = p.mod + (size_t)bb * 6144;
#pragma unroll
    for (int i = 0; i < 8; ++i) {
      const int c = (i * 64 + lane) * 4;
      f32x4 v = *(const f32x4*)(src + c), sh = *(const f32x4*)(md + c), scl = *(const f32x4*)(md + 2048 + c);
      u32x2 o;
      o[0] = pk2(v[0] * (1.f + scl[0]) + sh[0], v[1] * (1.f + scl[1]) + sh[1]);
      o[1] = pk2(v[2] * (1.f + scl[2]) + sh[2], v[3] * (1.f + scl[3]) + sh[3]);
      *(u32x2*)(p.H + (size_t)row * DM + c) = o;
    }
  }
}

DI void gemm_tile(const KP& p, int mode, int layer, int m0, int n0, char* smem) {
  constexpr int STG = 512 * 72;
  u16* base = (u16*)smem;
  float* rs = (float*)(base + 2 * STG);
  const int tid = otid(), lane = tid & 63, w = tid >> 6, wm = w >> 2, wn = w & 3, l31 = lane & 31, h = lane >> 5;
  const u16* A; const u16* Bt; const float* gv = nullptr; int lda, K, N;
  if (mode == 0) { A = p.H; lda = DM; K = DM; N = NIN; Bt = p.WinT; }
  else if (mode == 1) { A = p.P + 2048; lda = NIN; K = 512; N = 1536; Bt = p.WuqT; gv = p.q_g + layer * 512; }
  else if (mode == 2) { A = p.P + 2560; lda = NIN; K = 256; N = 2048; Bt = p.WukvT; gv = p.kv_g + layer * 256; }
  else { A = p.H; lda = DM; K = DM; N = DM; Bt = p.WoutT; }
  const bool xf = (mode == 1 || mode == 2);
  const bool active = (n0 + wn * 64) < N;
  __syncthreads();
  if (xf) {
    const int r = tid >> 1, part = tid & 1;
    const u16* src = A + (size_t)(m0 + r) * lda + part * (K >> 1);
    float ss = 0.f;
    for (int i = 0; i < (K >> 1); i += 8) {
      float f[8]; unpack8(ld8(src + i), f);
#pragma unroll
      for (int j = 0; j < 8; ++j) ss += f[j] * f[j];
    }
    ss += __shfl_xor(ss, 1);
    if (!part) rs[r] = rsqrtf(ss / (float)K + 1e-6f);
    __syncthreads();
  }
  f32x16 acc[4][2];
#pragma unroll
  for (int i = 0; i < 4; ++i)
#pragma unroll
    for (int j = 0; j < 2; ++j) acc[i][j] = zero16();
  bf16x8 ra[4], rb[4];
  const int arow = tid >> 3, ac = tid & 7;
  auto loadg = [&](int k0) {
#pragma unroll
    for (int i = 0; i < 4; ++i) {
      const int row = arow + 64 * i;
      bf16x8 v = ld8(A + (size_t)(m0 + row) * lda + k0 + ac * 8);
      if (xf) {
        float f[8]; unpack8(v, f);
        const float sc = rs[row];
        f32x4 g0 = *(const f32x4*)(gv + k0 + ac * 8), g1 = *(const f32x4*)(gv + k0 + ac * 8 + 4);
#pragma unroll
        for (int j = 0; j < 4; ++j) { f[j] *= sc * g0[j]; f[4 + j] *= sc * g1[j]; }
        v = pack8(f);
      }
      ra[i] = v;
    }
#pragma unroll
    for (int i = 0; i < 4; ++i) {
      int nrow = n0 + arow + 64 * i;
      nrow = nrow < N ? nrow : N - 1;
      rb[i] = ld8(Bt + (size_t)nrow * K + k0 + ac * 8);
    }
  };
  auto stage = [&](int buf) {
    u16* As = base + buf * STG;
    u16* Bs = As + 256 * 72;
#pragma unroll
    for (int i = 0; i < 4; ++i) *(bf16x8*)(As + (arow + 64 * i) * 72 + ac * 8) = ra[i];
#pragma unroll
    for (int i = 0; i < 4; ++i) *(bf16x8*)(Bs + (arow + 64 * i) * 72 + ac * 8) = rb[i];
  };
  loadg(0);
  stage(0);
  __syncthreads();
  const int nk = K >> 6;
  for (int kt = 0; kt < nk; ++kt) {
    const u16* As = base + (kt & 1) * STG;
    const u16* Bs = As + 256 * 72;
    if (kt + 1 < nk) loadg((kt + 1) * 64);
    if (active) {
#pragma unroll
      for (int ks = 0; ks < 4; ++ks) {
        bf16x8 bfr[2], afr[4];
#pragma unroll
        for (int ni = 0; ni < 2; ++ni) bfr[ni] = ld8(Bs + (wn * 64 + ni * 32 + l31) * 72 + ks * 16 + h * 8);
#pragma unroll
        for (int mi = 0; mi < 4; ++mi) afr[mi] = ld8(As + (wm * 128 + mi * 32 + l31) * 72 + ks * 16 + h * 8);
#pragma unroll
        for (int mi = 0; mi < 4; ++mi)
#pragma unroll
          for (int ni = 0; ni < 2; ++ni) acc[mi][ni] = MFMA(afr[mi], bfr[ni], acc[mi][ni]);
      }
    }
    if (kt + 1 < nk) stage((kt + 1) & 1);
    __syncthreads();
  }
#pragma unroll
  for (int mi = 0; mi < 4; ++mi)
#pragma unroll
    for (int ni = 0; ni < 2; ++ni) {
      const int cb = n0 + wn * 64 + ni * 32;
      if (cb >= N) continue;
      const int col = cb + l31;
      const int rb0 = m0 + wm * 128 + mi * 32;
      const f32x16& a = acc[mi][ni];
      if (mode == 0) {
#pragma unroll
        for (int r = 0; r < 16; ++r) p.P[(size_t)(rb0 + crow(r, h)) * NIN + col] = f2bf(a[r]);
      } else if (mode == 1) {
        const int dd = cb % 192;
        const bool rope = (dd >= 128) && (rb0 < NLAT);
        const int part = (dd - 128) >> 5;
#pragma unroll
        for (int r = 0; r < 16; ++r) {
          const int row = rb0 + crow(r, h);
          float v = a[r] * QSCALE;
          if (rope) {
            const int t = row & 4095;
            const int pos = part ? (t & 63) : (t >> 6);
            float cs, sn; rope_cs(pos, l31 & 15, cs, sn);
            const float pr = __shfl_xor(v, 16);
            v = (l31 < 16) ? (v * cs - pr * sn) : (v * cs + pr * sn);
          }
          p.Q[(size_t)row * 1536 + col] = f2bf(v);
        }
      } else if (mode == 2) {
        const int head = col >> 8, dd = col & 255;
#pragma unroll
        for (int g = 0; g < 4; ++g) {
          const int row = rb0 + 8 * g + 4 * h;
          int b, pos;
          if (row < NLAT) { b = row >> 12; pos = 256 + (row & 4095); } else { b = (row - NLAT) >> 8; pos = (row - NLAT) & 255; }
          if (dd < 128) {
#pragma unroll
            for (int j = 0; j < 4; ++j) p.Kn[((size_t)(b * 8 + head) * LPOS + pos + j) * 128 + dd] = f2bf(a[4 * g + j]);
          } else {
            u32x2 o; o[0] = pk2(a[4 * g], a[4 * g + 1]); o[1] = pk2(a[4 * g + 2], a[4 * g + 3]);
            *(u32x2*)(p.Vt + ((size_t)(b * 8 + head) * 128 + (dd - 128)) * LPOS + pos) = o;
          }
        }
      } else {
#pragma unroll
        for (int r = 0; r < 16; ++r) {
          const int row = rb0 + crow(r, h);
          const int bb = row < NLAT ? (row >> 12) : 4;
          const float gate = p.mod[((size_t)layer * 5 + bb) * 6144 + 4096 + col];
          float xv;
          float* dst;
          if (row < NLAT) {
            dst = p.out + (size_t)row * DM + col;
            xv = layer == 0 ? p.x[(size_t)row * DM + col] : *dst;
          } else {
            dst = p.X1c + (size_t)(row - NLAT) * DM + col;
            xv = p.ctx[(size_t)(row - NLAT) * DM + col];
          }
          *dst = ALPHA * xv + gate * a[r];
        }
      }
    }
}

DI void krope_item(const KP& p, int it) {
  const int tid = otid(), tok = tid >> 6, dim = tid & 63;
  const int row = it * 8 + tok;
  const u16* src = p.P + (size_t)row * NIN + 2816;
  float v = bf2f(src[dim]);
  int b, pos;
  if (row < NLAT) {
    const float pr = bf2f(src[dim ^ 16]);
    const int t = row & 4095, part = dim >> 5;
    const int ps = part ? (t & 63) : (t >> 6);
    float cs, sn; rope_cs(ps, dim & 15, cs, sn);
    v = ((dim & 31) < 16) ? (v * cs - pr * sn) : (v * cs + pr * sn);
    b = row >> 12; pos = 256 + t;
  } else { b = (row - NLAT) >> 8; pos = (row - NLAT) & 255; }
  p.Kr[((size_t)b * LPOS + pos) * 64 + dim] = f2bf(v);
}

DI void attn_item(const KP& p, int qrow0, int b, int hd, int nkeys, char* smem) {
  constexpr int STG = 64 * 200 + 128 * 72;
  u16* base = (u16*)smem;
  const int tid = otid(), lane = tid & 63, w = tid >> 6, l31 = lane & 31, h = lane >> 5;
  const int qrow = qrow0 + 32 * w + l31;
  bf16x8 qf[12];
  {
    const u16* qp = p.Q + (size_t)qrow * 1536 + hd * 192 + 8 * h;
#pragma unroll
    for (int ks = 0; ks < 12; ++ks) qf[ks] = ld8(qp + 16 * ks);
  }
  f32x16 o[4];
#pragma unroll
  for (int i = 0; i < 4; ++i) o[i] = zero16();
  float m = -1e30f, lsum = 0.f;
  const u16* kn = p.Kn + (size_t)(b * 8 + hd) * LPOS * 128;
  const u16* kr = p.Kr + (size_t)b * LPOS * 64;
  const u16* vt = p.Vt + (size_t)(b * 8 + hd) * 128 * LPOS;
  int kkey[3], kc[3];
#pragma unroll
  for (int i = 0; i < 3; ++i) { const int idx = tid + NTHR * i; kkey[i] = idx / 24; kc[i] = idx % 24; }
  bf16x8 rk[3], rv[2];
  auto loadg = [&](int kt0) {
#pragma unroll
    for (int i = 0; i < 3; ++i) {
      const u16* src = kc[i] < 16 ? kn + (size_t)(kt0 + kkey[i]) * 128 + kc[i] * 8 : kr + (size_t)(kt0 + kkey[i]) * 64 + (kc[i] - 16) * 8;
      rk[i] = ld8(src);
    }
#pragma unroll
    for (int i = 0; i < 2; ++i) {
      const int idx = tid + NTHR * i, dd = idx >> 3, c = idx & 7;
      rv[i] = ld8(vt + (size_t)dd * LPOS + kt0 + c * 8);
    }
  };
  auto stage = [&](int buf) {
    u16* Ksm = base + buf * STG;
    u16* Vsm = Ksm + 64 * 200;
#pragma unroll
    for (int i = 0; i < 3; ++i) *(bf16x8*)(Ksm + kkey[i] * 200 + kc[i] * 8) = rk[i];
#pragma unroll
    for (int i = 0; i < 2; ++i) {
      const int idx = tid + NTHR * i, dd = idx >> 3, c = idx & 7;
      u32x4 u = __builtin_bit_cast(u32x4, rv[i]);
      u32x2 lo = {u[0], u[1]}, hi = {u[2], u[3]};
      u16* dst = Vsm + dd * 72 + 16 * (c >> 1) + 4 * (c & 1);
      *(u32x2*)dst = lo;
      *(u32x2*)(dst + 8) = hi;
    }
  };
  __syncthreads();
  loadg(0);
  stage(0);
  __syncthreads();
  const int ntile = nkeys >> 6;
  for (int t = 0; t < ntile; ++t) {
    const u16* Ksm = base + (t & 1) * STG;
    const u16* Vsm = Ksm + 64 * 200;
    if (t + 1 < ntile) loadg((t + 1) * 64);
    f32x16 s[2];
#pragma unroll
    for (int kt = 0; kt < 2; ++kt) {
      s[kt] = zero16();
#pragma unroll
      for (int ks = 0; ks < 12; ++ks) {
        bf16x8 a = ld8(Ksm + (kt * 32 + l31) * 200 + ks * 16 + h * 8);
        s[kt] = MFMA(a, qf[ks], s[kt]);
        if ((ks & 3) == 3) asm volatile("" ::: "memory");
      }
    }
    float mx = s[0][0];
#pragma unroll
    for (int r = 0; r < 16; ++r) { mx = fmaxf(mx, s[0][r]); mx = fmaxf(mx, s[1][r]); }
    mx = fmaxf(mx, __shfl_xor(mx, 32));
    const float mnew = fmaxf(m, mx);
    const float alpha = __builtin_amdgcn_exp2f(m - mnew);
    m = mnew;
    float ps = 0.f;
#pragma unroll
    for (int kt = 0; kt < 2; ++kt)
#pragma unroll
      for (int r = 0; r < 16; ++r) { float e = __builtin_amdgcn_exp2f(s[kt][r] - mnew); s[kt][r] = e; ps += e; }
    lsum = lsum * alpha + ps;
#pragma unroll
    for (int dt = 0; dt < 4; ++dt)
#pragma unroll
      for (int r = 0; r < 16; ++r) o[dt][r] *= alpha;
#pragma unroll
    for (int kt = 0; kt < 2; ++kt)
#pragma unroll
      for (int sI = 0; sI < 2; ++sI) {
        u32x4 pu;
#pragma unroll
        for (int j = 0; j < 4; ++j) pu[j] = pk2(s[kt][8 * sI + 2 * j], s[kt][8 * sI + 2 * j + 1]);
        const bf16x8 pb = __builtin_bit_cast(bf16x8, pu);
        const int kb = kt * 32 + sI * 16 + 8 * h;
#pragma unroll
        for (int dt = 0; dt < 4; ++dt) o[dt] = MFMA(ld8(Vsm + (dt * 32 + l31) * 72 + kb), pb, o[dt]);
        asm volatile("" ::: "memory");
      }
    if (t + 1 < ntile) stage((t + 1) & 1);
    __syncthreads();
  }
  lsum += __shfl_xor(lsum, 32);
  const float inv = 1.f / lsum;
  const u16* gp = p.P + (size_t)qrow * NIN + 2880 + hd * 128;
  u16* op = p.H + (size_t)qrow * DM + 512 + hd * 128;
#pragma unroll
  for (int dt = 0; dt < 4; ++dt)
#pragma unroll
    for (int g = 0; g < 4; ++g) {
      const int d0 = dt * 32 + 8 * g + 4 * h;
      u32x2 gg = *(const u32x2*)(gp + d0);
      float g0 = bflo(gg[0]), g1 = bfhi(gg[0]), g2 = bflo(gg[1]), g3 = bfhi(gg[1]);
      u32x2 ov;
      ov[0] = pk2(o[dt][4 * g] * inv * silu(g0), o[dt][4 * g + 1] * inv * silu(g1));
      ov[1] = pk2(o[dt][4 * g + 2] * inv * silu(g2), o[dt][4 * g + 3] * inv * silu(g3));
      *(u32x2*)(op + d0) = ov;
    }
}

DI void ret_chain(const KP& p, int layer, int chain, char* smem) {
  const int d = chain >> 4, b = (chain >> 2) & 3, hd = chain & 3;
  u16* Qs = (u16*)smem;
  u16* Ks = Qs + 128 * 136;
  u16* Vs = Ks + 128 * 136;
  u16* Sts = Vs + 128 * 136;
  const int tid = otid(), lane = tid & 63, w = tid >> 6, l31 = lane & 31, h = lane >> 5;
  const int q4 = (lane & 15) >> 2, p4 = lane & 3, blk = (lane >> 4) & 1;
  const float logit = p.ret_logit[(layer * 2 + d) * 4 + hd];
  const float z = -logit;
  const float logg = -(fmaxf(z, 0.f) + log1pf(expf(-fabsf(z))));
  const float lg2 = logg * 1.4426950408889634f;
  const float gC = exp2f(128.f * lg2);
  const float kscale = 0.08838834764831845f;
  const int iw = w & 3, half = w >> 2;
  const int kt = w & 3, vh = w >> 2;
  f32x16 st[2];
  st[0] = zero16(); st[1] = zero16();
  __syncthreads();
  for (int i = tid; i < 128 * 136 / 8; i += NTHR) *(bf16x8*)(Sts + i * 8) = zero8();
  bf16x8 rq[4], rk[4], rv[4];
  const int trow = tid >> 4, tc = tid & 15;
  auto rowbase = [&](int n) -> size_t {
    if (d == 0) return n < 2 ? (size_t)(NLAT + b * 256 + 128 * n) : (size_t)(b * 4096 + 128 * (n - 2));
    return n < 2 ? (size_t)(NLAT + b * 256 + 128 * (1 - n)) : (size_t)(b * 4096 + 128 * (33 - n));
  };
  auto loadg = [&](int n) {
    const size_t rb = rowbase(n);
#pragma unroll
    for (int i = 0; i < 4; ++i) {
      const u16* src = p.P + (rb + trow + 32 * i) * NIN + hd * 128 + tc * 8;
      rq[i] = ld8(src); rk[i] = ld8(src + 512); rv[i] = ld8(src + 1024);
    }
  };
  loadg(0);
  for (int n = 0; n < 34; ++n) {
    const size_t rb = rowbase(n);
#pragma unroll
    for (int i = 0; i < 4; ++i) {
      const int j = trow + 32 * i;
      *(bf16x8*)(Qs + j * 136 + tc * 8) = rq[i];
      *(bf16x8*)(Ks + j * 136 + tc * 8) = rk[i];
      const float zeta = exp2f((d == 0 ? (float)(127 - j) : (float)j) * lg2) * kscale;
      float f[8]; unpack8(rv[i], f);
#pragma unroll
      for (int jj = 0; jj < 8; ++jj) f[jj] *= zeta;
      *(bf16x8*)(Vs + j * 136 + tc * 8) = pack8(f);
    }
    __syncthreads();
    if (n + 1 < 34) loadg(n + 1);
    f32x16 acc[2];
    acc[0] = zero16(); acc[1] = zero16();
    bf16x8 qf[8];
#pragma unroll
    for (int ks = 0; ks < 8; ++ks) qf[ks] = ld8(Qs + (32 * iw + l31) * 136 + 16 * ks + 8 * h);
#pragma unroll
    for (int et = 0; et < 2; ++et)
#pragma unroll
      for (int ks = 0; ks < 8; ++ks) {
        bf16x8 a = ld8(Sts + (32 * (2 * half + et) + l31) * 136 + 16 * ks + 8 * h);
        acc[et] = MFMA(a, qf[ks], acc[et]);
      }
#pragma unroll
    for (int et = 0; et < 2; ++et)
#pragma unroll
      for (int r = 0; r < 16; ++r) acc[et][r] *= gC;
    const int ii = 32 * iw + l31;
#pragma unroll
    for (int jt = 0; jt < 4; ++jt) {
      f32x16 sT = zero16();
#pragma unroll
      for (int ks = 0; ks < 8; ++ks) {
        bf16x8 a = ld8(Ks + (32 * jt + l31) * 136 + 16 * ks + 8 * h);
        sT = MFMA(a, qf[ks], sT);
      }
#pragma unroll
      for (int r = 0; r < 16; ++r) {
        const int j = 32 * jt + crow(r, h);
        const bool keep = d == 0 ? (ii >= j) : (j >= ii);
        sT[r] = keep ? sT[r] : 0.f;
      }
#pragma unroll
      for (int sI = 0; sI < 2; ++sI) {
        u32x4 pu;
#pragma unroll
        for (int j = 0; j < 4; ++j) pu[j] = pk2(sT[8 * sI + 2 * j], sT[8 * sI + 2 * j + 1]);
        const bf16x8 pb = __builtin_bit_cast(bf16x8, pu);
        const int j0 = 32 * jt + 16 * sI + 4 * h;
#pragma unroll
        for (int et = 0; et < 2; ++et) {
          const u16* vp = Vs + (j0 + q4) * 136 + 32 * (2 * half + et) + 16 * blk + 4 * p4;
          s16x4 lo = trread(vp), hi = trread(vp + 8 * 136);
          acc[et] = MFMA(cat4(lo, hi), pb, acc[et]);
        }
      }
    }
    {
      const float rho = exp2f((d == 0 ? (float)(ii - 127) : (float)(-ii)) * lg2);
      u16* yp = p.Yret + ((size_t)d * NTOK + rb + ii) * 512 + hd * 128;
#pragma unroll
      for (int et = 0; et < 2; ++et)
#pragma unroll
        for (int g = 0; g < 4; ++g) {
          const int e0 = 32 * (2 * half + et) + 8 * g + 4 * h;
          u32x2 ov;
          ov[0] = pk2(acc[et][4 * g] * rho, acc[et][4 * g + 1] * rho);
          ov[1] = pk2(acc[et][4 * g + 2] * rho, acc[et][4 * g + 3] * rho);
          *(u32x2*)(yp + e0) = ov;
        }
    }
#pragma unroll
    for (int vi = 0; vi < 2; ++vi)
#pragma unroll
      for (int r = 0; r < 16; ++r) st[vi][r] *= gC;
#pragma unroll
    for (int ks = 0; ks < 8; ++ks) {
      const int jb = 16 * ks + 4 * h + q4;
      const u16* kp = Ks + jb * 136 + 32 * kt + 16 * blk + 4 * p4;
      const bf16x8 a = cat4(trread(kp), trread(kp + 8 * 136));
#pragma unroll
      for (int vi = 0; vi < 2; ++vi) {
        const u16* vp = Vs + jb * 136 + 32 * (2 * vh + vi) + 16 * blk + 4 * p4;
        const bf16x8 bfr = cat4(trread(vp), trread(vp + 8 * 136));
        st[vi] = MFMA(a, bfr, st[vi]);
      }
    }
    __syncthreads();
#pragma unroll
    for (int vi = 0; vi < 2; ++vi)
#pragma unroll
      for (int g = 0; g < 4; ++g) {
        const int v = 32 * (2 * vh + vi) + l31, k0 = 32 * kt + 8 * g + 4 * h;
        u32x2 ov;
        ov[0] = pk2(st[vi][4 * g], st[vi][4 * g + 1]);
        ov[1] = pk2(st[vi][4 * g + 2], st[vi][4 * g + 3]);
        *(u32x2*)(Sts + v * 136 + k0) = ov;
      }
  }
}

DI void rwkv_chain(const KP& p, int layer, int item, char* smem) {
  const int chain = item >> 1, vhalf = item & 1;
  const int d = chain >> 5, b = (chain >> 3) & 3, hd = chain & 7;
  float* buf = (float*)smem;
  u16* twS = (u16*)(smem + 98304);
  u16* alS = twS + 32 * 72;
  const int tid = otid(), lane = tid & 63, w = tid >> 6, l31 = lane & 31, h = lane >> 5;
  auto geom = [&](int cc, int& o0, int& len, size_t& rbase) {
    const int j0 = 32 * cc;
    const bool isctx = j0 < 256;
    len = isctx ? 256 : 4096;
    if (d == 0) o0 = isctx ? j0 : j0 - 256; else o0 = isctx ? (224 - j0) : (4064 - (j0 - 256));
    rbase = isctx ? (size_t)(NLAT + b * 256) : (size_t)(b * 4096);
  };
  __syncthreads();
  if (w >= 4) {
    const int pt = tid - 256;
    const int pw = w - 4, mat = pw >> 1, nh = pw & 1;
    bf16x8 bw[4];
    const int n = hd * 64 + nh * 32 + l31;
    {
      const u16* wT = (mat ? p.A2T : p.W2T) + ((size_t)d * 512 + n) * 64 + 8 * h;
#pragma unroll
      for (int ks = 0; ks < 4; ++ks) bw[ks] = ld8(wT + 16 * ks);
    }
    const float c0 = (mat ? p.a0 : p.w0)[((size_t)layer * 2 + d) * 512 + n];
    const int tok = pt >> 3, c8 = pt & 7;
    int colg[5];
    colg[0] = 3904 + hd * 64 + c8 * 8; colg[1] = 4416 + hd * 64 + c8 * 8; colg[2] = 4928 + hd * 64 + c8 * 8;
    colg[3] = 5440 + d * 64 + c8 * 8; colg[4] = 5568 + d * 64 + c8 * 8;
    const float* mu0 = p.mu + (size_t)layer * 2 * 1792;
    const float* mu1 = mu0 + 1792;
    float m0[5][8], m1[5][8], kkc[8], kac[8];
#pragma unroll
    for (int g = 0; g < 5; ++g)
#pragma unroll
      for (int j = 0; j < 8; ++j) { m0[g][j] = mu0[colg[g] - 3904 + j]; m1[g][j] = mu1[colg[g] - 3904 + j]; }
#pragma unroll
    for (int j = 0; j < 8; ++j) { kkc[j] = p.k_k[layer * 512 + hd * 64 + c8 * 8 + j]; kac[j] = p.k_a[layer * 512 + hd * 64 + c8 * 8 + j]; }
    bf16x8 raw[5][3];
    auto loadraw = [&](int cc) {
      int o0, len; size_t rbase; geom(cc, o0, len, rbase);
      const int o = o0 + tok;
#pragma unroll
      for (int g = 0; g < 5; ++g) {
        const u16* src = p.P + (rbase + o) * NIN + colg[g];
        raw[g][1] = ld8(src);
        raw[g][0] = o > 0 ? ld8(src - NIN) : zero8();
        raw[g][2] = o < len - 1 ? ld8(src + NIN) : zero8();
      }
    };
    loadraw(0);
    for (int cn = 0; cn < 137; ++cn) {
      float* bbase = buf + (cn & 1) * 32 * 384;
      float* bb = bbase + tok * 384;
      if (cn < 136) {
#pragma unroll
        for (int g = 0; g < 5; ++g) {
          float cur[8], prv[8], nxt[8], sh[8];
          unpack8(raw[g][1], cur); unpack8(raw[g][0], prv); unpack8(raw[g][2], nxt);
#pragma unroll
          for (int j = 0; j < 8; ++j) sh[j] = cur[j] + m0[g][j] * (prv[j] - cur[j]) + m1[g][j] * (nxt[j] - cur[j]);
          if (g < 3) {
            float* dst = bb + (g == 0 ? 0 : g == 1 ? 128 : 320) + c8 * 8;
            *(f32x4*)dst = f32x4{sh[0], sh[1], sh[2], sh[3]};
            *(f32x4*)(dst + 4) = f32x4{sh[4], sh[5], sh[6], sh[7]};
          } else if (g == 3) {
#pragma unroll
            for (int j = 0; j < 8; ++j) sh[j] = 1.f - 2.f / (1.f + __expf(2.f * sh[j]));
            *(bf16x8*)(twS + tok * 72 + c8 * 8) = pack8(sh);
          } else {
            *(bf16x8*)(alS + tok * 72 + c8 * 8) = pack8(sh);
          }
        }
      }
      __syncthreads();
      if (cn + 1 < 136) loadraw(cn + 1);
      if (cn < 136) {
        const u16* X = mat ? alS : twS;
        f32x16 acc = zero16();
#pragma unroll
        for (int ks = 0; ks < 4; ++ks) acc = MFMA(ld8(X + l31 * 72 + ks * 16 + h * 8), bw[ks], acc);
        const int ch = nh * 32 + l31;
#pragma unroll
        for (int r = 0; r < 16; ++r) {
          const int tk = crow(r, h);
          const float sg = 1.f / (1.f + __expf(-(c0 + acc[r])));
          if (mat == 0) bbase[tk * 384 + 64 + ch] = __expf(-0.6065306597126334f * sg);
          else bbase[tk * 384 + 256 + ch] = sg;
        }
      }
      __syncthreads();
      if (cn < 136) {
        float kk[8], kr[8], ar[8];
        float ss = 0.f;
        {
          f32x4 k0 = *(const f32x4*)(bb + 128 + c8 * 8), k1 = *(const f32x4*)(bb + 132 + c8 * 8);
          f32x4 a0 = *(const f32x4*)(bb + 256 + c8 * 8), a1 = *(const f32x4*)(bb + 260 + c8 * 8);
#pragma unroll
          for (int j = 0; j < 4; ++j) { kr[j] = k0[j]; kr[4 + j] = k1[j]; ar[j] = a0[j]; ar[4 + j] = a1[j]; }
        }
#pragma unroll
        for (int j = 0; j < 8; ++j) { kk[j] = kr[j] * kkc[j]; ss += kk[j] * kk[j]; }
        ss = sum8(ss);
        const float inv = 1.f / fmaxf(sqrtf(ss), 1e-12f);
        float oa[8], ob[8], ok[8];
#pragma unroll
        for (int j = 0; j < 8; ++j) {
          const float kkn = kk[j] * inv;
          oa[j] = -kkn; ob[j] = kkn * ar[j]; ok[j] = kr[j] * (1.f + (ar[j] - 1.f) * kac[j]);
        }
        *(f32x4*)(bb + 192 + c8 * 8) = f32x4{oa[0], oa[1], oa[2], oa[3]}; *(f32x4*)(bb + 196 + c8 * 8) = f32x4{oa[4], oa[5], oa[6], oa[7]};
        *(f32x4*)(bb + 256 + c8 * 8) = f32x4{ob[0], ob[1], ob[2], ob[3]}; *(f32x4*)(bb + 260 + c8 * 8) = f32x4{ob[4], ob[5], ob[6], ob[7]};
        *(f32x4*)(bb + 128 + c8 * 8) = f32x4{ok[0], ok[1], ok[2], ok[3]}; *(f32x4*)(bb + 132 + c8 * 8) = f32x4{ok[4], ok[5], ok[6], ok[7]};
      }
      __syncthreads();
    }
  } else {
    const int kq = lane & 15, vrow = 32 * vhalf + 8 * w + 2 * (lane >> 4);
    float S0[4], S1[4];
#pragma unroll
    for (int i = 0; i < 4; ++i) { S0[i] = 0.f; S1[i] = 0.f; }
    for (int c = -1; c < 136; ++c) {
      int o0 = 0, len; size_t rbase = 0;
      if (c >= 0) geom(c, o0, len, rbase);
      const float* bbase = buf + (c & 1) * 32 * 384;
      u16* yp = p.Yrw + ((size_t)d * NTOK + rbase + o0) * 512 + hd * 64 + vrow;
#pragma unroll 1
      for (int part = 0; part < 3; ++part) {
        if (c >= 0) {
          const int s0 = part == 0 ? 0 : part == 1 ? 12 : 22, s1 = part == 0 ? 12 : part == 1 ? 22 : 32;
          f32x4 A[5], Bq[5];
          f32x2 va, vb;
          auto ldstep = [&](int s, f32x4 (&R)[5], f32x2& vv) {
            const int i = d ? 31 - s : s;
            const float* t = bbase + i * 384 + 4 * kq;
#pragma unroll
            for (int q = 0; q < 5; ++q) R[q] = *(const f32x4*)(t + 64 * q);
            vv = *(const f32x2*)(bbase + i * 384 + 320 + vrow);
          };
          auto step = [&](const f32x4 (&R)[5], f32x2 vv, int s) {
            const int i = d ? 31 - s : s;
            float sa0 = (S0[0] * R[3][0] + S0[1] * R[3][1]) + (S0[2] * R[3][2] + S0[3] * R[3][3]);
            float sa1 = (S1[0] * R[3][0] + S1[1] * R[3][1]) + (S1[2] * R[3][2] + S1[3] * R[3][3]);
            sa0 = sum16(sa0); sa1 = sum16(sa1);
            float y0 = 0.f, y1 = 0.f;
#pragma unroll
            for (int k = 0; k < 4; ++k) {
              S0[k] = S0[k] * R[1][k] + (sa0 * R[4][k] + vv[0] * R[2][k]);
              S1[k] = S1[k] * R[1][k] + (sa1 * R[4][k] + vv[1] * R[2][k]);
              y0 += S0[k] * R[0][k]; y1 += S1[k] * R[0][k];
            }
            y0 = sum16(y0); y1 = sum16(y1);
            if (kq == 0) *(unsigned*)(yp + (size_t)i * 512) = pk2(y0, y1);
          };
          ldstep(s0, A, va);
          for (int s = s0; s < s1; s += 2) {
            ldstep(s + 1, Bq, vb);
            step(A, va, s);
            if (s + 2 < s1) ldstep(s + 2, A, va);
            step(Bq, vb, s + 1);
          }
        }
        __syncthreads();
      }
    }
  }
}

DI void merge_phase(const KP& p, int layer, int M) {
  const int lane = otid() & 63, w = otid() >> 6;
  const float* mu0 = p.mu + (size_t)layer * 2 * 1792;
  const float* mu1 = mu0 + 1792;
  for (int row = obid() * 8 + w; row < M; row += gridDim.x * 8) {
    const int ch0 = lane * 8;
    {
      float y0[8], y1[8], y[8];
      unpack8(ld8(p.Yret + (size_t)row * 512 + ch0), y0);
      unpack8(ld8(p.Yret + ((size_t)NTOK + row) * 512 + ch0), y1);
      float s = 0.f;
#pragma unroll
      for (int j = 0; j < 8; ++j) { y[j] = y0[j] + y1[j]; s += y[j]; }
      s += __shfl_xor(s, 1); s += __shfl_xor(s, 2); s += __shfl_xor(s, 4); s += __shfl_xor(s, 8);
      const float mean = s * (1.f / 128.f);
      float v = 0.f;
#pragma unroll
      for (int j = 0; j < 8; ++j) { const float dlt = y[j] - mean; v += dlt * dlt; }
      v += __shfl_xor(v, 1); v += __shfl_xor(v, 2); v += __shfl_xor(v, 4); v += __shfl_xor(v, 8);
      const float rstd = rsqrtf(v * (1.f / 128.f) + 1e-5f);
      float gt[8], o[8];
      unpack8(ld8(p.P + (size_t)row * NIN + 1536 + ch0), gt);
#pragma unroll
      for (int j = 0; j < 8; ++j) o[j] = (y[j] - mean) * rstd * p.ret_gn[layer * 512 + ch0 + j] * silu(gt[j]);
      *(bf16x8*)(p.H + (size_t)row * DM + ch0) = pack8(o);
    }
    {
      float y0[8], y1[8], y[8];
      unpack8(ld8(p.Yrw + (size_t)row * 512 + ch0), y0);
      unpack8(ld8(p.Yrw + ((size_t)NTOK + row) * 512 + ch0), y1);
      float s = 0.f;
#pragma unroll
      for (int j = 0; j < 8; ++j) { y[j] = y0[j] + y1[j]; s += y[j]; }
      s += __shfl_xor(s, 1); s += __shfl_xor(s, 2); s += __shfl_xor(s, 4);
      const float mean = s * (1.f / 64.f);
      float v = 0.f;
#pragma unroll
      for (int j = 0; j < 8; ++j) { const float dlt = y[j] - mean; v += dlt * dlt; }
      v += __shfl_xor(v, 1); v += __shfl_xor(v, 2); v += __shfl_xor(v, 4);
      const float rstd = rsqrtf(v * (1.f / 64.f) + 64e-5f);
      int o, len;
      if (row < NLAT) { o = row & 4095; len = 4096; } else { o = (row - NLAT) & 255; len = 256; }
      float f[3][8];
#pragma unroll
      for (int g = 0; g < 3; ++g) {
        const int col = 3904 + 512 * g + ch0;
        const u16* src = p.P + (size_t)row * NIN + col;
        float cur[8], prv[8], nxt[8];
        unpack8(ld8(src), cur);
        if (o > 0) unpack8(ld8(src - NIN), prv); else { for (int j = 0; j < 8; ++j) prv[j] = 0.f; }
        if (o < len - 1) unpack8(ld8(src + NIN), nxt); else { for (int j = 0; j < 8; ++j) nxt[j] = 0.f; }
#pragma unroll
        for (int j = 0; j < 8; ++j) {
          const float m0v = mu0[col - 3904 + j], m1v = mu1[col - 3904 + j];
          f[g][j] = cur[j] + m0v * (prv[j] - cur[j]) + m1v * (nxt[j] - cur[j]);
        }
      }
      float rk = 0.f;
#pragma unroll
      for (int j = 0; j < 8; ++j) rk += f[0][j] * f[1][j] * p.r_k[layer * 512 + ch0 + j];
      rk += __shfl_xor(rk, 1); rk += __shfl_xor(rk, 2); rk += __shfl_xor(rk, 4);
      float gt[8], ov[8];
      unpack8(ld8(p.P + (size_t)row * NIN + 5696 + ch0), gt);
#pragma unroll
      for (int j = 0; j < 8; ++j)
        ov[j] = ((y[j] - mean) * rstd * p.rw_gn[layer * 512 + ch0 + j] + rk * f[2][j]) * silu(gt[j]);
      *(bf16x8*)(p.H + (size_t)row * DM + 1536 + ch0) = pack8(ov);
    }
  }
}

DI void ln_phase(const KP& p, int layer, int M) {
  const int lane = otid() & 63, w = otid() >> 6;
  const float* g = p.ln_g + layer * DM;
  const float* bb_ = p.ln_b + layer * DM;
  for (int row = obid() * 8 + w; row < M; row += gridDim.x * 8) {
    float* ptr = row < NLAT ? p.out + (size_t)row * DM : p.X1c + (size_t)(row - NLAT) * DM;
    f32x4 v[8];
    float s = 0.f;
#pragma unroll
    for (int i = 0; i < 8; ++i) { v[i] = *(const f32x4*)(ptr + (i * 64 + lane) * 4); s += v[i][0] + v[i][1] + v[i][2] + v[i][3]; }
#pragma unroll
    for (int o = 1; o < 64; o <<= 1) s += __shfl_xor(s, o);
    const float mean = s * (1.f / 2048.f);
    float q = 0.f;
#pragma unroll
    for (int i = 0; i < 8; ++i)
#pragma unroll
      for (int j = 0; j < 4; ++j) { const float dlt = v[i][j] - mean; q += dlt * dlt; }
#pragma unroll
    for (int o = 1; o < 64; o <<= 1) q += __shfl_xor(q, o);
    const float rstd = rsqrtf(q * (1.f / 2048.f) + 1e-5f);
    const int bidx = row < NLAT ? (row >> 12) : 4;
    const float* md = p.mod + ((size_t)5 + bidx) * 6144;
#pragma unroll
    for (int i = 0; i < 8; ++i) {
      const int c = (i * 64 + lane) * 4;
      f32x4 gg = *(const f32x4*)(g + c), bbv = *(const f32x4*)(bb_ + c), y;
#pragma unroll
      for (int j = 0; j < 4; ++j) y[j] = (v[i][j] - mean) * rstd * gg[j] + bbv[j];
      *(f32x4*)(ptr + c) = y;
      if (layer == 0) {
        f32x4 sh = *(const f32x4*)(md + c), scl = *(const f32x4*)(md + 2048 + c);
        u32x2 o;
        o[0] = pk2(y[0] * (1.f + scl[0]) + sh[0], y[1] * (1.f + scl[1]) + sh[1]);
        o[1] = pk2(y[2] * (1.f + scl[2]) + sh[2], y[3] * (1.f + scl[3]) + sh[3]);
        *(u32x2*)(p.H + (size_t)row * DM + c) = o;
      }
    }
  }
}

#define XB_TMO      128
#define XB_XCNT(j)  (256  + 64 * (j))
#define XB_XSUB(j)  (1280 + 64 * (j))
#define XB_XGEN(j)  (2304 + 64 * (j))
#define XB_TOP      3328
#define XB_TOPGEN   3392
#define XCD_BAR_WORDS 3456
#define XB_SPIN_CAP (1u << 18)
#define LAS __attribute__((address_space(3)))

__device__ __forceinline__ unsigned xb_ld(unsigned* p)              { return __hip_atomic_load(p, __ATOMIC_RELAXED, __HIP_MEMORY_SCOPE_AGENT); }
__device__ __forceinline__ unsigned xb_add(unsigned* p, unsigned v) { return __hip_atomic_fetch_add(p, v, __ATOMIC_RELAXED, __HIP_MEMORY_SCOPE_AGENT); }
__device__ __forceinline__ unsigned xb_xcc_id() { return (unsigned)__builtin_amdgcn_s_getreg((3 << 11) | 20) & 0xFu; }
#define XB_SPIN(cond, bar) do { unsigned _sp = 0; while (cond) { __builtin_amdgcn_s_sleep(1); \
    if ((++_sp & 255u) == 0u) { if (xb_ld(&(bar)[XB_TMO])) break; if (_sp > XB_SPIN_CAP) { atomicAdd(&(bar)[XB_TMO], 1u); break; } } } } while (0)

struct XcdBarrier {
    unsigned* bar; unsigned x;
    volatile LAS unsigned* st;
};

__device__ __forceinline__ XcdBarrier xcd_barrier_post(unsigned* bar, volatile LAS unsigned* st) {
    XcdBarrier b; b.bar = bar; b.x = xb_xcc_id(); b.st = st;
    if (threadIdx.x == 0) (void)xb_add(&bar[XB_XCNT(b.x)], 1u);
    return b;
}
__device__ __forceinline__ void xcd_barrier_complete(unsigned* bar, unsigned x, unsigned& nloc, unsigned& nx) {
    const unsigned G = gridDim.x * gridDim.y * gridDim.z;
    unsigned sum, cnt, mine, sp = 0u;
    for (;;) {
        sum = 0u; cnt = 0u; mine = 0u;
#pragma unroll
        for (unsigned j = 0; j < 16; ++j) { const unsigned c = xb_ld(&bar[XB_XCNT(j)]); sum += c; cnt += (c > 0u) ? 1u : 0u; mine = (j == x) ? c : mine; }
        if (sum == G) break;
        __builtin_amdgcn_s_sleep(1);
        if ((++sp & 255u) == 0u) { if (xb_ld(&bar[XB_TMO])) break; if (sp > XB_SPIN_CAP) { atomicAdd(&bar[XB_TMO], 1u); break; } }
    }
    nloc = mine > 0u ? mine : 1u; nx = cnt > 0u ? cnt : 1u;
}

__device__ __forceinline__ void xcd_barrier(const XcdBarrier& b) {
    asm volatile("s_waitcnt vmcnt(0)" ::: "memory");
    __syncthreads();
    if (threadIdx.x == 0) {
        unsigned* bar = b.bar;
        __builtin_amdgcn_s_waitcnt(0);
        unsigned nloc = b.st[0], nx = b.st[1];
        if (nloc == 0u) { xcd_barrier_complete(bar, b.x, nloc, nx); b.st[0] = nloc; b.st[1] = nx; }
        const unsigned old = xb_add(&bar[XB_XSUB(b.x)], 1u);
        const unsigned gen = old / nloc;
        if (old + 1u == (gen + 1u) * nloc) {
            __builtin_amdgcn_fence(__ATOMIC_RELEASE, "agent");
            asm volatile("s_waitcnt vmcnt(0)" ::: "memory");
            const unsigned og = xb_add(&bar[XB_TOP], 1u);
            const unsigned tg = og / nx;
            if (og + 1u == (tg + 1u) * nx) xb_add(&bar[XB_TOPGEN], 1u);
            else XB_SPIN(xb_ld(&bar[XB_TOPGEN]) == tg, bar);
            __builtin_amdgcn_fence(__ATOMIC_ACQUIRE, "agent");
            xb_add(&bar[XB_XGEN(b.x)], 1u);
            asm volatile("s_waitcnt vmcnt(0)" ::: "memory");
        } else {
            XB_SPIN(xb_ld(&bar[XB_XGEN(b.x)]) == gen, bar);
            __builtin_amdgcn_fence(__ATOMIC_ACQUIRE, "agent");
            asm volatile("s_waitcnt vmcnt(0)" ::: "memory");
        }
    }
    __syncthreads();
}


__global__ void __launch_bounds__(NTHR) hybrid_block_megakernel(KP p) {
  extern __shared__ __attribute__((aligned(16))) char smem[];
  cg::grid_group grid = cg::this_grid();
  __shared__ int s_item;
  const int tid = otid();
  __shared__ uint4 xb_words;
  if (threadIdx.x == 0) xb_words = make_uint4(0u, 0u, 0u, 0u);
  __syncthreads();
  const XcdBarrier xb = xcd_barrier_post(p.cnt + 128, (volatile LAS unsigned*)&xb_words);

  mod_phase(p, smem);
  convert_weights(p, 0, smem);
  grid.sync();
  h0_phase(p);
  xcd_barrier(xb);

  for (int layer = 0; layer < 2; ++layer) {
    const int Mq = layer == 0 ? NTOK : NLAT;
    for (int it = obid(); it < 68 * 25; it += gridDim.x) {
      const int nt = it / 68, mt = it % 68;
      gemm_tile(p, 0, layer, mt * 256, nt * 256, smem);
    }
    xcd_barrier(xb);
    {
      const int n_uq = (Mq / 256) * 6, n_ukv = 68 * 8, n_kr = NTOK / 8;
      for (int it = obid(); it < n_uq + n_ukv + n_kr; it += gridDim.x) {
        if (it < n_uq) gemm_tile(p, 1, layer, (it / 6) * 256, (it % 6) * 256, smem);
        else if (it < n_uq + n_ukv) { const int i = it - n_uq; gemm_tile(p, 2, layer, (i / 8) * 256, (i % 8) * 256, smem); }
        else krope_item(p, it - n_uq - n_ukv);
      }
    }
    xcd_barrier(xb);
    {
      for (int ch = obid(); ch < 160; ch += gridDim.x) {
        if (ch < 128) rwkv_chain(p, layer, ch, smem); else ret_chain(p, layer, ch - 128, smem);
      }
      const int n_att = layer == 0 ? 512 + 32 : 512;
      while (true) {
        __syncthreads();
        if (tid == 0) s_item = (int)atomicAdd(&p.cnt[layer], 1u);
        __syncthreads();
        const int it = s_item;
        if (it >= n_att) break;
        if (it < 512) {
          const int b = it >> 7, hd = (it >> 4) & 7, qb = it & 15;
          attn_item(p, b * 4096 + qb * 256, b, hd, LPOS, smem);
        } else {
          const int i = it - 512, b = i >> 3, hd = i & 7;
          attn_item(p, NLAT + b * 256, b, hd, 256, smem);
        }
      }
    }
    xcd_barrier(xb);
    merge_phase(p, layer, Mq);
    xcd_barrier(xb);
    for (int it = obid(); it < (Mq / 256) * 8; it += gridDim.x) {
      const int nt = it % 8, mt = it / 8;
      gemm_tile(p, 3, layer, mt * 256, nt * 256, smem);
    }
    xcd_barrier(xb);
    ln_phase(p, layer, Mq);
    if (layer == 0) {
      convert_weights(p, 1, smem);
      xcd_barrier(xb);
    }
  }
}

extern "C" void kernel_launch(void* const* d_in, const int* in_sizes, int n_in, void* d_out, int out_size, void* d_ws,
                              size_t ws_size, hipStream_t stream) {
  static int grid_blocks = 0;
  if (!grid_blocks) {
    int dev = 0, cus = 0, per_cu = 0;
    hipGetDevice(&dev);
    hipDeviceGetAttribute(&cus, hipDeviceAttributeMultiprocessorCount, dev);
    hipFuncSetAttribute((const void*)hybrid_block_megakernel, hipFuncAttributeMaxDynamicSharedMemorySize, (int)LDS_BYTES);
    hipOccupancyMaxActiveBlocksPerMultiprocessor(&per_cu, hybrid_block_megakernel, NTHR, LDS_BYTES);
    if (per_cu > 1) per_cu = 1;
    grid_blocks = cus * per_cu;
  }
  KP p{};
  const float* const* in = (const float* const*)d_in;
  p.x = in[0]; p.c = in[1]; p.ctx = in[2]; p.c_ctx = in[3]; p.w_ada = in[4]; p.b_ada = in[5]; p.w_in = in[6];
  p.ret_logit = in[7]; p.ret_gn = in[8]; p.q_g = in[9]; p.w_uq = in[10]; p.kv_g = in[11]; p.w_ukv = in[12]; p.mu = in[13];
  p.w0 = in[14]; p.w2 = in[15]; p.a0 = in[16]; p.a2 = in[17]; p.k_k = in[18]; p.k_a = in[19]; p.r_k = in[20]; p.rw_gn = in[21];
  p.w_out = in[22]; p.ln_g = in[23]; p.ln_b = in[24];
  p.out = (float*)d_out;
  char* ws = (char*)d_ws;
  size_t off = 0;
  auto take = [&](size_t bytes) { char* r = ws + off; off += (bytes + 255) & ~(size_t)255; return r; };
  p.P = (u16*)take((size_t)NTOK * NIN * 2);
  p.H = (u16*)take((size_t)NTOK * DM * 2);
  p.Q = (u16*)take((size_t)NTOK * 1536 * 2);
  p.Kn = (u16*)take((size_t)4 * 8 * LPOS * 128 * 2);
  p.Vt = (u16*)take((size_t)4 * 8 * 128 * LPOS * 2);
  p.Kr = (u16*)take((size_t)4 * LPOS * 64 * 2);
  p.Yret = (u16*)take((size_t)2 * NTOK * 512 * 2);
  p.Yrw = (u16*)take((size_t)2 * NTOK * 512 * 2);
  p.WinT = (u16*)take((size_t)NIN * DM * 2);
  p.WuqT = (u16*)take((size_t)1536 * 512 * 2);
  p.WukvT = (u16*)take((size_t)2048 * 256 * 2);
  p.WoutT = (u16*)take((size_t)DM * DM * 2);
  p.W2T = (u16*)take((size_t)2 * 512 * 64 * 2);
  p.A2T = (u16*)take((size_t)2 * 512 * 64 * 2);
  p.X1c = (float*)take((size_t)1024 * DM * 4);
  p.mod = (float*)take((size_t)2 * 5 * 6144 * 4);
  p.cnt = (unsigned*)take(512 + XCD_BAR_WORDS * 4);
  if (off > ws_size) { fprintf(stderr, "workspace too small: need %zu have %zu\n", off, ws_size); return; }
  hipMemsetAsync(p.cnt, 0, 512 + XCD_BAR_WORDS * 4, stream);
  void* args[] = {&p};
  hipError_t e = hipLaunchCooperativeKernel((void*)hybrid_block_megakernel, dim3(grid_blocks), dim3(NTHR), args, LDS_BYTES, stream);
  if (e != hipSuccess) fprintf(stderr, "cooperative launch failed: %s (grid %d)\n", hipGetErrorString(e), grid_blocks);
}
```

```cpp
#include <hip/hip_runtime.h>
#include <hip/hip_cooperative_groups.h>
#include <cstdio>
namespace cg = cooperative_groups;

#define DI __device__ __forceinline__
typedef unsigned short u16;
using bf16x8 = __attribute__((ext_vector_type(8))) short;
using s16x4 = __attribute__((ext_vector_type(4))) short;
using f32x16 = __attribute__((ext_vector_type(16))) float;
using f32x4 = __attribute__((ext_vector_type(4))) float;
using u32x4 = __attribute__((ext_vector_type(4))) unsigned;
using u32x2 = __attribute__((ext_vector_type(2))) unsigned;
using f32x2 = __attribute__((ext_vector_type(2))) float;
#define MFMA(a, b, c) __builtin_amdgcn_mfma_f32_32x32x16_bf16((a), (b), (c), 0, 0, 0)

constexpr int DM = 2048, NIN = 6208, NLAT = 16384, NTOK = 17408, LPOS = 4352;
constexpr int NTHR = 512;
constexpr size_t LDS_BYTES = 149504;
constexpr float ALPHA = 1.4142135623730951f;
constexpr float QSCALE = 0.07216878364870323f * 1.4426950408889634f;

struct KP {
  const float *x, *c, *ctx, *c_ctx, *w_ada, *b_ada, *w_in, *ret_logit, *ret_gn, *q_g, *w_uq, *kv_g, *w_ukv, *mu, *w0, *w2, *a0,
      *a2, *k_k, *k_a, *r_k, *rw_gn, *w_out, *ln_g, *ln_b;
  float* out;
  u16 *P, *H, *Q, *Kn, *Vt, *Kr, *Yret, *Yrw, *WinT, *WuqT, *WukvT, *WoutT, *W2T, *A2T;
  float *X1c, *mod;
  unsigned* cnt;
};

DI int otid() { int t = threadIdx.x; asm volatile("" : "+v"(t)); return t; }
DI int obid() { int t = blockIdx.x; asm volatile("" : "+s"(t)); return t; }
template <int CTRL> DI float dppf(float v) {
  return __builtin_bit_cast(float, __builtin_amdgcn_update_dpp(0, __builtin_bit_cast(int, v), CTRL, 0xf, 0xf, true));
}
DI float sum8(float x) { x += dppf<0xB1>(x); x += dppf<0x4E>(x); x += dppf<0x141>(x); return x; }
DI float sum16(float x) { x += dppf<0xB1>(x); x += dppf<0x4E>(x); x += dppf<0x141>(x); x += dppf<0x140>(x); return x; }
DI void lds_barrier() { asm volatile("s_waitcnt lgkmcnt(0)\n\ts_barrier" ::: "memory"); }
DI float bf2f(u16 v) { return __uint_as_float(((unsigned)v) << 16); }
DI float bflo(unsigned v) { return __uint_as_float(v << 16); }
DI float bfhi(unsigned v) { return __uint_as_float(v & 0xffff0000u); }
DI u16 f2bf(float a) { __bf16 r = (__bf16)a; return __builtin_bit_cast(u16, r); }
DI unsigned pk2(float a, float b) {
  typedef __bf16 bf2 __attribute__((ext_vector_type(2)));
  typedef float f2 __attribute__((ext_vector_type(2)));
  f2 v = {a, b};
  bf2 r = __builtin_convertvector(v, bf2);
  return __builtin_bit_cast(unsigned, r);
}
DI int crow(int reg, int h) { return (reg & 3) + 8 * (reg >> 2) + 4 * h; }
DI float silu(float x) { return x / (1.f + __expf(-x)); }
DI void unpack8(const bf16x8& v, float* f) {
  u32x4 u = __builtin_bit_cast(u32x4, v);
#pragma unroll
  for (int i = 0; i < 4; ++i) { f[2 * i] = bflo(u[i]); f[2 * i + 1] = bfhi(u[i]); }
}
DI bf16x8 pack8(const float* f) {
  u32x4 u;
#pragma unroll
  for (int i = 0; i < 4; ++i) u[i] = pk2(f[2 * i], f[2 * i + 1]);
  return __builtin_bit_cast(bf16x8, u);
}
DI bf16x8 ld8(const u16* p) { return *(const bf16x8*)p; }
DI bf16x8 zero8() { bf16x8 z = {0, 0, 0, 0, 0, 0, 0, 0}; return z; }
DI f32x16 zero16() { f32x16 z; for (int i = 0; i < 16; ++i) z[i] = 0.f; return z; }
DI s16x4 trread(const u16* p) {
  return __builtin_amdgcn_ds_read_tr16_b64_v4i16((s16x4 __attribute__((address_space(3)))*)(p));
}
DI bf16x8 cat4(s16x4 lo, s16x4 hi) { return __builtin_shufflevector(lo, hi, 0, 1, 2, 3, 4, 5, 6, 7); }
DI void rope_cs(int pos, int i, float& cs, float& sn) {
  float inv = exp2f(-(float)i * (13.287712379549449f / 16.f));
  float rev = (float)pos * inv * 0.15915494309189535f;
  rev -= floorf(rev);
  cs = __builtin_amdgcn_cosf(rev);
  sn = __builtin_amdgcn_sinf(rev);
}

DI void transpose_item(const float* src, u16* dst, int K, int N, int kt, int nt, char* smem) {
  float* tile = (float*)smem;
  const int tid = otid();
  __syncthreads();
  {
    const int kk = tid >> 4, n4 = tid & 15;
#pragma unroll
    for (int i = 0; i < 2; ++i) {
      const int k = kk + 32 * i;
      f32x4 v = *(const f32x4*)(src + (size_t)(kt * 64 + k) * N + nt * 64 + n4 * 4);
      tile[k * 65 + n4 * 4 + 0] = v[0]; tile[k * 65 + n4 * 4 + 1] = v[1];
      tile[k * 65 + n4 * 4 + 2] = v[2]; tile[k * 65 + n4 * 4 + 3] = v[3];
    }
  }
  __syncthreads();
  {
    const int n = tid >> 3, k8 = tid & 7;
    float f[8];
#pragma unroll
    for (int j = 0; j < 8; ++j) f[j] = tile[(k8 * 8 + j) * 65 + n];
    *(bf16x8*)(dst + (size_t)(nt * 64 + n) * K + kt * 64 + k8 * 8) = pack8(f);
  }
}

DI void convert_weights(const KP& p, int layer, char* smem) {
  const int n_in = 32 * 97, n_uq = 8 * 24, n_ukv = 4 * 32, n_out = 32 * 32, n_lora = 8;
  const int total = n_in + n_uq + n_ukv + n_out + 4 * n_lora;
  for (int it = obid(); it < total; it += gridDim.x) {
    int i = it;
    if (i < n_in) { transpose_item(p.w_in + (size_t)layer * DM * NIN, p.WinT, DM, NIN, i / 97, i % 97, smem); continue; }
    i -= n_in;
    if (i < n_uq) { transpose_item(p.w_uq + (size_t)layer * 512 * 1536, p.WuqT, 512, 1536, i / 24, i % 24, smem); continue; }
    i -= n_uq;
    if (i < n_ukv) { transpose_item(p.w_ukv + (size_t)layer * 256 * 2048, p.WukvT, 256, 2048, i / 32, i % 32, smem); continue; }
    i -= n_ukv;
    if (i < n_out) { transpose_item(p.w_out + (size_t)layer * DM * DM, p.WoutT, DM, DM, i / 32, i % 32, smem); continue; }
    i -= n_out;
    {
      const int which = i / (2 * n_lora), r = i % (2 * n_lora), d = r / n_lora, nt = r % n_lora;
      const float* src = (which ? p.a2 : p.w2) + ((size_t)layer * 2 + d) * 64 * 512;
      u16* dst = (which ? p.A2T : p.W2T) + (size_t)d * 512 * 64;
      transpose_item(src, dst, 64, 512, 0, nt, smem);
    }
  }
}

DI void mod_phase(const KP& p, char* smem) {
  float* sc = (float*)smem;
  float* red = sc + 5 * 2048;
  const int tid = otid();
  __syncthreads();
  for (int i = tid; i < 5 * 2048; i += NTHR) {
    float v = i < 4 * 2048 ? p.c[i] : p.c_ctx[i - 4 * 2048];
    sc[i] = silu(v);
  }
  __syncthreads();
  const int kg = tid >> 5, col = tid & 31;
  for (int it = obid(); it < 384; it += gridDim.x) {
    const int layer = it / 192, j = (it % 192) * 32 + col;
    const float* w = p.w_ada + (size_t)layer * DM * 6144 + j;
    float acc[5] = {0.f, 0.f, 0.f, 0.f, 0.f};
    for (int k = kg * 128; k < kg * 128 + 128; k += 16) {
      float wv[16];
#pragma unroll
      for (int u = 0; u < 16; ++u) wv[u] = w[(size_t)(k + u) * 6144];
#pragma unroll
      for (int u = 0; u < 16; ++u)
#pragma unroll
        for (int r = 0; r < 5; ++r) acc[r] += sc[r * 2048 + k + u] * wv[u];
    }
#pragma unroll
    for (int r = 0; r < 5; ++r) red[(kg * 5 + r) * 32 + col] = acc[r];
    __syncthreads();
    if (tid < 160) {
      const int r = tid >> 5;
      float s = p.b_ada[(size_t)layer * 6144 + j];
      for (int g = 0; g < 16; ++g) s += red[(g * 5 + r) * 32 + col];
      p.mod[((size_t)layer * 5 + r) * 6144 + j] = s;
    }
    __syncthreads();
  }
}

DI void h0_phase(const KP& p) {
  const int lane = otid() & 63, w = otid() >> 6;
  for (int row = obid() * 8 + w; row < NTOK; row += gridDim.x * 8) {
    const float* src = row < NLAT ? p.x + (size_t)row * DM : p.ctx + (size_t)(row - NLAT) * DM;
    const int bb = row < NLAT ? (row >> 12) : 4;
    const float* md = p.mod + (size_t)bb * 6144;
#pragma unroll
    for (int i = 0; i < 8; ++i) {
      const int c = (i * 64 + lane) * 4;
      f32x4 v = *(const f32x4*)(src + c), sh = *(const f32x4*)(md + c), scl = *(const f32x4*)(md + 2048 + c);
      u32x2 o;
      o[0] = pk2(v[0] * (1.f + scl[0]) + sh[0], v[1] * (1.f + scl[1]) + sh[1]);
      o[1] = pk2(v[2] * (1.f + scl[2]) + sh[2], v[3] * (1.f + scl[3]) + sh[3]);
      *(u32x2*)(p.H + (size_t)row * DM + c) = o;
    }
  }
}

DI void gemm_tile(const KP& p, int mode, int layer, int m0, int n0, char* smem) {
  constexpr int STG = 512 * 72;
  u16* base = (u16*)smem;
  float* rs = (float*)(base + 2 * STG);
  const int tid = otid(), lane = tid & 63, w = tid >> 6, wm = w >> 2, wn = w & 3, l31 = lane & 31, h = lane >> 5;
  const u16* A; const u16* Bt; const float* gv = nullptr; int lda, K, N;
  if (mode == 0) { A = p.H; lda = DM; K = DM; N = NIN; Bt = p.WinT; }
  else if (mode == 1) { A = p.P + 2048; lda = NIN; K = 512; N = 1536; Bt = p.WuqT; gv = p.q_g + layer * 512; }
  else if (mode == 2) { A = p.P + 2560; lda = NIN; K = 256; N = 2048; Bt = p.WukvT; gv = p.kv_g + layer * 256; }
  else { A = p.H; lda = DM; K = DM; N = DM; Bt = p.WoutT; }
  const bool xf = (mode == 1 || mode == 2);
  const bool active = (n0 + wn * 64) < N;
  __syncthreads();
  if (xf) {
    const int r = tid >> 1, part = tid & 1;
    const u16* src = A + (size_t)(m0 + r) * lda + part * (K >> 1);
    float ss = 0.f;
    for (int i = 0; i < (K >> 1); i += 8) {
      float f[8]; unpack8(ld8(src + i), f);
#pragma unroll
      for (int j = 0; j < 8; ++j) ss += f[j] * f[j];
    }
    ss += __shfl_xor(ss, 1);
    if (!part) rs[r] = rsqrtf(ss / (float)K + 1e-6f);
    __syncthreads();
  }
  f32x16 acc[4][2];
#pragma unroll
  for (int i = 0; i < 4; ++i)
#pragma unroll
    for (int j = 0; j < 2; ++j) acc[i][j] = zero16();
  bf16x8 ra[4], rb[4];
  const int arow = tid >> 3, ac = tid & 7;
  auto loadg = [&](int k0) {
#pragma unroll
    for (int i = 0; i < 4; ++i) {
      const int row = arow + 64 * i;
      bf16x8 v = ld8(A + (size_t)(m0 + row) * lda + k0 + ac * 8);
      if (xf) {
        float f[8]; unpack8(v, f);
        const float sc = rs[row];
        f32x4 g0 = *(const f32x4*)(gv + k0 + ac * 8), g1 = *(const f32x4*)(gv + k0 + ac * 8 + 4);
#pragma unroll
        for (int j = 0; j < 4; ++j) { f[j] *= sc * g0[j]; f[4 + j] *= sc * g1[j]; }
        v = pack8(f);
      }
      ra[i] = v;
    }
#pragma unroll
    for (int i = 0; i < 4; ++i) {
      int nrow = n0 + arow + 64 * i;
      nrow = nrow < N ? nrow : N - 1;
      rb[i] = ld8(Bt + (size_t)nrow * K + k0 + ac * 8);
    }
  };
  auto stage = [&](int buf) {
    u16* As = base + buf * STG;
    u16* Bs = As + 256 * 72;
#pragma unroll
    for (int i = 0; i < 4; ++i) *(bf16x8*)(As + (arow + 64 * i) * 72 + ac * 8) = ra[i];
#pragma unroll
    for (int i = 0; i < 4; ++i) *(bf16x8*)(Bs + (arow + 64 * i) * 72 + ac * 8) = rb[i];
  };
  loadg(0);
  stage(0);
  __syncthreads();
  const int nk = K >> 6;
  for (int kt = 0; kt < nk; ++kt) {
    const u16* As = base + (kt & 1) * STG;
    const u16* Bs = As + 256 * 72;
    if (kt + 1 < nk) loadg((kt + 1) * 64);
    if (active) {
#pragma unroll
      for (int ks = 0; ks < 4; ++ks) {
        bf16x8 bfr[2], afr[4];
#pragma unroll
        for (int ni = 0; ni < 2; ++ni) bfr[ni] = ld8(Bs + (wn * 64 + ni * 32 + l31) * 72 + ks * 16 + h * 8);
#pragma unroll
        for (int mi = 0; mi < 4; ++mi) afr[mi] = ld8(As + (wm * 128 + mi * 32 + l31) * 72 + ks * 16 + h * 8);
#pragma unroll
        for (int mi = 0; mi < 4; ++mi)
#pragma unroll
          for (int ni = 0; ni < 2; ++ni) acc[mi][ni] = MFMA(afr[mi], bfr[ni], acc[mi][ni]);
      }
    }
    if (kt + 1 < nk) stage((kt + 1) & 1);
    __syncthreads();
  }
#pragma unroll
  for (int mi = 0; mi < 4; ++mi)
#pragma unroll
    for (int ni = 0; ni < 2; ++ni) {
      const int cb = n0 + wn * 64 + ni * 32;
      if (cb >= N) continue;
      const int col = cb + l31;
      const int rb0 = m0 + wm * 128 + mi * 32;
      const f32x16& a = acc[mi][ni];
      if (mode == 0) {
#pragma unroll
        for (int r = 0; r < 16; ++r) p.P[(size_t)(rb0 + crow(r, h)) * NIN + col] = f2bf(a[r]);
      } else if (mode == 1) {
        const int dd = cb % 192;
        const bool rope = (dd >= 128) && (rb0 < NLAT);
        const int part = (dd - 128) >> 5;
#pragma unroll
        for (int r = 0; r < 16; ++r) {
          const int row = rb0 + crow(r, h);
          float v = a[r] * QSCALE;
          if (rope) {
            const int t = row & 4095;
            const int pos = part ? (t & 63) : (t >> 6);
            float cs, sn; rope_cs(pos, l31 & 15, cs, sn);
            const float pr = __shfl_xor(v, 16);
            v = (l31 < 16) ? (v * cs - pr * sn) : (v * cs + pr * sn);
          }
          p.Q[(size_t)row * 1536 + col] = f2bf(v);
        }
      } else if (mode == 2) {
        const int head = col >> 8, dd = col & 255;
#pragma unroll
        for (int g = 0; g < 4; ++g) {
          const int row = rb0 + 8 * g + 4 * h;
          int b, pos;
          if (row < NLAT) { b = row >> 12; pos = 256 + (row & 4095); } else { b = (row - NLAT) >> 8; pos = (row - NLAT) & 255; }
          if (dd < 128) {
#pragma unroll
            for (int j = 0; j < 4; ++j) p.Kn[((size_t)(b * 8 + head) * LPOS + pos + j) * 128 + dd] = f2bf(a[4 * g + j]);
          } else {
            u32x2 o; o[0] = pk2(a[4 * g], a[4 * g + 1]); o[1] = pk2(a[4 * g + 2], a[4 * g + 3]);
            *(u32x2*)(p.Vt + ((size_t)(b * 8 + head) * 128 + (dd - 128)) * LPOS + pos) = o;
          }
        }
      } else {
#pragma unroll
        for (int r = 0; r < 16; ++r) {
          const int row = rb0 + crow(r, h);
          const int bb = row < NLAT ? (row >> 12) : 4;
          const float gate = p.mod[((size_t)layer * 5 + bb) * 6144 + 4096 + col];
          float xv;
          float* dst;
          if (row < NLAT) {
            dst = p.out + (size_t)row * DM + col;
            xv = layer == 0 ? p.x[(size_t)row * DM + col] : *dst;
          } else {
            dst = p.X1c + (size_t)(row - NLAT) * DM + col;
            xv = p.ctx[(size_t)(row - NLAT) * DM + col];
          }
          *dst = ALPHA * xv + gate * a[r];
        }
      }
    }
}

DI void krope_item(const KP& p, int it) {
  const int tid = otid(), tok = tid >> 6, dim = tid & 63;
  const int row = it * 8 + tok;
  const u16* src = p.P + (size_t)row * NIN + 2816;
  float v = bf2f(src[dim]);
  int b, pos;
  if (row < NLAT) {
    const float pr = bf2f(src[dim ^ 16]);
    const int t = row & 4095, part = dim >> 5;
    const int ps = part ? (t & 63) : (t >> 6);
    float cs, sn; rope_cs(ps, dim & 15, cs, sn);
    v = ((dim & 31) < 16) ? (v * cs - pr * sn) : (v * cs + pr * sn);
    b = row >> 12; pos = 256 + t;
  } else { b = (row - NLAT) >> 8; pos = (row - NLAT) & 255; }
  p.Kr[((size_t)b * LPOS + pos) * 64 + dim] = f2bf(v);
}

DI void attn_item(const KP& p, int qrow0, int b, int hd, int nkeys, char* smem) {
  constexpr int STG = 64 * 200 + 128 * 72;
  u16* base = (u16*)smem;
  const int tid = otid(), lane = tid & 63, w = tid >> 6, l31 = lane & 31, h = lane >> 5;
  const int qrow = qrow0 + 32 * w + l31;
  bf16x8 qf[12];
  {
    const u16* qp = p.Q + (size_t)qrow * 1536 + hd * 192 + 8 * h;
#pragma unroll
    for (int ks = 0; ks < 12; ++ks) qf[ks] = ld8(qp + 16 * ks);
  }
  f32x16 o[4];
#pragma unroll
  for (int i = 0; i < 4; ++i) o[i] = zero16();
  float m = -1e30f, lsum = 0.f;
  const u16* kn = p.Kn + (size_t)(b * 8 + hd) * LPOS * 128;
  const u16* kr = p.Kr + (size_t)b * LPOS * 64;
  const u16* vt = p.Vt + (size_t)(b * 8 + hd) * 128 * LPOS;
  int kkey[3], kc[3];
#pragma unroll
  for (int i = 0; i < 3; ++i) { const int idx = tid + NTHR * i; kkey[i] = idx / 24; kc[i] = idx % 24; }
  bf16x8 rk[3], rv[2];
  auto loadg = [&](int kt0) {
#pragma unroll
    for (int i = 0; i < 3; ++i) {
      const u16* src = kc[i] < 16 ? kn + (size_t)(kt0 + kkey[i]) * 128 + kc[i] * 8 : kr + (size_t)(kt0 + kkey[i]) * 64 + (kc[i] - 16) * 8;
      rk[i] = ld8(src);
    }
#pragma unroll
    for (int i = 0; i < 2; ++i) {
      const int idx = tid + NTHR * i, dd = idx >> 3, c = idx & 7;
      rv[i] = ld8(vt + (size_t)dd * LPOS + kt0 + c * 8);
    }
  };
  auto stage = [&](int buf) {
    u16* Ksm = base + buf * STG;
    u16* Vsm = Ksm + 64 * 200;
#pragma unroll
    for (int i = 0; i < 3; ++i) *(bf16x8*)(Ksm + kkey[i] * 200 + kc[i] * 8) = rk[i];
#pragma unroll
    for (int i = 0; i < 2; ++i) {
      const int idx = tid + NTHR * i, dd = idx >> 3, c = idx & 7;
      u32x4 u = __builtin_bit_cast(u32x4, rv[i]);
      u32x2 lo = {u[0], u[1]}, hi = {u[2], u[3]};
      u16* dst = Vsm + dd * 72 + 16 * (c >> 1) + 4 * (c & 1);
      *(u32x2*)dst = lo;
      *(u32x2*)(dst + 8) = hi;
    }
  };
  __syncthreads();
  loadg(0);
  stage(0);
  __syncthreads();
  const int ntile = nkeys >> 6;
  for (int t = 0; t < ntile; ++t) {
    const u16* Ksm = base + (t & 1) * STG;
    const u16* Vsm = Ksm + 64 * 200;
    if (t + 1 < ntile) loadg((t + 1) * 64);
    f32x16 s[2];
#pragma unroll
    for (int kt = 0; kt < 2; ++kt) {
      s[kt] = zero16();
#pragma unroll
      for (int ks = 0; ks < 12; ++ks) {
        bf16x8 a = ld8(Ksm + (kt * 32 + l31) * 200 + ks * 16 + h * 8);
        s[kt] = MFMA(a, qf[ks], s[kt]);
        if ((ks & 3) == 3) asm volatile("" ::: "memory");
      }
    }
    float mx = s[0][0];
#pragma unroll
    for (int r = 0; r < 16; ++r) { mx = fmaxf(mx, s[0][r]); mx = fmaxf(mx, s[1][r]); }
    mx = fmaxf(mx, __shfl_xor(mx, 32));
    const float mnew = fmaxf(m, mx);
    const float alpha = __builtin_amdgcn_exp2f(m - mnew);
    m = mnew;
    float ps = 0.f;
#pragma unroll
    for (int kt = 0; kt < 2; ++kt)
#pragma unroll
      for (int r = 0; r < 16; ++r) { float e = __builtin_amdgcn_exp2f(s[kt][r] - mnew); s[kt][r] = e; ps += e; }
    lsum = lsum * alpha + ps;
#pragma unroll
    for (int dt = 0; dt < 4; ++dt)
#pragma unroll
      for (int r = 0; r < 16; ++r) o[dt][r] *= alpha;
#pragma unroll
    for (int kt = 0; kt < 2; ++kt)
#pragma unroll
      for (int sI = 0; sI < 2; ++sI) {
        u32x4 pu;
#pragma unroll
        for (int j = 0; j < 4; ++j) pu[j] = pk2(s[kt][8 * sI + 2 * j], s[kt][8 * sI + 2 * j + 1]);
        const bf16x8 pb = __builtin_bit_cast(bf16x8, pu);
        const int kb = kt * 32 + sI * 16 + 8 * h;
#pragma unroll
        for (int dt = 0; dt < 4; ++dt) o[dt] = MFMA(ld8(Vsm + (dt * 32 + l31) * 72 + kb), pb, o[dt]);
        asm volatile("" ::: "memory");
      }
    if (t + 1 < ntile) stage((t + 1) & 1);
    __syncthreads();
  }
  lsum += __shfl_xor(lsum, 32);
  const float inv = 1.f / lsum;
  const u16* gp = p.P + (size_t)qrow * NIN + 2880 + hd * 128;
  u16* op = p.H + (size_t)qrow * DM + 512 + hd * 128;
#pragma unroll
  for (int dt = 0; dt < 4; ++dt)
#pragma unroll
    for (int g = 0; g < 4; ++g) {
      const int d0 = dt * 32 + 8 * g + 4 * h;
      u32x2 gg = *(const u32x2*)(gp + d0);
      float g0 = bflo(gg[0]), g1 = bfhi(gg[0]), g2 = bflo(gg[1]), g3 = bfhi(gg[1]);
      u32x2 ov;
      ov[0] = pk2(o[dt][4 * g] * inv * silu(g0), o[dt][4 * g + 1] * inv * silu(g1));
      ov[1] = pk2(o[dt][4 * g + 2] * inv * silu(g2), o[dt][4 * g + 3] * inv * silu(g3));
      *(u32x2*)(op + d0) = ov;
    }
}

DI void ret_chain(const KP& p, int layer, int chain, char* smem) {
  const int d = chain >> 4, b = (chain >> 2) & 3, hd = chain & 3;
  u16* Qs = (u16*)smem;
  u16* Ks = Qs + 128 * 136;
  u16* Vs = Ks + 128 * 136;
  u16* Sts = Vs + 128 * 136;
  const int tid = otid(), lane = tid & 63, w = tid >> 6, l31 = lane & 31, h = lane >> 5;
  const int q4 = (lane & 15) >> 2, p4 = lane & 3, blk = (lane >> 4) & 1;
  const float logit = p.ret_logit[(layer * 2 + d) * 4 + hd];
  const float z = -logit;
  const float logg = -(fmaxf(z, 0.f) + log1pf(expf(-fabsf(z))));
  const float lg2 = logg * 1.4426950408889634f;
  const float gC = exp2f(128.f * lg2);
  const float kscale = 0.08838834764831845f;
  const int iw = w & 3, half = w >> 2;
  const int kt = w & 3, vh = w >> 2;
  f32x16 st[2];
  st[0] = zero16(); st[1] = zero16();
  __syncthreads();
  for (int i = tid; i < 128 * 136 / 8; i += NTHR) *(bf16x8*)(Sts + i * 8) = zero8();
  bf16x8 rq[4], rk[4], rv[4];
  const int trow = tid >> 4, tc = tid & 15;
  auto rowbase = [&](int n) -> size_t {
    if (d == 0) return n < 2 ? (size_t)(NLAT + b * 256 + 128 * n) : (size_t)(b * 4096 + 128 * (n - 2));
    return n < 2 ? (size_t)(NLAT + b * 256 + 128 * (1 - n)) : (size_t)(b * 4096 + 128 * (33 - n));
  };
  auto loadg = [&](int n) {
    const size_t rb = rowbase(n);
#pragma unroll
    for (int i = 0; i < 4; ++i) {
      const u16* src = p.P + (rb + trow + 32 * i) * NIN + hd * 128 + tc * 8;
      rq[i] = ld8(src); rk[i] = ld8(src + 512); rv[i] = ld8(src + 1024);
    }
  };
  loadg(0);
  for (int n = 0; n < 34; ++n) {
    const size_t rb = rowbase(n);
#pragma unroll
    for (int i = 0; i < 4; ++i) {
      const int j = trow + 32 * i;
      *(bf16x8*)(Qs + j * 136 + tc * 8) = rq[i];
      *(bf16x8*)(Ks + j * 136 + tc * 8) = rk[i];
      const float zeta = exp2f((d == 0 ? (float)(127 - j) : (float)j) * lg2) * kscale;
      float f[8]; unpack8(rv[i], f);
#pragma unroll
      for (int jj = 0; jj < 8; ++jj) f[jj] *= zeta;
      *(bf16x8*)(Vs + j * 136 + tc * 8) = pack8(f);
    }
    __syncthreads();
    if (n + 1 < 34) loadg(n + 1);
    f32x16 acc[2];
    acc[0] = zero16(); acc[1] = zero16();
    bf16x8 qf[8];
#pragma unroll
    for (int ks = 0; ks < 8; ++ks) qf[ks] = ld8(Qs + (32 * iw + l31) * 136 + 16 * ks + 8 * h);
#pragma unroll
    for (int et = 0; et < 2; ++et)
#pragma unroll
      for (int ks = 0; ks < 8; ++ks) {
        bf16x8 a = ld8(Sts + (32 * (2 * half + et) + l31) * 136 + 16 * ks + 8 * h);
        acc[et] = MFMA(a, qf[ks], acc[et]);
      }
#pragma unroll
    for (int et = 0; et < 2; ++et)
#pragma unroll
      for (int r = 0; r < 16; ++r) acc[et][r] *= gC;
    const int ii = 32 * iw + l31;
#pragma unroll
    for (int jt = 0; jt < 4; ++jt) {
      f32x16 sT = zero16();
#pragma unroll
      for (int ks = 0; ks < 8; ++ks) {
        bf16x8 a = ld8(Ks + (32 * jt + l31) * 136 + 16 * ks + 8 * h);
        sT = MFMA(a, qf[ks], sT);
      }
#pragma unroll
      for (int r = 0; r < 16; ++r) {
        const int j = 32 * jt + crow(r, h);
        const bool keep = d == 0 ? (ii >= j) : (j >= ii);
        sT[r] = keep ? sT[r] : 0.f;
      }
#pragma unroll
      for (int sI = 0; sI < 2; ++sI) {
        u32x4 pu;
#pragma unroll
        for (int j = 0; j < 4; ++j) pu[j] = pk2(sT[8 * sI + 2 * j], sT[8 * sI + 2 * j + 1]);
        const bf16x8 pb = __builtin_bit_cast(bf16x8, pu);
        const int j0 = 32 * jt + 16 * sI + 4 * h;
#pragma unroll
        for (int et = 0; et < 2; ++et) {
          const u16* vp = Vs + (j0 + q4) * 136 + 32 * (2 * half + et) + 16 * blk + 4 * p4;
          s16x4 lo = trread(vp), hi = trread(vp + 8 * 136);
          acc[et] = MFMA(cat4(lo, hi), pb, acc[et]);
        }
      }
    }
    {
      const float rho = exp2f((d == 0 ? (float)(ii - 127) : (float)(-ii)) * lg2);
      u16* yp = p.Yret + ((size_t)d * NTOK + rb + ii) * 512 + hd * 128;
#pragma unroll
      for (int et = 0; et < 2; ++et)
#pragma unroll
        for (int g = 0; g < 4; ++g) {
          const int e0 = 32 * (2 * half + et) + 8 * g + 4 * h;
          u32x2 ov;
          ov[0] = pk2(acc[et][4 * g] * rho, acc[et][4 * g + 1] * rho);
          ov[1] = pk2(acc[et][4 * g + 2] * rho, acc[et][4 * g + 3] * rho);
          *(u32x2*)(yp + e0) = ov;
        }
    }
#pragma unroll
    for (int vi = 0; vi < 2; ++vi)
#pragma unroll
      for (int r = 0; r < 16; ++r) st[vi][r] *= gC;
#pragma unroll
    for (int ks = 0; ks < 8; ++ks) {
      const int jb = 16 * ks + 4 * h + q4;
      const u16* kp = Ks + jb * 136 + 32 * kt + 16 * blk + 4 * p4;
      const bf16x8 a = cat4(trread(kp), trread(kp + 8 * 136));
#pragma unroll
      for (int vi = 0; vi < 2; ++vi) {
        const u16* vp = Vs + jb * 136 + 32 * (2 * vh + vi) + 16 * blk + 4 * p4;
        const bf16x8 bfr = cat4(trread(vp), trread(vp + 8 * 136));
        st[vi] = MFMA(a, bfr, st[vi]);
      }
    }
    __syncthreads();
#pragma unroll
    for (int vi = 0; vi < 2; ++vi)
#pragma unroll
      for (int g = 0; g < 4; ++g) {
        const int v = 32 * (2 * vh + vi) + l31, k0 = 32 * kt + 8 * g + 4 * h;
        u32x2 ov;
        ov[0] = pk2(st[vi][4 * g], st[vi][4 * g + 1]);
        ov[1] = pk2(st[vi][4 * g + 2], st[vi][4 * g + 3]);
        *(u32x2*)(Sts + v * 136 + k0) = ov;
      }
  }
}

DI void rwkv_chain(const KP& p, int layer, int item, char* smem) {
  const int chain = item >> 1, vhalf = item & 1;
  const int d = chain >> 5, b = (chain >> 3) & 3, hd = chain & 7;
  float* buf = (float*)smem;
  u16* twS = (u16*)(smem + 98304);
  u16* alS = twS + 32 * 72;
  const int tid = otid(), lane = tid & 63, w = tid >> 6, l31 = lane & 31, h = lane >> 5;
  auto geom = [&](int cc, int& o0, int& len, size_t& rbase) {
    const int j0 = 32 * cc;
    const bool isctx = j0 < 256;
    len = isctx ? 256 : 4096;
    if (d == 0) o0 = isctx ? j0 : j0 - 256; else o0 = isctx ? (224 - j0) : (4064 - (j0 - 256));
    rbase = isctx ? (size_t)(NLAT + b * 256) : (size_t)(b * 4096);
  };
  __syncthreads();
  if (w >= 4) {
    const int pt = tid - 256;
    const int pw = w - 4, mat = pw >> 1, nh = pw & 1;
    const int matu = __builtin_amdgcn_readfirstlane(mat);
    bf16x8 bw[4];
    const int n = hd * 64 + nh * 32 + l31;
    {
      const u16* wT = (mat ? p.A2T : p.W2T) + ((size_t)d * 512 + n) * 64 + 8 * h;
#pragma unroll
      for (int ks = 0; ks < 4; ++ks) bw[ks] = ld8(wT + 16 * ks);
    }
    const float c0 = (mat ? p.a0 : p.w0)[((size_t)layer * 2 + d) * 512 + n];
    const int tok = pt >> 3, c8 = pt & 7;
    int colg[5];
    colg[0] = 3904 + hd * 64 + c8 * 8; colg[1] = 4416 + hd * 64 + c8 * 8; colg[2] = 4928 + hd * 64 + c8 * 8;
    colg[3] = 5440 + d * 64 + c8 * 8; colg[4] = 5568 + d * 64 + c8 * 8;
    const float* mu0 = p.mu + (size_t)layer * 2 * 1792;
    const float* mu1 = mu0 + 1792;
    float m0[5][8], m1[5][8], kkc[8], kac[8];
#pragma unroll
    for (int g = 0; g < 5; ++g)
#pragma unroll
      for (int j = 0; j < 8; ++j) { m0[g][j] = mu0[colg[g] - 3904 + j]; m1[g][j] = mu1[colg[g] - 3904 + j]; }
#pragma unroll
    for (int j = 0; j < 8; ++j) { kkc[j] = p.k_k[layer * 512 + hd * 64 + c8 * 8 + j]; kac[j] = p.k_a[layer * 512 + hd * 64 + c8 * 8 + j]; }
    bf16x8 raw[5][3];
    auto loadraw = [&](int cc) {
      int o0, len; size_t rbase; geom(cc, o0, len, rbase);
      const int o = o0 + tok;
#pragma unroll
      for (int g = 0; g < 5; ++g) {
        const u16* src = p.P + (rbase + o) * NIN + colg[g];
        raw[g][1] = ld8(src);
        raw[g][0] = o > 0 ? ld8(src - NIN) : zero8();
        raw[g][2] = o < len - 1 ? ld8(src + NIN) : zero8();
      }
    };
    loadraw(0);
    for (int cn = 0; cn < 137; ++cn) {
      float* bbase = buf + (cn & 1) * 32 * 384;
      float* bb = bbase + tok * 384;
      if (cn < 136) {
#pragma unroll
        for (int g = 0; g < 5; ++g) {
          float cur[8], prv[8], nxt[8], sh[8];
          unpack8(raw[g][1], cur); unpack8(raw[g][0], prv); unpack8(raw[g][2], nxt);
#pragma unroll
          for (int j = 0; j < 8; ++j) sh[j] = cur[j] + m0[g][j] * (prv[j] - cur[j]) + m1[g][j] * (nxt[j] - cur[j]);
          if (g < 3) {
            float* dst = bb + (g == 0 ? 0 : g == 1 ? 128 : 320) + c8 * 8;
            *(f32x4*)dst = f32x4{sh[0], sh[1], sh[2], sh[3]};
            *(f32x4*)(dst + 4) = f32x4{sh[4], sh[5], sh[6], sh[7]};
          } else if (g == 3) {
#pragma unroll
            for (int j = 0; j < 8; ++j) sh[j] = 1.f - 2.f * __builtin_amdgcn_rcpf(1.f + __expf(2.f * sh[j]));
            *(bf16x8*)(twS + tok * 72 + c8 * 8) = pack8(sh);
          } else {
            *(bf16x8*)(alS + tok * 72 + c8 * 8) = pack8(sh);
          }
        }
      }
      lds_barrier();
      if (cn + 1 < 136) loadraw(cn + 1);
      if (cn < 136) {
        const u16* X = mat ? alS : twS;
        f32x16 acc = zero16();
#pragma unroll
        for (int ks = 0; ks < 4; ++ks) acc = MFMA(ld8(X + l31 * 72 + ks * 16 + h * 8), bw[ks], acc);
        const int ch = nh * 32 + l31;
        float* dstb = bbase + (matu == 0 ? 64 : 256) + ch + 4 * h * 384;
#pragma unroll
        for (int r = 0; r < 16; ++r) {
          float sg = __builtin_amdgcn_rcpf(1.f + __expf(-(c0 + acc[r])));
          if (matu == 0) sg = __expf(-0.6065306597126334f * sg);
          dstb[((r & 3) + 8 * (r >> 2)) * 384] = sg;
        }
      }
      lds_barrier();
      if (cn < 136) {
        float kk[8], kr[8], ar[8];
        float ss = 0.f;
        {
          f32x4 k0 = *(const f32x4*)(bb + 128 + c8 * 8), k1 = *(const f32x4*)(bb + 132 + c8 * 8);
          f32x4 a0 = *(const f32x4*)(bb + 256 + c8 * 8), a1 = *(const f32x4*)(bb + 260 + c8 * 8);
#pragma unroll
          for (int j = 0; j < 4; ++j) { kr[j] = k0[j]; kr[4 + j] = k1[j]; ar[j] = a0[j]; ar[4 + j] = a1[j]; }
        }
#pragma unroll
        for (int j = 0; j < 8; ++j) { kk[j] = kr[j] * kkc[j]; ss += kk[j] * kk[j]; }
        ss = sum8(ss);
        const float inv = fminf(__builtin_amdgcn_rsqf(ss), 1e12f);
        float oa[8], ob[8], ok[8];
#pragma unroll
        for (int j = 0; j < 8; ++j) {
          const float kkn = kk[j] * inv;
          oa[j] = -kkn; ob[j] = kkn * ar[j]; ok[j] = kr[j] * (1.f + (ar[j] - 1.f) * kac[j]);
        }
        *(f32x4*)(bb + 192 + c8 * 8) = f32x4{oa[0], oa[1], oa[2], oa[3]}; *(f32x4*)(bb + 196 + c8 * 8) = f32x4{oa[4], oa[5], oa[6], oa[7]};
        *(f32x4*)(bb + 256 + c8 * 8) = f32x4{ob[0], ob[1], ob[2], ob[3]}; *(f32x4*)(bb + 260 + c8 * 8) = f32x4{ob[4], ob[5], ob[6], ob[7]};
        *(f32x4*)(bb + 128 + c8 * 8) = f32x4{ok[0], ok[1], ok[2], ok[3]}; *(f32x4*)(bb + 132 + c8 * 8) = f32x4{ok[4], ok[5], ok[6], ok[7]};
      }
      lds_barrier();
    }
  } else {
    const int kq = lane & 15, vrow = 32 * vhalf + 8 * w + 2 * (lane >> 4);
    float S0[4], S1[4];
#pragma unroll
    for (int i = 0; i < 4; ++i) { S0[i] = 0.f; S1[i] = 0.f; }
    for (int c = -1; c < 136; ++c) {
      int o0 = 0, len; size_t rbase = 0;
      if (c >= 0) geom(c, o0, len, rbase);
      const float* bbase = buf + (c & 1) * 32 * 384;
      u16* yp = p.Yrw + ((size_t)d * NTOK + rbase + o0) * 512 + hd * 64 + vrow;
#pragma unroll 1
      for (int part = 0; part < 3; ++part) {
        if (c >= 0) {
          const int s0 = part == 0 ? 0 : part == 1 ? 12 : 22, s1 = part == 0 ? 12 : part == 1 ? 22 : 32;
          f32x4 A[5], Bq[5];
          f32x2 va, vb;
          auto ldstep = [&](int s, f32x4 (&R)[5], f32x2& vv) {
            const int i = d ? 31 - s : s;
            const float* t = bbase + i * 384 + 4 * kq;
#pragma unroll
            for (int q = 0; q < 5; ++q) R[q] = *(const f32x4*)(t + 64 * q);
            vv = *(const f32x2*)(bbase + i * 384 + 320 + vrow);
          };
          auto step = [&](const f32x4 (&R)[5], f32x2 vv, int s) {
            const int i = d ? 31 - s : s;
            float sa0 = (S0[0] * R[3][0] + S0[1] * R[3][1]) + (S0[2] * R[3][2] + S0[3] * R[3][3]);
            float sa1 = (S1[0] * R[3][0] + S1[1] * R[3][1]) + (S1[2] * R[3][2] + S1[3] * R[3][3]);
            sa0 = sum16(sa0); sa1 = sum16(sa1);
            float y0 = 0.f, y1 = 0.f;
#pragma unroll
            for (int k = 0; k < 4; ++k) {
              S0[k] = S0[k] * R[1][k] + (sa0 * R[4][k] + vv[0] * R[2][k]);
              S1[k] = S1[k] * R[1][k] + (sa1 * R[4][k] + vv[1] * R[2][k]);
              y0 += S0[k] * R[0][k]; y1 += S1[k] * R[0][k];
            }
            y0 = sum16(y0); y1 = sum16(y1);
            *(unsigned*)(yp + (size_t)i * 512) = pk2(y0, y1);
          };
          ldstep(s0, A, va);
          for (int s = s0; s < s1; s += 2) {
            ldstep(s + 1, Bq, vb);
            step(A, va, s);
            ldstep(s + 2 < 32 ? s + 2 : 31, A, va);
            step(Bq, vb, s + 1);
          }
        }
        lds_barrier();
      }
    }
  }
}

DI void merge_phase(const KP& p, int layer, int M) {
  const int lane = otid() & 63, w = otid() >> 6;
  const float* mu0 = p.mu + (size_t)layer * 2 * 1792;
  const float* mu1 = mu0 + 1792;
  for (int row = obid() * 8 + w; row < M; row += gridDim.x * 8) {
    const int ch0 = lane * 8;
    {
      float y0[8], y1[8], y[8];
      unpack8(ld8(p.Yret + (size_t)row * 512 + ch0), y0);
      unpack8(ld8(p.Yret + ((size_t)NTOK + row) * 512 + ch0), y1);
      float s = 0.f;
#pragma unroll
      for (int j = 0; j < 8; ++j) { y[j] = y0[j] + y1[j]; s += y[j]; }
      s += __shfl_xor(s, 1); s += __shfl_xor(s, 2); s += __shfl_xor(s, 4); s += __shfl_xor(s, 8);
      const float mean = s * (1.f / 128.f);
      float v = 0.f;
#pragma unroll
      for (int j = 0; j < 8; ++j) { const float dlt = y[j] - mean; v += dlt * dlt; }
      v += __shfl_xor(v, 1); v += __shfl_xor(v, 2); v += __shfl_xor(v, 4); v += __shfl_xor(v, 8);
      const float rstd = rsqrtf(v * (1.f / 128.f) + 1e-5f);
      float gt[8], o[8];
      unpack8(ld8(p.P + (size_t)row * NIN + 1536 + ch0), gt);
#pragma unroll
      for (int j = 0; j < 8; ++j) o[j] = (y[j] - mean) * rstd * p.ret_gn[layer * 512 + ch0 + j] * silu(gt[j]);
      *(bf16x8*)(p.H + (size_t)row * DM + ch0) = pack8(o);
    }
    {
      float y0[8], y1[8], y[8];
      unpack8(ld8(p.Yrw + (size_t)row * 512 + ch0), y0);
      unpack8(ld8(p.Yrw + ((size_t)NTOK + row) * 512 + ch0), y1);
      float s = 0.f;
#pragma unroll
      for (int j = 0; j < 8; ++j) { y[j] = y0[j] + y1[j]; s += y[j]; }
      s += __shfl_xor(s, 1); s += __shfl_xor(s, 2); s += __shfl_xor(s, 4);
      const float mean = s * (1.f / 64.f);
      float v = 0.f;
#pragma unroll
      for (int j = 0; j < 8; ++j) { const float dlt = y[j] - mean; v += dlt * dlt; }
      v += __shfl_xor(v, 1); v += __shfl_xor(v, 2); v += __shfl_xor(v, 4);
      const float rstd = rsqrtf(v * (1.f / 64.f) + 64e-5f);
      int o, len;
      if (row < NLAT) { o = row & 4095; len = 4096; } else { o = (row - NLAT) & 255; len = 256; }
      float f[3][8];
#pragma unroll
      for (int g = 0; g < 3; ++g) {
        const int col = 3904 + 512 * g + ch0;
        const u16* src = p.P + (size_t)row * NIN + col;
        float cur[8], prv[8], nxt[8];
        unpack8(ld8(src), cur);
        if (o > 0) unpack8(ld8(src - NIN), prv); else { for (int j = 0; j < 8; ++j) prv[j] = 0.f; }
        if (o < len - 1) unpack8(ld8(src + NIN), nxt); else { for (int j = 0; j < 8; ++j) nxt[j] = 0.f; }
#pragma unroll
        for (int j = 0; j < 8; ++j) {
          const float m0v = mu0[col - 3904 + j], m1v = mu1[col - 3904 + j];
          f[g][j] = cur[j] + m0v * (prv[j] - cur[j]) + m1v * (nxt[j] - cur[j]);
        }
      }
      float rk = 0.f;
#pragma unroll
      for (int j = 0; j < 8; ++j) rk += f[0][j] * f[1][j] * p.r_k[layer * 512 + ch0 + j];
      rk += __shfl_xor(rk, 1); rk += __shfl_xor(rk, 2); rk += __shfl_xor(rk, 4);
      float gt[8], ov[8];
      unpack8(ld8(p.P + (size_t)row * NIN + 5696 + ch0), gt);
#pragma unroll
      for (int j = 0; j < 8; ++j)
        ov[j] = ((y[j] - mean) * rstd * p.rw_gn[layer * 512 + ch0 + j] + rk * f[2][j]) * silu(gt[j]);
      *(bf16x8*)(p.H + (size_t)row * DM + 1536 + ch0) = pack8(ov);
    }
  }
}

DI void ln_phase(const KP& p, int layer, int M) {
  const int lane = otid() & 63, w = otid() >> 6;
  const float* g = p.ln_g + layer * DM;
  const float* bb_ = p.ln_b + layer * DM;
  for (int row = obid() * 8 + w; row < M; row += gridDim.x * 8) {
    float* ptr = row < NLAT ? p.out + (size_t)row * DM : p.X1c + (size_t)(row - NLAT) * DM;
    f32x4 v[8];
    float s = 0.f;
#pragma unroll
    for (int i = 0; i < 8; ++i) { v[i] = *(const f32x4*)(ptr + (i * 64 + lane) * 4); s += v[i][0] + v[i][1] + v[i][2] + v[i][3]; }
#pragma unroll
    for (int o = 1; o < 64; o <<= 1) s += __shfl_xor(s, o);
    const float mean = s * (1.f / 2048.f);
    float q = 0.f;
#pragma unroll
    for (int i = 0; i < 8; ++i)
#pragma unroll
      for (int j = 0; j < 4; ++j) { const float dlt = v[i][j] - mean; q += dlt * dlt; }
#pragma unroll
    for (int o = 1; o < 64; o <<= 1) q += __shfl_xor(q, o);
    const float rstd = rsqrtf(q * (1.f / 2048.f) + 1e-5f);
    const int bidx = row < NLAT ? (row >> 12) : 4;
    const float* md = p.mod + ((size_t)5 + bidx) * 6144;
#pragma unroll
    for (int i = 0; i < 8; ++i) {
      const int c = (i * 64 + lane) * 4;
      f32x4 gg = *(const f32x4*)(g + c), bbv = *(const f32x4*)(bb_ + c), y;
#pragma unroll
      for (int j = 0; j < 4; ++j) y[j] = (v[i][j] - mean) * rstd * gg[j] + bbv[j];
      *(f32x4*)(ptr + c) = y;
      if (layer == 0) {
        f32x4 sh = *(const f32x4*)(md + c), scl = *(const f32x4*)(md + 2048 + c);
        u32x2 o;
        o[0] = pk2(y[0] * (1.f + scl[0]) + sh[0], y[1] * (1.f + scl[1]) + sh[1]);
        o[1] = pk2(y[2] * (1.f + scl[2]) + sh[2], y[3] * (1.f + scl[3]) + sh[3]);
        *(u32x2*)(p.H + (size_t)row * DM + c) = o;
      }
    }
  }
}

#define XB_TMO      128
#define XB_XCNT(j)  (256  + 64 * (j))
#define XB_XSUB(j)  (1280 + 64 * (j))
#define XB_XGEN(j)  (2304 + 64 * (j))
#define XB_TOP      3328
#define XB_TOPGEN   3392
#define XCD_BAR_WORDS 3456
#define XB_SPIN_CAP (1u << 18)
#define LAS __attribute__((address_space(3)))

__device__ __forceinline__ unsigned xb_ld(unsigned* p)              { return __hip_atomic_load(p, __ATOMIC_RELAXED, __HIP_MEMORY_SCOPE_AGENT); }
__device__ __forceinline__ unsigned xb_add(unsigned* p, unsigned v) { return __hip_atomic_fetch_add(p, v, __ATOMIC_RELAXED, __HIP_MEMORY_SCOPE_AGENT); }
__device__ __forceinline__ unsigned xb_xcc_id() { return (unsigned)__builtin_amdgcn_s_getreg((3 << 11) | 20) & 0xFu; }
#define XB_SPIN(cond, bar) do { unsigned _sp = 0; while (cond) { __builtin_amdgcn_s_sleep(1); \
    if ((++_sp & 255u) == 0u) { if (xb_ld(&(bar)[XB_TMO])) break; if (_sp > XB_SPIN_CAP) { atomicAdd(&(bar)[XB_TMO], 1u); break; } } } } while (0)

struct XcdBarrier {
    unsigned* bar; unsigned x;
    volatile LAS unsigned* st;
};

__device__ __forceinline__ XcdBarrier xcd_barrier_post(unsigned* bar, volatile LAS unsigned* st) {
    XcdBarrier b; b.bar = bar; b.x = xb_xcc_id(); b.st = st;
    if (threadIdx.x == 0) (void)xb_add(&bar[XB_XCNT(b.x)], 1u);
    return b;
}
__device__ __forceinline__ void xcd_barrier_complete(unsigned* bar, unsigned x, unsigned& nloc, unsigned& nx) {
    const unsigned G = gridDim.x * gridDim.y * gridDim.z;
    unsigned sum, cnt, mine, sp = 0u;
    for (;;) {
        sum = 0u; cnt = 0u; mine = 0u;
#pragma unroll
        for (unsigned j = 0; j < 16; ++j) { const unsigned c = xb_ld(&bar[XB_XCNT(j)]); sum += c; cnt += (c > 0u) ? 1u : 0u; mine = (j == x) ? c : mine; }
        if (sum == G) break;
        __builtin_amdgcn_s_sleep(1);
        if ((++sp & 255u) == 0u) { if (xb_ld(&bar[XB_TMO])) break; if (sp > XB_SPIN_CAP) { atomicAdd(&bar[XB_TMO], 1u); break; } }
    }
    nloc = mine > 0u ? mine : 1u; nx = cnt > 0u ? cnt : 1u;
}

__device__ __forceinline__ void xcd_barrier(const XcdBarrier& b) {
    asm volatile("s_waitcnt vmcnt(0)" ::: "memory");
    __syncthreads();
    if (threadIdx.x == 0) {
        unsigned* bar = b.bar;
        __builtin_amdgcn_s_waitcnt(0);
        unsigned nloc = b.st[0], nx = b.st[1];
        if (nloc == 0u) { xcd_barrier_complete(bar, b.x, nloc, nx); b.st[0] = nloc; b.st[1] = nx; }
        const unsigned old = xb_add(&bar[XB_XSUB(b.x)], 1u);
        const unsigned gen = old / nloc;
        if (old + 1u == (gen + 1u) * nloc) {
            __builtin_amdgcn_fence(__ATOMIC_RELEASE, "agent");
            asm volatile("s_waitcnt vmcnt(0)" ::: "memory");
            const unsigned og = xb_add(&bar[XB_TOP], 1u);
            const unsigned tg = og / nx;
            if (og + 1u == (tg + 1u) * nx) xb_add(&bar[XB_TOPGEN], 1u);
            else XB_SPIN(xb_ld(&bar[XB_TOPGEN]) == tg, bar);
            __builtin_amdgcn_fence(__ATOMIC_ACQUIRE, "agent");
            xb_add(&bar[XB_XGEN(b.x)], 1u);
            asm volatile("s_waitcnt vmcnt(0)" ::: "memory");
        } else {
            XB_SPIN(xb_ld(&bar[XB_XGEN(b.x)]) == gen, bar);
            __builtin_amdgcn_fence(__ATOMIC_ACQUIRE, "agent");
            asm volatile("s_waitcnt vmcnt(0)" ::: "memory");
        }
    }
    __syncthreads();
}


__global__ void __launch_bounds__(NTHR) hybrid_block_megakernel(KP p) {
  extern __shared__ __attribute__((aligned(16))) char smem[];
  cg::grid_group grid = cg::this_grid();
  __shared__ int s_item;
  const int tid = otid();
  __shared__ uint4 xb_words;
  if (threadIdx.x == 0) xb_words = make_uint4(0u, 0u, 0u, 0u);
  __syncthreads();
  const XcdBarrier xb = xcd_barrier_post(p.cnt + 128, (volatile LAS unsigned*)&xb_words);

  mod_phase(p, smem);
  convert_weights(p, 0, smem);
  grid.sync();
  h0_phase(p);
  xcd_barrier(xb);

  for (int layer = 0; layer < 2; ++layer) {
    const int Mq = layer == 0 ? NTOK : NLAT;
    for (int it = obid(); it < 68 * 25; it += gridDim.x) {
      const int nt = it / 68, mt = it % 68;
      gemm_tile(p, 0, layer, mt * 256, nt * 256, smem);
    }
    xcd_barrier(xb);
    {
      const int n_uq = (Mq / 256) * 6, n_ukv = 68 * 8, n_kr = NTOK / 8;
      for (int it = obid(); it < n_uq + n_ukv + n_kr; it += gridDim.x) {
        if (it < n_uq) gemm_tile(p, 1, layer, (it / 6) * 256, (it % 6) * 256, smem);
        else if (it < n_uq + n_ukv) { const int i = it - n_uq; gemm_tile(p, 2, layer, (i / 8) * 256, (i % 8) * 256, smem); }
        else krope_item(p, it - n_uq - n_ukv);
      }
    }
    xcd_barrier(xb);
    {
      for (int ch = obid(); ch < 160; ch += gridDim.x) {
        if (ch < 128) rwkv_chain(p, layer, ch, smem); else ret_chain(p, layer, ch - 128, smem);
      }
      const int n_att = layer == 0 ? 512 + 32 : 512;
      while (true) {
        __syncthreads();
        if (tid == 0) s_item = (int)atomicAdd(&p.cnt[layer], 1u);
        __syncthreads();
        const int it = s_item;
        if (it >= n_att) break;
        if (it < 512) {
          const int b = it >> 7, hd = (it >> 4) & 7, qb = it & 15;
          attn_item(p, b * 4096 + qb * 256, b, hd, LPOS, smem);
        } else {
          const int i = it - 512, b = i >> 3, hd = i & 7;
          attn_item(p, NLAT + b * 256, b, hd, 256, smem);
        }
      }
    }
    xcd_barrier(xb);
    merge_phase(p, layer, Mq);
    xcd_barrier(xb);
    for (int it = obid(); it < (Mq / 256) * 8; it += gridDim.x) {
      const int nt = it % 8, mt = it / 8;
      gemm_tile(p, 3, layer, mt * 256, nt * 256, smem);
    }
    xcd_barrier(xb);
    ln_phase(p, layer, Mq);
    if (layer == 0) {
      convert_weights(p, 1, smem);
      xcd_barrier(xb);
    }
  }
}

extern "C" void kernel_launch(void* const* d_in, const int* in_sizes, int n_in, void* d_out, int out_size, void* d_ws,
                              size_t ws_size, hipStream_t stream) {
  static int grid_blocks = 0;
  if (!grid_blocks) {
    int dev = 0, cus = 0, per_cu = 0;
    hipGetDevice(&dev);
    hipDeviceGetAttribute(&cus, hipDeviceAttributeMultiprocessorCount, dev);
    hipFuncSetAttribute((const void*)hybrid_block_megakernel, hipFuncAttributeMaxDynamicSharedMemorySize, (int)LDS_BYTES);
    hipOccupancyMaxActiveBlocksPerMultiprocessor(&per_cu, hybrid_block_megakernel, NTHR, LDS_BYTES);
    if (per_cu > 1) per_cu = 1;
    grid_blocks = cus * per_cu;
  }
  KP p{};
  const float* const* in = (const float* const*)d_in;
  p.x = in[0]; p.c = in[1]; p.ctx = in[2]; p.c_ctx = in[3]; p.w_ada = in[4]; p.b_ada = in[5]; p.w_in = in[6];
  p.ret_logit = in[7]; p.ret_gn = in[8]; p.q_g = in[9]; p.w_uq = in[10]; p.kv_g = in[11]; p.w_ukv = in[12]; p.mu = in[13];
  p.w0 = in[14]; p.w2 = in[15]; p.a0 = in[16]; p.a2 = in[17]; p.k_k = in[18]; p.k_a = in[19]; p.r_k = in[20]; p.rw_gn = in[21];
  p.w_out = in[22]; p.ln_g = in[23]; p.ln_b = in[24];
  p.out = (float*)d_out;
  char* ws = (char*)d_ws;
  size_t off = 0;
  auto take = [&](size_t bytes) { char* r = ws + off; off += (bytes + 255) & ~(size_t)255; return r; };
  p.P = (u16*)take((size_t)NTOK * NIN * 2);
  p.H = (u16*)take((size_t)NTOK * DM * 2);
  p.Q = (u16*)take((size_t)NTOK * 1536 * 2);
  p.Kn = (u16*)take((size_t)4 * 8 * LPOS * 128 * 2);
  p.Vt = (u16*)take((size_t)4 * 8 * 128 * LPOS * 2);
  p.Kr = (u16*)take((size_t)4 * LPOS * 64 * 2);
  p.Yret = (u16*)take((size_t)2 * NTOK * 512 * 2);
  p.Yrw = (u16*)take((size_t)2 * NTOK * 512 * 2);
  p.WinT = (u16*)take((size_t)NIN * DM * 2);
  p.WuqT = (u16*)take((size_t)1536 * 512 * 2);
  p.WukvT = (u16*)take((size_t)2048 * 256 * 2);
  p.WoutT = (u16*)take((size_t)DM * DM * 2);
  p.W2T = (u16*)take((size_t)2 * 512 * 64 * 2);
  p.A2T = (u16*)take((size_t)2 * 512 * 64 * 2);
  p.X1c = (float*)take((size_t)1024 * DM * 4);
  p.mod = (float*)take((size_t)2 * 5 * 6144 * 4);
  p.cnt = (unsigned*)take(512 + XCD_BAR_WORDS * 4);
  if (off > ws_size) { fprintf(stderr, "workspace too small: need %zu have %zu\n", off, ws_size); return; }
  hipMemsetAsync(p.cnt, 0, 512 + XCD_BAR_WORDS * 4, stream);
  void* args[] = {&p};
  hipError_t e = hipLaunchCooperativeKernel((void*)hybrid_block_megakernel, dim3(grid_blocks), dim3(NTHR), args, LDS_BYTES, stream);
  if (e != hipSuccess) fprintf(stderr, "cooperative launch failed: %s (grid %d)\n", hipGetErrorString(e), grid_blocks);
}
```

```cpp
#include <hip/hip_runtime.h>
#include <hip/hip_cooperative_groups.h>
#include <cstdio>
namespace cg = cooperative_groups;

#define DI __device__ __forceinline__
typedef unsigned short u16;
using bf16x8 = __attribute__((ext_vector_type(8))) short;
using s16x4 = __attribute__((ext_vector_type(4))) short;
using f32x16 = __attribute__((ext_vector_type(16))) float;
using f32x4 = __attribute__((ext_vector_type(4))) float;
using u32x4 = __attribute__((ext_vector_type(4))) unsigned;
using u32x2 = __attribute__((ext_vector_type(2))) unsigned;
using f32x2 = __attribute__((ext_vector_type(2))) float;
#define MFMA(a, b, c) __builtin_amdgcn_mfma_f32_32x32x16_bf16((a), (b), (c), 0, 0, 0)

constexpr int DM = 2048, NIN = 6208, NLAT = 16384, NTOK = 17408, LPOS = 4352;
constexpr int NTHR = 512;
constexpr size_t LDS_BYTES = 149504;
constexpr float ALPHA = 1.4142135623730951f;
constexpr float QSCALE = 0.07216878364870323f * 1.4426950408889634f;

struct KP {
  const float *x, *c, *ctx, *c_ctx, *w_ada, *b_ada, *w_in, *ret_logit, *ret_gn, *q_g, *w_uq, *kv_g, *w_ukv, *mu, *w0, *w2, *a0,
      *a2, *k_k, *k_a, *r_k, *rw_gn, *w_out, *ln_g, *ln_b;
  float* out;
  u16 *P, *H, *Q, *Kn, *Vt, *Kr, *Yret, *Yrw, *WinT, *WuqT, *WukvT, *WoutT, *W2T, *A2T;
  float *X1c, *mod;
  unsigned* cnt;
};

DI int otid() { int t = threadIdx.x; asm volatile("" : "+v"(t)); return t; }
DI int obid() { int t = blockIdx.x; asm volatile("" : "+s"(t)); return t; }
template <int CTRL> DI float dppf(float v) {
  return __builtin_bit_cast(float, __builtin_amdgcn_update_dpp(0, __builtin_bit_cast(int, v), CTRL, 0xf, 0xf, true));
}
DI float sum8(float x) { x += dppf<0xB1>(x); x += dppf<0x4E>(x); x += dppf<0x141>(x); return x; }
DI float sum16(float x) { x += dppf<0xB1>(x); x += dppf<0x4E>(x); x += dppf<0x141>(x); x += dppf<0x140>(x); return x; }
DI void lds_barrier() { asm volatile("s_waitcnt lgkmcnt(0)\n\ts_barrier" ::: "memory"); }
DI float bf2f(u16 v) { return __uint_as_float(((unsigned)v) << 16); }
DI float bflo(unsigned v) { return __uint_as_float(v << 16); }
DI float bfhi(unsigned v) { return __uint_as_float(v & 0xffff0000u); }
DI u16 f2bf(float a) { __bf16 r = (__bf16)a; return __builtin_bit_cast(u16, r); }
DI unsigned pk2(float a, float b) {
  typedef __bf16 bf2 __attribute__((ext_vector_type(2)));
  typedef float f2 __attribute__((ext_vector_type(2)));
  f2 v = {a, b};
  bf2 r = __builtin_convertvector(v, bf2);
  return __builtin_bit_cast(unsigned, r);
}
DI int crow(int reg, int h) { return (reg & 3) + 8 * (reg >> 2) + 4 * h; }
DI float silu(float x) { return x / (1.f + __expf(-x)); }
DI void unpack8(const bf16x8& v, float* f) {
  u32x4 u = __builtin_bit_cast(u32x4, v);
#pragma unroll
  for (int i = 0; i < 4; ++i) { f[2 * i] = bflo(u[i]); f[2 * i + 1] = bfhi(u[i]); }
}
DI bf16x8 pack8(const float* f) {
  u32x4 u;
#pragma unroll
  for (int i = 0; i < 4; ++i) u[i] = pk2(f[2 * i], f[2 * i + 1]);
  return __builtin_bit_cast(bf16x8, u);
}
DI bf16x8 ld8(const u16* p) { return *(const bf16x8*)p; }
DI bf16x8 zero8() { bf16x8 z = {0, 0, 0, 0, 0, 0, 0, 0}; return z; }
DI f32x16 zero16() { f32x16 z; for (int i = 0; i < 16; ++i) z[i] = 0.f; return z; }
DI s16x4 trread(const u16* p) {
  return __builtin_amdgcn_ds_read_tr16_b64_v4i16((s16x4 __attribute__((address_space(3)))*)(p));
}
DI bf16x8 cat4(s16x4 lo, s16x4 hi) { return __builtin_shufflevector(lo, hi, 0, 1, 2, 3, 4, 5, 6, 7); }
DI void rope_cs(int pos, int i, float& cs, float& sn) {
  float inv = exp2f(-(float)i * (13.287712379549449f / 16.f));
  float rev = (float)pos * inv * 0.15915494309189535f;
  rev -= floorf(rev);
  cs = __builtin_amdgcn_cosf(rev);
  sn = __builtin_amdgcn_sinf(rev);
}

DI void transpose_item(const float* src, u16* dst, int K, int N, int kt, int nt, char* smem) {
  float* tile = (float*)smem;
  const int tid = otid();
  __syncthreads();
  {
    const int kk = tid >> 4, n4 = tid & 15;
#pragma unroll
    for (int i = 0; i < 2; ++i) {
      const int k = kk + 32 * i;
      f32x4 v = *(const f32x4*)(src + (size_t)(kt * 64 + k) * N + nt * 64 + n4 * 4);
      tile[k * 65 + n4 * 4 + 0] = v[0]; tile[k * 65 + n4 * 4 + 1] = v[1];
      tile[k * 65 + n4 * 4 + 2] = v[2]; tile[k * 65 + n4 * 4 + 3] = v[3];
    }
  }
  __syncthreads();
  {
    const int n = tid >> 3, k8 = tid & 7;
    float f[8];
#pragma unroll
    for (int j = 0; j < 8; ++j) f[j] = tile[(k8 * 8 + j) * 65 + n];
    *(bf16x8*)(dst + (size_t)(nt * 64 + n) * K + kt * 64 + k8 * 8) = pack8(f);
  }
}

DI void convert_weights(const KP& p, int layer, char* smem) {
  const int n_in = 32 * 97, n_uq = 8 * 24, n_ukv = 4 * 32, n_out = 32 * 32, n_lora = 8;
  const int total = n_in + n_uq + n_ukv + n_out + 4 * n_lora;
  for (int it = obid(); it < total; it += gridDim.x) {
    int i = it;
    if (i < n_in) { transpose_item(p.w_in + (size_t)layer * DM * NIN, p.WinT, DM, NIN, i / 97, i % 97, smem); continue; }
    i -= n_in;
    if (i < n_uq) { transpose_item(p.w_uq + (size_t)layer * 512 * 1536, p.WuqT, 512, 1536, i / 24, i % 24, smem); continue; }
    i -= n_uq;
    if (i < n_ukv) { transpose_item(p.w_ukv + (size_t)layer * 256 * 2048, p.WukvT, 256, 2048, i / 32, i % 32, smem); continue; }
    i -= n_ukv;
    if (i < n_out) { transpose_item(p.w_out + (size_t)layer * DM * DM, p.WoutT, DM, DM, i / 32, i % 32, smem); continue; }
    i -= n_out;
    {
      const int which = i / (2 * n_lora), r = i % (2 * n_lora), d = r / n_lora, nt = r % n_lora;
      const float* src = (which ? p.a2 : p.w2) + ((size_t)layer * 2 + d) * 64 * 512;
      u16* dst = (which ? p.A2T : p.W2T) + (size_t)d * 512 * 64;
      transpose_item(src, dst, 64, 512, 0, nt, smem);
    }
  }
}

DI void mod_phase(const KP& p, char* smem) {
  float* sc = (float*)smem;
  float* red = sc + 5 * 2048;
  const int tid = otid();
  __syncthreads();
  for (int i = tid; i < 5 * 2048; i += NTHR) {
    float v = i < 4 * 2048 ? p.c[i] : p.c_ctx[i - 4 * 2048];
    sc[i] = silu(v);
  }
  __syncthreads();
  const int kg = tid >> 5, col = tid & 31;
  for (int it = obid(); it < 384; it += gridDim.x) {
    const int layer = it / 192, j = (it % 192) * 32 + col;
    const float* w = p.w_ada + (size_t)layer * DM * 6144 + j;
    float acc[5] = {0.f, 0.f, 0.f, 0.f, 0.f};
    for (int k = kg * 128; k < kg * 128 + 128; k += 16) {
      float wv[16];
#pragma unroll
      for (int u = 0; u < 16; ++u) wv[u] = w[(size_t)(k + u) * 6144];
#pragma unroll
      for (int u = 0; u < 16; ++u)
#pragma unroll
        for (int r = 0; r < 5; ++r) acc[r] += sc[r * 2048 + k + u] * wv[u];
    }
#pragma unroll
    for (int r = 0; r < 5; ++r) red[(kg * 5 + r) * 32 + col] = acc[r];
    __syncthreads();
    if (tid < 160) {
      const int r = tid >> 5;
      float s = p.b_ada[(size_t)layer * 6144 + j];
      for (int g = 0; g < 16; ++g) s += red[(g * 5 + r) * 32 + col];
      p.mod[((size_t)layer * 5 + r) * 6144 + j] = s;
    }
    __syncthreads();
  }
}

DI void h0_phase(const KP& p) {
  const int lane = otid() & 63, w = otid() >> 6;
  for (int row = obid() * 8 + w; row < NTOK; row += gridDim.x * 8) {
    const float* src = row < NLAT ? p.x + (size_t)row * DM : p.ctx + (size_t)(row - NLAT) * DM;
    const int bb = row < NLAT ? (row >> 12) : 4;
    const float* md = p.mod + (size_t)bb * 6144;
#pragma unroll
    for (int i = 0; i < 8; ++i) {
      const int c = (i * 64 + lane) * 4;
      f32x4 v = *(const f32x4*)(src + c), sh = *(const f32x4*)(md + c), scl = *(const f32x4*)(md + 2048 + c);
      u32x2 o;
      o[0] = pk2(v[0] * (1.f + scl[0]) + sh[0], v[1] * (1.f + scl[1]) + sh[1]);
      o[1] = pk2(v[2] * (1.f + scl[2]) + sh[2], v[3] * (1.f + scl[3]) + sh[3]);
      *(u32x2*)(p.H + (size_t)row * DM + c) = o;
    }
  }
}

DI void gemm_tile(const KP& p, int mode, int layer, int m0, int n0, char* smem) {
  constexpr int STG = 512 * 72;
  u16* base = (u16*)smem;
  float* rs = (float*)(base + 2 * STG);
  const int tid = otid(), lane = tid & 63, w = tid >> 6, wm = w >> 2, wn = w & 3, l31 = lane & 31, h = lane >> 5;
  const u16* A; const u16* Bt; const float* gv = nullptr; int lda, K, N;
  if (mode == 0) { A = p.H; lda = DM; K = DM; N = NIN; Bt = p.WinT; }
  else if (mode == 1) { A = p.P + 2048; lda = NIN; K = 512; N = 1536; Bt = p.WuqT; gv = p.q_g + layer * 512; }
  else if (mode == 2) { A = p.P + 2560; lda = NIN; K = 256; N = 2048; Bt = p.WukvT; gv = p.kv_g + layer * 256; }
  else { A = p.H; lda = DM; K = DM; N = DM; Bt = p.WoutT; }
  const bool xf = (mode == 1 || mode == 2);
  const bool active = (n0 + wn * 64) < N;
  __syncthreads();
  if (xf) {
    const int r = tid >> 1, part = tid & 1;
    const u16* src = A + (size_t)(m0 + r) * lda + part * (K >> 1);
    float ss = 0.f;
    for (int i = 0; i < (K >> 1); i += 8) {
      float f[8]; unpack8(ld8(src + i), f);
#pragma unroll
      for (int j = 0; j < 8; ++j) ss += f[j] * f[j];
    }
    ss += __shfl_xor(ss, 1);
    if (!part) rs[r] = rsqrtf(ss / (float)K + 1e-6f);
    __syncthreads();
  }
  f32x16 acc[4][2];
#pragma unroll
  for (int i = 0; i < 4; ++i)
#pragma unroll
    for (int j = 0; j < 2; ++j) acc[i][j] = zero16();
  bf16x8 ra[4], rb[4];
  const int arow = tid >> 3, ac = tid & 7;
  auto loadg = [&](int k0) {
#pragma unroll
    for (int i = 0; i < 4; ++i) ra[i] = ld8(A + (size_t)(m0 + arow + 64 * i) * lda + k0 + ac * 8);
#pragma unroll
    for (int i = 0; i < 4; ++i) {
      int nrow = n0 + arow + 64 * i;
      nrow = nrow < N ? nrow : N - 1;
      rb[i] = ld8(Bt + (size_t)nrow * K + k0 + ac * 8);
    }
  };
  auto stage = [&](int buf, int k0) {
    u16* As = base + buf * STG;
    u16* Bs = As + 256 * 72;
#pragma unroll
    for (int i = 0; i < 4; ++i) {
      bf16x8 v = ra[i];
      if (xf) {
        float f[8]; unpack8(v, f);
        const float sc = rs[arow + 64 * i];
        f32x4 g0 = *(const f32x4*)(gv + k0 + ac * 8), g1 = *(const f32x4*)(gv + k0 + ac * 8 + 4);
#pragma unroll
        for (int j = 0; j < 4; ++j) { f[j] *= sc * g0[j]; f[4 + j] *= sc * g1[j]; }
        v = pack8(f);
      }
      *(bf16x8*)(As + (arow + 64 * i) * 72 + ac * 8) = v;
    }
#pragma unroll
    for (int i = 0; i < 4; ++i) *(bf16x8*)(Bs + (arow + 64 * i) * 72 + ac * 8) = rb[i];
  };
  const int nk = K >> 6;
  loadg(0);
  stage(0, 0);
  if (nk > 1) loadg(64);
  __syncthreads();
  for (int kt = 0; kt < nk; ++kt) {
    if (kt + 1 < nk) stage((kt + 1) & 1, (kt + 1) * 64);
    if (kt + 2 < nk) loadg((kt + 2) * 64);
    const u16* As = base + (kt & 1) * STG;
    const u16* Bs = As + 256 * 72;
    if (active) {
#pragma unroll
      for (int ks = 0; ks < 4; ++ks) {
        bf16x8 bfr[2], afr[4];
#pragma unroll
        for (int ni = 0; ni < 2; ++ni) bfr[ni] = ld8(Bs + (wn * 64 + ni * 32 + l31) * 72 + ks * 16 + h * 8);
#pragma unroll
        for (int mi = 0; mi < 4; ++mi) afr[mi] = ld8(As + (wm * 128 + mi * 32 + l31) * 72 + ks * 16 + h * 8);
#pragma unroll
        for (int mi = 0; mi < 4; ++mi)
#pragma unroll
          for (int ni = 0; ni < 2; ++ni) acc[mi][ni] = MFMA(afr[mi], bfr[ni], acc[mi][ni]);
      }
    }
    __syncthreads();
  }
#pragma unroll
  for (int mi = 0; mi < 4; ++mi)
#pragma unroll
    for (int ni = 0; ni < 2; ++ni) {
      const int cb = n0 + wn * 64 + ni * 32;
      if (cb >= N) continue;
      const int col = cb + l31;
      const int rb0 = m0 + wm * 128 + mi * 32;
      const f32x16& a = acc[mi][ni];
      if (mode == 0) {
#pragma unroll
        for (int r = 0; r < 16; ++r) p.P[(size_t)(rb0 + crow(r, h)) * NIN + col] = f2bf(a[r]);
      } else if (mode == 1) {
        const int dd = cb % 192;
        const bool rope = (dd >= 128) && (rb0 < NLAT);
        const int part = (dd - 128) >> 5;
#pragma unroll
        for (int r = 0; r < 16; ++r) {
          const int row = rb0 + crow(r, h);
          float v = a[r] * QSCALE;
          if (rope) {
            const int t = row & 4095;
            const int pos = part ? (t & 63) : (t >> 6);
            float cs, sn; rope_cs(pos, l31 & 15, cs, sn);
            const float pr = __shfl_xor(v, 16);
            v = (l31 < 16) ? (v * cs - pr * sn) : (v * cs + pr * sn);
          }
          p.Q[(size_t)row * 1536 + col] = f2bf(v);
        }
      } else if (mode == 2) {
        const int head = col >> 8, dd = col & 255;
#pragma unroll
        for (int g = 0; g < 4; ++g) {
          const int row = rb0 + 8 * g + 4 * h;
          int b, pos;
          if (row < NLAT) { b = row >> 12; pos = 256 + (row & 4095); } else { b = (row - NLAT) >> 8; pos = (row - NLAT) & 255; }
          if (dd < 128) {
#pragma unroll
            for (int j = 0; j < 4; ++j) p.Kn[((size_t)(b * 8 + head) * LPOS + pos + j) * 128 + dd] = f2bf(a[4 * g + j]);
          } else {
            u32x2 o; o[0] = pk2(a[4 * g], a[4 * g + 1]); o[1] = pk2(a[4 * g + 2], a[4 * g + 3]);
            *(u32x2*)(p.Vt + ((size_t)(b * 8 + head) * 128 + (dd - 128)) * LPOS + pos) = o;
          }
        }
      } else {
#pragma unroll
        for (int r = 0; r < 16; ++r) {
          const int row = rb0 + crow(r, h);
          const int bb = row < NLAT ? (row >> 12) : 4;
          const float gate = p.mod[((size_t)layer * 5 + bb) * 6144 + 4096 + col];
          float xv;
          float* dst;
          if (row < NLAT) {
            dst = p.out + (size_t)row * DM + col;
            xv = layer == 0 ? p.x[(size_t)row * DM + col] : *dst;
          } else {
            dst = p.X1c + (size_t)(row - NLAT) * DM + col;
            xv = p.ctx[(size_t)(row - NLAT) * DM + col];
          }
          *dst = ALPHA * xv + gate * a[r];
        }
      }
    }
}

DI void krope_item(const KP& p, int it) {
  const int tid = otid(), tok = tid >> 6, dim = tid & 63;
  const int row = it * 8 + tok;
  const u16* src = p.P + (size_t)row * NIN + 2816;
  float v = bf2f(src[dim]);
  int b, pos;
  if (row < NLAT) {
    const float pr = bf2f(src[dim ^ 16]);
    const int t = row & 4095, part = dim >> 5;
    const int ps = part ? (t & 63) : (t >> 6);
    float cs, sn; rope_cs(ps, dim & 15, cs, sn);
    v = ((dim & 31) < 16) ? (v * cs - pr * sn) : (v * cs + pr * sn);
    b = row >> 12; pos = 256 + t;
  } else { b = (row - NLAT) >> 8; pos = (row - NLAT) & 255; }
  p.Kr[((size_t)b * LPOS + pos) * 64 + dim] = f2bf(v);
}

DI void attn_item(const KP& p, int qrow0, int b, int hd, int nkeys, char* smem) {
  constexpr int STG = 64 * 200 + 128 * 72;
  u16* base = (u16*)smem;
  const int tid = otid(), lane = tid & 63, w = tid >> 6, l31 = lane & 31, h = lane >> 5;
  const int qrow = qrow0 + 32 * w + l31;
  bf16x8 qf[12];
  {
    const u16* qp = p.Q + (size_t)qrow * 1536 + hd * 192 + 8 * h;
#pragma unroll
    for (int ks = 0; ks < 12; ++ks) qf[ks] = ld8(qp + 16 * ks);
  }
  f32x16 o[4];
#pragma unroll
  for (int i = 0; i < 4; ++i) o[i] = zero16();
  float m = -1e30f, lsum = 0.f;
  const u16* kn = p.Kn + (size_t)(b * 8 + hd) * LPOS * 128;
  const u16* kr = p.Kr + (size_t)b * LPOS * 64;
  const u16* vt = p.Vt + (size_t)(b * 8 + hd) * 128 * LPOS;
  int kkey[3], kc[3];
#pragma unroll
  for (int i = 0; i < 3; ++i) { const int idx = tid + NTHR * i; kkey[i] = idx / 24; kc[i] = idx % 24; }
  bf16x8 rk[3], rv[2];
  auto loadg = [&](int kt0) {
#pragma unroll
    for (int i = 0; i < 3; ++i) {
      const u16* src = kc[i] < 16 ? kn + (size_t)(kt0 + kkey[i]) * 128 + kc[i] * 8 : kr + (size_t)(kt0 + kkey[i]) * 64 + (kc[i] - 16) * 8;
      rk[i] = ld8(src);
    }
#pragma unroll
    for (int i = 0; i < 2; ++i) {
      const int idx = tid + NTHR * i, dd = idx >> 3, c = idx & 7;
      rv[i] = ld8(vt + (size_t)dd * LPOS + kt0 + c * 8);
    }
  };
  auto stage = [&](int buf) {
    u16* Ksm = base + buf * STG;
    u16* Vsm = Ksm + 64 * 200;
#pragma unroll
    for (int i = 0; i < 3; ++i) *(bf16x8*)(Ksm + kkey[i] * 200 + kc[i] * 8) = rk[i];
#pragma unroll
    for (int i = 0; i < 2; ++i) {
      const int idx = tid + NTHR * i, dd = idx >> 3, c = idx & 7;
      u32x4 u = __builtin_bit_cast(u32x4, rv[i]);
      u32x2 lo = {u[0], u[1]}, hi = {u[2], u[3]};
      u16* dst = Vsm + dd * 72 + 16 * (c >> 1) + 4 * (c & 1);
      *(u32x2*)dst = lo;
      *(u32x2*)(dst + 8) = hi;
    }
  };
  __syncthreads();
  const int ntile = nkeys >> 6;
  loadg(0);
  stage(0);
  if (ntile > 1) loadg(64);
  __syncthreads();
  for (int t = 0; t < ntile; ++t) {
    const u16* Ksm = base + (t & 1) * STG;
    const u16* Vsm = Ksm + 64 * 200;
    if (t + 1 < ntile) stage((t + 1) & 1);
    if (t + 2 < ntile) loadg((t + 2) * 64);
    f32x16 s[2];
#pragma unroll
    for (int kt = 0; kt < 2; ++kt) {
      s[kt] = zero16();
#pragma unroll
      for (int ks = 0; ks < 12; ++ks) {
        bf16x8 a = ld8(Ksm + (kt * 32 + l31) * 200 + ks * 16 + h * 8);
        s[kt] = MFMA(a, qf[ks], s[kt]);
        if ((ks & 3) == 3) asm volatile("" ::: "memory");
      }
    }
    float mx = s[0][0];
#pragma unroll
    for (int r = 0; r < 16; ++r) { mx = fmaxf(mx, s[0][r]); mx = fmaxf(mx, s[1][r]); }
    mx = fmaxf(mx, __shfl_xor(mx, 32));
    const float mnew = fmaxf(m, mx);
    const float alpha = __builtin_amdgcn_exp2f(m - mnew);
    m = mnew;
    float ps = 0.f;
#pragma unroll
    for (int kt = 0; kt < 2; ++kt)
#pragma unroll
      for (int r = 0; r < 16; ++r) { float e = __builtin_amdgcn_exp2f(s[kt][r] - mnew); s[kt][r] = e; ps += e; }
    lsum = lsum * alpha + ps;
#pragma unroll
    for (int dt = 0; dt < 4; ++dt)
#pragma unroll
      for (int r = 0; r < 16; ++r) o[dt][r] *= alpha;
#pragma unroll
    for (int kt = 0; kt < 2; ++kt)
#pragma unroll
      for (int sI = 0; sI < 2; ++sI) {
        u32x4 pu;
#pragma unroll
        for (int j = 0; j < 4; ++j) pu[j] = pk2(s[kt][8 * sI + 2 * j], s[kt][8 * sI + 2 * j + 1]);
        const bf16x8 pb = __builtin_bit_cast(bf16x8, pu);
        const int kb = kt * 32 + sI * 16 + 8 * h;
#pragma unroll
        for (int dt = 0; dt < 4; ++dt) o[dt] = MFMA(ld8(Vsm + (dt * 32 + l31) * 72 + kb), pb, o[dt]);
        asm volatile("" ::: "memory");
      }
    __syncthreads();
  }
  lsum += __shfl_xor(lsum, 32);
  const float inv = 1.f / lsum;
  const u16* gp = p.P + (size_t)qrow * NIN + 2880 + hd * 128;
  u16* op = p.H + (size_t)qrow * DM + 512 + hd * 128;
#pragma unroll
  for (int dt = 0; dt < 4; ++dt)
#pragma unroll
    for (int g = 0; g < 4; ++g) {
      const int d0 = dt * 32 + 8 * g + 4 * h;
      u32x2 gg = *(const u32x2*)(gp + d0);
      float g0 = bflo(gg[0]), g1 = bfhi(gg[0]), g2 = bflo(gg[1]), g3 = bfhi(gg[1]);
      u32x2 ov;
      ov[0] = pk2(o[dt][4 * g] * inv * silu(g0), o[dt][4 * g + 1] * inv * silu(g1));
      ov[1] = pk2(o[dt][4 * g + 2] * inv * silu(g2), o[dt][4 * g + 3] * inv * silu(g3));
      *(u32x2*)(op + d0) = ov;
    }
}

DI void ret_chain(const KP& p, int layer, int chain, char* smem) {
  const int d = chain >> 4, b = (chain >> 2) & 3, hd = chain & 3;
  u16* Qs = (u16*)smem;
  u16* Ks = Qs + 128 * 136;
  u16* Vs = Ks + 128 * 136;
  u16* Sts = Vs + 128 * 136;
  const int tid = otid(), lane = tid & 63, w = tid >> 6, l31 = lane & 31, h = lane >> 5;
  const int q4 = (lane & 15) >> 2, p4 = lane & 3, blk = (lane >> 4) & 1;
  const float logit = p.ret_logit[(layer * 2 + d) * 4 + hd];
  const float z = -logit;
  const float logg = -(fmaxf(z, 0.f) + log1pf(expf(-fabsf(z))));
  const float lg2 = logg * 1.4426950408889634f;
  const float gC = exp2f(128.f * lg2);
  const float kscale = 0.08838834764831845f;
  const int iw = w & 3, half = w >> 2;
  const int kt = w & 3, vh = w >> 2;
  f32x16 st[2];
  st[0] = zero16(); st[1] = zero16();
  __syncthreads();
  for (int i = tid; i < 128 * 136 / 8; i += NTHR) *(bf16x8*)(Sts + i * 8) = zero8();
  bf16x8 rq[4], rk[4], rv[4];
  const int trow = tid >> 4, tc = tid & 15;
  auto rowbase = [&](int n) -> size_t {
    if (d == 0) return n < 2 ? (size_t)(NLAT + b * 256 + 128 * n) : (size_t)(b * 4096 + 128 * (n - 2));
    return n < 2 ? (size_t)(NLAT + b * 256 + 128 * (1 - n)) : (size_t)(b * 4096 + 128 * (33 - n));
  };
  auto loadg = [&](int n) {
    const size_t rb = rowbase(n);
#pragma unroll
    for (int i = 0; i < 4; ++i) {
      const u16* src = p.P + (rb + trow + 32 * i) * NIN + hd * 128 + tc * 8;
      rq[i] = ld8(src); rk[i] = ld8(src + 512); rv[i] = ld8(src + 1024);
    }
  };
  loadg(0);
  for (int n = 0; n < 34; ++n) {
    const size_t rb = rowbase(n);
#pragma unroll
    for (int i = 0; i < 4; ++i) {
      const int j = trow + 32 * i;
      *(bf16x8*)(Qs + j * 136 + tc * 8) = rq[i];
      *(bf16x8*)(Ks + j * 136 + tc * 8) = rk[i];
      const float zeta = exp2f((d == 0 ? (float)(127 - j) : (float)j) * lg2) * kscale;
      float f[8]; unpack8(rv[i], f);
#pragma unroll
      for (int jj = 0; jj < 8; ++jj) f[jj] *= zeta;
      *(bf16x8*)(Vs + j * 136 + tc * 8) = pack8(f);
    }
    __syncthreads();
    if (n + 1 < 34) loadg(n + 1);
    f32x16 acc[2];
    acc[0] = zero16(); acc[1] = zero16();
    bf16x8 qf[8];
#pragma unroll
    for (int ks = 0; ks < 8; ++ks) qf[ks] = ld8(Qs + (32 * iw + l31) * 136 + 16 * ks + 8 * h);
#pragma unroll
    for (int et = 0; et < 2; ++et)
#pragma unroll
      for (int ks = 0; ks < 8; ++ks) {
        bf16x8 a = ld8(Sts + (32 * (2 * half + et) + l31) * 136 + 16 * ks + 8 * h);
        acc[et] = MFMA(a, qf[ks], acc[et]);
      }
#pragma unroll
    for (int et = 0; et < 2; ++et)
#pragma unroll
      for (int r = 0; r < 16; ++r) acc[et][r] *= gC;
    const int ii = 32 * iw + l31;
#pragma unroll
    for (int jt = 0; jt < 4; ++jt) {
      f32x16 sT = zero16();
#pragma unroll
      for (int ks = 0; ks < 8; ++ks) {
        bf16x8 a = ld8(Ks + (32 * jt + l31) * 136 + 16 * ks + 8 * h);
        sT = MFMA(a, qf[ks], sT);
      }
#pragma unroll
      for (int r = 0; r < 16; ++r) {
        const int j = 32 * jt + crow(r, h);
        const bool keep = d == 0 ? (ii >= j) : (j >= ii);
        sT[r] = keep ? sT[r] : 0.f;
      }
#pragma unroll
      for (int sI = 0; sI < 2; ++sI) {
        u32x4 pu;
#pragma unroll
        for (int j = 0; j < 4; ++j) pu[j] = pk2(sT[8 * sI + 2 * j], sT[8 * sI + 2 * j + 1]);
        const bf16x8 pb = __builtin_bit_cast(bf16x8, pu);
        const int j0 = 32 * jt + 16 * sI + 4 * h;
#pragma unroll
        for (int et = 0; et < 2; ++et) {
          const u16* vp = Vs + (j0 + q4) * 136 + 32 * (2 * half + et) + 16 * blk + 4 * p4;
          s16x4 lo = trread(vp), hi = trread(vp + 8 * 136);
          acc[et] = MFMA(cat4(lo, hi), pb, acc[et]);
        }
      }
    }
    {
      const float rho = exp2f((d == 0 ? (float)(ii - 127) : (float)(-ii)) * lg2);
      u16* yp = p.Yret + ((size_t)d * NTOK + rb + ii) * 512 + hd * 128;
#pragma unroll
      for (int et = 0; et < 2; ++et)
#pragma unroll
        for (int g = 0; g < 4; ++g) {
          const int e0 = 32 * (2 * half + et) + 8 * g + 4 * h;
          u32x2 ov;
          ov[0] = pk2(acc[et][4 * g] * rho, acc[et][4 * g + 1] * rho);
          ov[1] = pk2(acc[et][4 * g + 2] * rho, acc[et][4 * g + 3] * rho);
          *(u32x2*)(yp + e0) = ov;
        }
    }
#pragma unroll
    for (int vi = 0; vi < 2; ++vi)
#pragma unroll
      for (int r = 0; r < 16; ++r) st[vi][r] *= gC;
#pragma unroll
    for (int ks = 0; ks < 8; ++ks) {
      const int jb = 16 * ks + 4 * h + q4;
      const u16* kp = Ks + jb * 136 + 32 * kt + 16 * blk + 4 * p4;
      const bf16x8 a = cat4(trread(kp), trread(kp + 8 * 136));
#pragma unroll
      for (int vi = 0; vi < 2; ++vi) {
        const u16* vp = Vs + jb * 136 + 32 * (2 * vh + vi) + 16 * blk + 4 * p4;
        const bf16x8 bfr = cat4(trread(vp), trread(vp + 8 * 136));
        st[vi] = MFMA(a, bfr, st[vi]);
      }
    }
    __syncthreads();
#pragma unroll
    for (int vi = 0; vi < 2; ++vi)
#pragma unroll
      for (int g = 0; g < 4; ++g) {
        const int v = 32 * (2 * vh + vi) + l31, k0 = 32 * kt + 8 * g + 4 * h;
        u32x2 ov;
        ov[0] = pk2(st[vi][4 * g], st[vi][4 * g + 1]);
        ov[1] = pk2(st[vi][4 * g + 2], st[vi][4 * g + 3]);
        *(u32x2*)(Sts + v * 136 + k0) = ov;
      }
  }
}

DI void rwkv_chain(const KP& p, int layer, int item, char* smem) {
  const int chain = item >> 1, vhalf = item & 1;
  const int d = chain >> 5, b = (chain >> 3) & 3, hd = chain & 7;
  float* buf = (float*)smem;
  u16* twS = (u16*)(smem + 98304);
  u16* alS = twS + 32 * 72;
  const int tid = otid(), lane = tid & 63, w = tid >> 6, l31 = lane & 31, h = lane >> 5;
  auto geom = [&](int cc, int& o0, int& len, size_t& rbase) {
    const int j0 = 32 * cc;
    const bool isctx = j0 < 256;
    len = isctx ? 256 : 4096;
    if (d == 0) o0 = isctx ? j0 : j0 - 256; else o0 = isctx ? (224 - j0) : (4064 - (j0 - 256));
    rbase = isctx ? (size_t)(NLAT + b * 256) : (size_t)(b * 4096);
  };
  __syncthreads();
  if (w >= 4) {
    const int pt = tid - 256;
    const int pw = w - 4, mat = pw >> 1, nh = pw & 1;
    const int matu = __builtin_amdgcn_readfirstlane(mat);
    bf16x8 bw[4];
    const int n = hd * 64 + nh * 32 + l31;
    {
      const u16* wT = (mat ? p.A2T : p.W2T) + ((size_t)d * 512 + n) * 64 + 8 * h;
#pragma unroll
      for (int ks = 0; ks < 4; ++ks) bw[ks] = ld8(wT + 16 * ks);
    }
    const float c0 = (mat ? p.a0 : p.w0)[((size_t)layer * 2 + d) * 512 + n];
    const int tok = pt >> 3, c8 = pt & 7;
    int colg[5];
    colg[0] = 3904 + hd * 64 + c8 * 8; colg[1] = 4416 + hd * 64 + c8 * 8; colg[2] = 4928 + hd * 64 + c8 * 8;
    colg[3] = 5440 + d * 64 + c8 * 8; colg[4] = 5568 + d * 64 + c8 * 8;
    const float* mu0 = p.mu + (size_t)layer * 2 * 1792;
    const float* mu1 = mu0 + 1792;
    float m0[5][8], m1[5][8], kkc[8], kac[8];
#pragma unroll
    for (int g = 0; g < 5; ++g)
#pragma unroll
      for (int j = 0; j < 8; ++j) { m0[g][j] = mu0[colg[g] - 3904 + j]; m1[g][j] = mu1[colg[g] - 3904 + j]; }
#pragma unroll
    for (int j = 0; j < 8; ++j) { kkc[j] = p.k_k[layer * 512 + hd * 64 + c8 * 8 + j]; kac[j] = p.k_a[layer * 512 + hd * 64 + c8 * 8 + j]; }
    bf16x8 raw[5][3];
    auto loadraw = [&](int cc) {
      int o0, len; size_t rbase; geom(cc, o0, len, rbase);
      const int o = o0 + tok;
#pragma unroll
      for (int g = 0; g < 5; ++g) {
        const u16* src = p.P + (rbase + o) * NIN + colg[g];
        raw[g][1] = ld8(src);
        raw[g][0] = o > 0 ? ld8(src - NIN) : zero8();
        raw[g][2] = o < len - 1 ? ld8(src + NIN) : zero8();
      }
    };
    loadraw(0);
    for (int cn = 0; cn < 137; ++cn) {
      float* bbase = buf + (cn & 1) * 32 * 384;
      float* bb = bbase + tok * 384;
      if (cn < 136) {
#pragma unroll
        for (int g = 0; g < 5; ++g) {
          float cur[8], prv[8], nxt[8], sh[8];
          unpack8(raw[g][1], cur); unpack8(raw[g][0], prv); unpack8(raw[g][2], nxt);
#pragma unroll
          for (int j = 0; j < 8; ++j) sh[j] = cur[j] + m0[g][j] * (prv[j] - cur[j]) + m1[g][j] * (nxt[j] - cur[j]);
          if (g < 3) {
            float* dst = bb + (g == 0 ? 0 : g == 1 ? 128 : 320) + c8 * 8;
            *(f32x4*)dst = f32x4{sh[0], sh[1], sh[2], sh[3]};
            *(f32x4*)(dst + 4) = f32x4{sh[4], sh[5], sh[6], sh[7]};
          } else if (g == 3) {
#pragma unroll
            for (int j = 0; j < 8; ++j) sh[j] = 1.f - 2.f * __builtin_amdgcn_rcpf(1.f + __expf(2.f * sh[j]));
            *(bf16x8*)(twS + tok * 72 + c8 * 8) = pack8(sh);
          } else {
            *(bf16x8*)(alS + tok * 72 + c8 * 8) = pack8(sh);
          }
        }
      }
      lds_barrier();
      if (cn + 1 < 136) loadraw(cn + 1);
      if (cn < 136) {
        const u16* X = mat ? alS : twS;
        f32x16 acc = zero16();
#pragma unroll
        for (int ks = 0; ks < 4; ++ks) acc = MFMA(ld8(X + l31 * 72 + ks * 16 + h * 8), bw[ks], acc);
        const int ch = nh * 32 + l31;
        float* dstb = bbase + (matu == 0 ? 64 : 256) + ch + 4 * h * 384;
#pragma unroll
        for (int r = 0; r < 16; ++r) {
          float sg = __builtin_amdgcn_rcpf(1.f + __expf(-(c0 + acc[r])));
          if (matu == 0) sg = __expf(-0.6065306597126334f * sg);
          dstb[((r & 3) + 8 * (r >> 2)) * 384] = sg;
        }
      }
      lds_barrier();
      if (cn < 136) {
        float kk[8], kr[8], ar[8];
        float ss = 0.f;
        {
          f32x4 k0 = *(const f32x4*)(bb + 128 + c8 * 8), k1 = *(const f32x4*)(bb + 132 + c8 * 8);
          f32x4 a0 = *(const f32x4*)(bb + 256 + c8 * 8), a1 = *(const f32x4*)(bb + 260 + c8 * 8);
#pragma unroll
          for (int j = 0; j < 4; ++j) { kr[j] = k0[j]; kr[4 + j] = k1[j]; ar[j] = a0[j]; ar[4 + j] = a1[j]; }
        }
#pragma unroll
        for (int j = 0; j < 8; ++j) { kk[j] = kr[j] * kkc[j]; ss += kk[j] * kk[j]; }
        ss = sum8(ss);
        const float inv = fminf(__builtin_amdgcn_rsqf(ss), 1e12f);
        float oa[8], ob[8], ok[8];
#pragma unroll
        for (int j = 0; j < 8; ++j) {
          const float kkn = kk[j] * inv;
          oa[j] = -kkn; ob[j] = kkn * ar[j]; ok[j] = kr[j] * (1.f + (ar[j] - 1.f) * kac[j]);
        }
        *(f32x4*)(bb + 192 + c8 * 8) = f32x4{oa[0], oa[1], oa[2], oa[3]}; *(f32x4*)(bb + 196 + c8 * 8) = f32x4{oa[4], oa[5], oa[6], oa[7]};
        *(f32x4*)(bb + 256 + c8 * 8) = f32x4{ob[0], ob[1], ob[2], ob[3]}; *(f32x4*)(bb + 260 + c8 * 8) = f32x4{ob[4], ob[5], ob[6], ob[7]};
        *(f32x4*)(bb + 128 + c8 * 8) = f32x4{ok[0], ok[1], ok[2], ok[3]}; *(f32x4*)(bb + 132 + c8 * 8) = f32x4{ok[4], ok[5], ok[6], ok[7]};
      }
      lds_barrier();
    }
  } else {
    const int kq = lane & 15, vrow = 32 * vhalf + 8 * w + 2 * (lane >> 4);
    float S0[4], S1[4];
#pragma unroll
    for (int i = 0; i < 4; ++i) { S0[i] = 0.f; S1[i] = 0.f; }
    for (int c = -1; c < 136; ++c) {
      int o0 = 0, len; size_t rbase = 0;
      if (c >= 0) geom(c, o0, len, rbase);
      const float* bbase = buf + (c & 1) * 32 * 384;
      u16* yp = p.Yrw + ((size_t)d * NTOK + rbase + o0) * 512 + hd * 64 + vrow;
      f32x4 R0[5], R1[5], R2[5], R3[5];
      f32x2 v0, v1, v2, v3;
      auto ldstep = [&](int s, f32x4 (&R)[5], f32x2& vv) {
        s = s < 32 ? s : 31;
        const int i = d ? 31 - s : s;
        const float* t = bbase + i * 384 + 4 * kq;
#pragma unroll
        for (int q = 0; q < 5; ++q) R[q] = *(const f32x4*)(t + 64 * q);
        vv = *(const f32x2*)(bbase + i * 384 + 320 + vrow);
      };
      auto step = [&](const f32x4 (&R)[5], f32x2 vv, int s) {
        const int i = d ? 31 - s : s;
        float sa0 = (S0[0] * R[3][0] + S0[1] * R[3][1]) + (S0[2] * R[3][2] + S0[3] * R[3][3]);
        float sa1 = (S1[0] * R[3][0] + S1[1] * R[3][1]) + (S1[2] * R[3][2] + S1[3] * R[3][3]);
        sa0 = sum16(sa0); sa1 = sum16(sa1);
        float y0 = 0.f, y1 = 0.f;
#pragma unroll
        for (int k = 0; k < 4; ++k) {
          S0[k] = S0[k] * R[1][k] + (sa0 * R[4][k] + vv[0] * R[2][k]);
          S1[k] = S1[k] * R[1][k] + (sa1 * R[4][k] + vv[1] * R[2][k]);
          y0 += S0[k] * R[0][k]; y1 += S1[k] * R[0][k];
        }
        y0 = sum16(y0); y1 = sum16(y1);
        *(unsigned*)(yp + (size_t)i * 512) = pk2(y0, y1);
      };
      if (c >= 0) { ldstep(0, R0, v0); ldstep(1, R1, v1); }
#pragma unroll 1
      for (int part = 0; part < 3; ++part) {
        if (c >= 0) {
          const int s0 = part * 12, s1 = part == 2 ? 32 : s0 + 12;
          for (int s = s0; s < s1; s += 4) {
            ldstep(s + 2, R2, v2); step(R0, v0, s);
            ldstep(s + 3, R3, v3); step(R1, v1, s + 1);
            ldstep(s + 4, R0, v0); step(R2, v2, s + 2);
            ldstep(s + 5, R1, v1); step(R3, v3, s + 3);
          }
        }
        lds_barrier();
      }
    }
  }
}

DI void merge_phase(const KP& p, int layer, int M) {
  const int lane = otid() & 63, w = otid() >> 6;
  const float* mu0 = p.mu + (size_t)layer * 2 * 1792;
  const float* mu1 = mu0 + 1792;
  for (int row = obid() * 8 + w; row < M; row += gridDim.x * 8) {
    const int ch0 = lane * 8;
    {
      float y0[8], y1[8], y[8];
      unpack8(ld8(p.Yret + (size_t)row * 512 + ch0), y0);
      unpack8(ld8(p.Yret + ((size_t)NTOK + row) * 512 + ch0), y1);
      float s = 0.f;
#pragma unroll
      for (int j = 0; j < 8; ++j) { y[j] = y0[j] + y1[j]; s += y[j]; }
      s += __shfl_xor(s, 1); s += __shfl_xor(s, 2); s += __shfl_xor(s, 4); s += __shfl_xor(s, 8);
      const float mean = s * (1.f / 128.f);
      float v = 0.f;
#pragma unroll
      for (int j = 0; j < 8; ++j) { const float dlt = y[j] - mean; v += dlt * dlt; }
      v += __shfl_xor(v, 1); v += __shfl_xor(v, 2); v += __shfl_xor(v, 4); v += __shfl_xor(v, 8);
      const float rstd = rsqrtf(v * (1.f / 128.f) + 1e-5f);
      float gt[8], o[8];
      unpack8(ld8(p.P + (size_t)row * NIN + 1536 + ch0), gt);
#pragma unroll
      for (int j = 0; j < 8; ++j) o[j] = (y[j] - mean) * rstd * p.ret_gn[layer * 512 + ch0 + j] * silu(gt[j]);
      *(bf16x8*)(p.H + (size_t)row * DM + ch0) = pack8(o);
    }
    {
      float y0[8], y1[8], y[8];
      unpack8(ld8(p.Yrw + (size_t)row * 512 + ch0), y0);
      unpack8(ld8(p.Yrw + ((size_t)NTOK + row) * 512 + ch0), y1);
      float s = 0.f;
#pragma unroll
      for (int j = 0; j < 8; ++j) { y[j] = y0[j] + y1[j]; s += y[j]; }
      s += __shfl_xor(s, 1); s += __shfl_xor(s, 2); s += __shfl_xor(s, 4);
      const float mean = s * (1.f / 64.f);
      float v = 0.f;
#pragma unroll
      for (int j = 0; j < 8; ++j) { const float dlt = y[j] - mean; v += dlt * dlt; }
      v += __shfl_xor(v, 1); v += __shfl_xor(v, 2); v += __shfl_xor(v, 4);
      const float rstd = rsqrtf(v * (1.f / 64.f) + 64e-5f);
      int o, len;
      if (row < NLAT) { o = row & 4095; len = 4096; } else { o = (row - NLAT) & 255; len = 256; }
      float f[3][8];
#pragma unroll
      for (int g = 0; g < 3; ++g) {
        const int col = 3904 + 512 * g + ch0;
        const u16* src = p.P + (size_t)row * NIN + col;
        float cur[8], prv[8], nxt[8];
        unpack8(ld8(src), cur);
        if (o > 0) unpack8(ld8(src - NIN), prv); else { for (int j = 0; j < 8; ++j) prv[j] = 0.f; }
        if (o < len - 1) unpack8(ld8(src + NIN), nxt); else { for (int j = 0; j < 8; ++j) nxt[j] = 0.f; }
#pragma unroll
        for (int j = 0; j < 8; ++j) {
          const float m0v = mu0[col - 3904 + j], m1v = mu1[col - 3904 + j];
          f[g][j] = cur[j] + m0v * (prv[j] - cur[j]) + m1v * (nxt[j] - cur[j]);
        }
      }
      float rk = 0.f;
#pragma unroll
      for (int j = 0; j < 8; ++j) rk += f[0][j] * f[1][j] * p.r_k[layer * 512 + ch0 + j];
      rk += __shfl_xor(rk, 1); rk += __shfl_xor(rk, 2); rk += __shfl_xor(rk, 4);
      float gt[8], ov[8];
      unpack8(ld8(p.P + (size_t)row * NIN + 5696 + ch0), gt);
#pragma unroll
      for (int j = 0; j < 8; ++j)
        ov[j] = ((y[j] - mean) * rstd * p.rw_gn[layer * 512 + ch0 + j] + rk * f[2][j]) * silu(gt[j]);
      *(bf16x8*)(p.H + (size_t)row * DM + 1536 + ch0) = pack8(ov);
    }
  }
}

DI void ln_phase(const KP& p, int layer, int M) {
  const int lane = otid() & 63, w = otid() >> 6;
  const float* g = p.ln_g + layer * DM;
  const float* bb_ = p.ln_b + layer * DM;
  for (int row = obid() * 8 + w; row < M; row += gridDim.x * 8) {
    float* ptr = row < NLAT ? p.out + (size_t)row * DM : p.X1c + (size_t)(row - NLAT) * DM;
    f32x4 v[8];
    float s = 0.f;
#pragma unroll
    for (int i = 0; i < 8; ++i) { v[i] = *(const f32x4*)(ptr + (i * 64 + lane) * 4); s += v[i][0] + v[i][1] + v[i][2] + v[i][3]; }
#pragma unroll
    for (int o = 1; o < 64; o <<= 1) s += __shfl_xor(s, o);
    const float mean = s * (1.f / 2048.f);
    float q = 0.f;
#pragma unroll
    for (int i = 0; i < 8; ++i)
#pragma unroll
      for (int j = 0; j < 4; ++j) { const float dlt = v[i][j] - mean; q += dlt * dlt; }
#pragma unroll
    for (int o = 1; o < 64; o <<= 1) q += __shfl_xor(q, o);
    const float rstd = rsqrtf(q * (1.f / 2048.f) + 1e-5f);
    const int bidx = row < NLAT ? (row >> 12) : 4;
    const float* md = p.mod + ((size_t)5 + bidx) * 6144;
#pragma unroll
    for (int i = 0; i < 8; ++i) {
      const int c = (i * 64 + lane) * 4;
      f32x4 gg = *(const f32x4*)(g + c), bbv = *(const f32x4*)(bb_ + c), y;
#pragma unroll
      for (int j = 0; j < 4; ++j) y[j] = (v[i][j] - mean) * rstd * gg[j] + bbv[j];
      *(f32x4*)(ptr + c) = y;
      if (layer == 0) {
        f32x4 sh = *(const f32x4*)(md + c), scl = *(const f32x4*)(md + 2048 + c);
        u32x2 o;
        o[0] = pk2(y[0] * (1.f + scl[0]) + sh[0], y[1] * (1.f + scl[1]) + sh[1]);
        o[1] = pk2(y[2] * (1.f + scl[2]) + sh[2], y[3] * (1.f + scl[3]) + sh[3]);
        *(u32x2*)(p.H + (size_t)row * DM + c) = o;
      }
    }
  }
}

#define XB_TMO      128
#define XB_XCNT(j)  (256  + 64 * (j))
#define XB_XSUB(j)  (1280 + 64 * (j))
#define XB_XGEN(j)  (2304 + 64 * (j))
#define XB_TOP      3328
#define XB_TOPGEN   3392
#define XCD_BAR_WORDS 3456
#define XB_SPIN_CAP (1u << 18)
#define LAS __attribute__((address_space(3)))

__device__ __forceinline__ unsigned xb_ld(unsigned* p)              { return __hip_atomic_load(p, __ATOMIC_RELAXED, __HIP_MEMORY_SCOPE_AGENT); }
__device__ __forceinline__ unsigned xb_add(unsigned* p, unsigned v) { return __hip_atomic_fetch_add(p, v, __ATOMIC_RELAXED, __HIP_MEMORY_SCOPE_AGENT); }
__device__ __forceinline__ unsigned xb_xcc_id() { return (unsigned)__builtin_amdgcn_s_getreg((3 << 11) | 20) & 0xFu; }
#define XB_SPIN(cond, bar) do { unsigned _sp = 0; while (cond) { __builtin_amdgcn_s_sleep(1); \
    if ((++_sp & 255u) == 0u) { if (xb_ld(&(bar)[XB_TMO])) break; if (_sp > XB_SPIN_CAP) { atomicAdd(&(bar)[XB_TMO], 1u); break; } } } } while (0)

struct XcdBarrier {
    unsigned* bar; unsigned x;
    volatile LAS unsigned* st;
};

__device__ __forceinline__ XcdBarrier xcd_barrier_post(unsigned* bar, volatile LAS unsigned* st) {
    XcdBarrier b; b.bar = bar; b.x = xb_xcc_id(); b.st = st;
    if (threadIdx.x == 0) (void)xb_add(&bar[XB_XCNT(b.x)], 1u);
    return b;
}
__device__ __forceinline__ void xcd_barrier_complete(unsigned* bar, unsigned x, unsigned& nloc, unsigned& nx) {
    const unsigned G = gridDim.x * gridDim.y * gridDim.z;
    unsigned sum, cnt, mine, sp = 0u;
    for (;;) {
        sum = 0u; cnt = 0u; mine = 0u;
#pragma unroll
        for (unsigned j = 0; j < 16; ++j) { const unsigned c = xb_ld(&bar[XB_XCNT(j)]); sum += c; cnt += (c > 0u) ? 1u : 0u; mine = (j == x) ? c : mine; }
        if (sum == G) break;
        __builtin_amdgcn_s_sleep(1);
        if ((++sp & 255u) == 0u) { if (xb_ld(&bar[XB_TMO])) break; if (sp > XB_SPIN_CAP) { atomicAdd(&bar[XB_TMO], 1u); break; } }
    }
    nloc = mine > 0u ? mine : 1u; nx = cnt > 0u ? cnt : 1u;
}

__device__ __forceinline__ void xcd_barrier(const XcdBarrier& b) {
    asm volatile("s_waitcnt vmcnt(0)" ::: "memory");
    __syncthreads();
    if (threadIdx.x == 0) {
        unsigned* bar = b.bar;
        __builtin_amdgcn_s_waitcnt(0);
        unsigned nloc = b.st[0], nx = b.st[1];
        if (nloc == 0u) { xcd_barrier_complete(bar, b.x, nloc, nx); b.st[0] = nloc; b.st[1] = nx; }
        const unsigned old = xb_add(&bar[XB_XSUB(b.x)], 1u);
        const unsigned gen = old / nloc;
        if (old + 1u == (gen + 1u) * nloc) {
            __builtin_amdgcn_fence(__ATOMIC_RELEASE, "agent");
            asm volatile("s_waitcnt vmcnt(0)" ::: "memory");
            const unsigned og = xb_add(&bar[XB_TOP], 1u);
            const unsigned tg = og / nx;
            if (og + 1u == (tg + 1u) * nx) xb_add(&bar[XB_TOPGEN], 1u);
            else XB_SPIN(xb_ld(&bar[XB_TOPGEN]) == tg, bar);
            __builtin_amdgcn_fence(__ATOMIC_ACQUIRE, "agent");
            xb_add(&bar[XB_XGEN(b.x)], 1u);
            asm volatile("s_waitcnt vmcnt(0)" ::: "memory");
        } else {
            XB_SPIN(xb_ld(&bar[XB_XGEN(b.x)]) == gen, bar);
            __builtin_amdgcn_fence(__ATOMIC_ACQUIRE, "agent");
            asm volatile("s_waitcnt vmcnt(0)" ::: "memory");
        }
    }
    __syncthreads();
}


__global__ void __launch_bounds__(NTHR) hybrid_block_megakernel(KP p) {
  extern __shared__ __attribute__((aligned(16))) char smem[];
  cg::grid_group grid = cg::this_grid();
  __shared__ int s_item;
  const int tid = otid();
  __shared__ uint4 xb_words;
  if (threadIdx.x == 0) xb_words = make_uint4(0u, 0u, 0u, 0u);
  __syncthreads();
  const XcdBarrier xb = xcd_barrier_post(p.cnt + 128, (volatile LAS unsigned*)&xb_words);

  mod_phase(p, smem);
  convert_weights(p, 0, smem);
  grid.sync();
  h0_phase(p);
  xcd_barrier(xb);

  for (int layer = 0; layer < 2; ++layer) {
    const int Mq = layer == 0 ? NTOK : NLAT;
    for (int it = obid(); it < 68 * 25; it += gridDim.x) {
      const int nt = it / 68, mt = it % 68;
      gemm_tile(p, 0, layer, mt * 256, nt * 256, smem);
    }
    xcd_barrier(xb);
    {
      const int n_uq = (Mq / 256) * 6, n_ukv = 68 * 8, n_kr = NTOK / 8;
      for (int it = obid(); it < n_uq + n_ukv + n_kr; it += gridDim.x) {
        if (it < n_uq) gemm_tile(p, 1, layer, (it / 6) * 256, (it % 6) * 256, smem);
        else if (it < n_uq + n_ukv) { const int i = it - n_uq; gemm_tile(p, 2, layer, (i / 8) * 256, (i % 8) * 256, smem); }
        else krope_item(p, it - n_uq - n_ukv);
      }
    }
    xcd_barrier(xb);
    {
      for (int ch = obid(); ch < 160; ch += gridDim.x) {
        if (ch < 128) rwkv_chain(p, layer, ch, smem); else ret_chain(p, layer, ch - 128, smem);
      }
      const int n_att = layer == 0 ? 512 + 32 : 512;
      while (true) {
        __syncthreads();
        if (tid == 0) s_item = (int)atomicAdd(&p.cnt[layer], 1u);
        __syncthreads();
        const int it = s_item;
        if (it >= n_att) break;
        if (it < 512) {
          const int b = it >> 7, hd = (it >> 4) & 7, qb = it & 15;
          attn_item(p, b * 4096 + qb * 256, b, hd, LPOS, smem);
        } else {
          const int i = it - 512, b = i >> 3, hd = i & 7;
          attn_item(p, NLAT + b * 256, b, hd, 256, smem);
        }
      }
    }
    xcd_barrier(xb);
    merge_phase(p, layer, Mq);
    xcd_barrier(xb);
    for (int it = obid(); it < (Mq / 256) * 8; it += gridDim.x) {
      const int nt = it % 8, mt = it / 8;
      gemm_tile(p, 3, layer, mt * 256, nt * 256, smem);
    }
    xcd_barrier(xb);
    ln_phase(p, layer, Mq);
    if (layer == 0) {
      convert_weights(p, 1, smem);
      xcd_barrier(xb);
    }
  }
}

extern "C" void kernel_launch(void* const* d_in, const int* in_sizes, int n_in, void* d_out, int out_size, void* d_ws,
                              size_t ws_size, hipStream_t stream) {
  static int grid_blocks = 0;
  if (!grid_blocks) {
    int dev = 0, cus = 0, per_cu = 0;
    hipGetDevice(&dev);
    hipDeviceGetAttribute(&cus, hipDeviceAttributeMultiprocessorCount, dev);
    hipFuncSetAttribute((const void*)hybrid_block_megakernel, hipFuncAttributeMaxDynamicSharedMemorySize, (int)LDS_BYTES);
    hipOccupancyMaxActiveBlocksPerMultiprocessor(&per_cu, hybrid_block_megakernel, NTHR, LDS_BYTES);
    if (per_cu > 1) per_cu = 1;
    grid_blocks = cus * per_cu;
  }
  KP p{};
  const float* const* in = (const float* const*)d_in;
  p.x = in[0]; p.c = in[1]; p.ctx = in[2]; p.c_ctx = in[3]; p.w_ada = in[4]; p.b_ada = in[5]; p.w_in = in[6];
  p.ret_logit = in[7]; p.ret_gn = in[8]; p.q_g = in[9]; p.w_uq = in[10]; p.kv_g = in[11]; p.w_ukv = in[12]; p.mu = in[13];
  p.w0 = in[14]; p.w2 = in[15]; p.a0 = in[16]; p.a2 = in[17]; p.k_k = in[18]; p.k_a = in[19]; p.r_k = in[20]; p.rw_gn = in[21];
  p.w_out = in[22]; p.ln_g = in[23]; p.ln_b = in[24];
  p.out = (float*)d_out;
  char* ws = (char*)d_ws;
  size_t off = 0;
  auto take = [&](size_t bytes) { char* r = ws + off; off += (bytes + 255) & ~(size_t)255; return r; };
  p.P = (u16*)take((size_t)NTOK * NIN * 2);
  p.H = (u16*)take((size_t)NTOK * DM * 2);
  p.Q = (u16*)take((size_t)NTOK * 1536 * 2);
  p.Kn = (u16*)take((size_t)4 * 8 * LPOS * 128 * 2);
  p.Vt = (u16*)take((size_t)4 * 8 * 128 * LPOS * 2);
  p.Kr = (u16*)take((size_t)4 * LPOS * 64 * 2);
  p.Yret = (u16*)take((size_t)2 * NTOK * 512 * 2);
  p.Yrw = (u16*)take((size_t)2 * NTOK * 512 * 2);
  p.WinT = (u16*)take((size_t)NIN * DM * 2);
  p.WuqT = (u16*)take((size_t)1536 * 512 * 2);
  p.WukvT = (u16*)take((size_t)2048 * 256 * 2);
  p.WoutT = (u16*)take((size_t)DM * DM * 2);
  p.W2T = (u16*)take((size_t)2 * 512 * 64 * 2);
  p.A2T = (u16*)take((size_t)2 * 512 * 64 * 2);
  p.X1c = (float*)take((size_t)1024 * DM * 4);
  p.mod = (float*)take((size_t)2 * 5 * 6144 * 4);
  p.cnt = (unsigned*)take(512 + XCD_BAR_WORDS * 4);
  if (off > ws_size) { fprintf(stderr, "workspace too small: need %zu have %zu\n", off, ws_size); return; }
  hipMemsetAsync(p.cnt, 0, 512 + XCD_BAR_WORDS * 4, stream);
  void* args[] = {&p};
  hipError_t e = hipLaunchCooperativeKernel((void*)hybrid_block_megakernel, dim3(grid_blocks), dim3(NTHR), args, LDS_BYTES, stream);
  if (e != hipSuccess) fprintf(stderr, "cooperative launch failed: %s (grid %d)\n", hipGetErrorString(e), grid_blocks);
}
```

```cpp
#include <hip/hip_runtime.h>
#include <hip/hip_cooperative_groups.h>
#include <cstdio>
namespace cg = cooperative_groups;

#define DI __device__ __forceinline__
typedef unsigned short u16;
using bf16x8 = __attribute__((ext_vector_type(8))) short;
using s16x4 = __attribute__((ext_vector_type(4))) short;
using f32x16 = __attribute__((ext_vector_type(16))) float;
using f32x4 = __attribute__((ext_vector_type(4))) float;
using u32x4 = __attribute__((ext_vector_type(4))) unsigned;
using u32x2 = __attribute__((ext_vector_type(2))) unsigned;
using f32x2 = __attribute__((ext_vector_type(2))) float;
#define MFMA(a, b, c) __builtin_amdgcn_mfma_f32_32x32x16_bf16((a), (b), (c), 0, 0, 0)

constexpr int DM = 2048, NIN = 6208, NLAT = 16384, NTOK = 17408, LPOS = 4352;
constexpr int NTHR = 512;
constexpr size_t LDS_BYTES = 149504;
constexpr float ALPHA = 1.4142135623730951f;
constexpr float QSCALE = 0.07216878364870323f * 1.4426950408889634f;

struct KP {
  const float *x, *c, *ctx, *c_ctx, *w_ada, *b_ada, *w_in, *ret_logit, *ret_gn, *q_g, *w_uq, *kv_g, *w_ukv, *mu, *w0, *w2, *a0,
      *a2, *k_k, *k_a, *r_k, *rw_gn, *w_out, *ln_g, *ln_b;
  float* out;
  u16 *P, *H, *Q, *Kn, *Vt, *Kr, *Yret, *Yrw, *WinT, *WuqT, *WukvT, *WoutT, *W2T, *A2T;
  float *X1c, *mod;
  unsigned* cnt;
};

DI int otid() { int t = threadIdx.x; asm volatile("" : "+v"(t)); return t; }
DI int obid() { int t = blockIdx.x; asm volatile("" : "+s"(t)); return t; }
template <int CTRL> DI float dppf(float v) {
  return __builtin_bit_cast(float, __builtin_amdgcn_update_dpp(0, __builtin_bit_cast(int, v), CTRL, 0xf, 0xf, true));
}
DI float sum8(float x) { x += dppf<0xB1>(x); x += dppf<0x4E>(x); x += dppf<0x141>(x); return x; }
DI float sum16(float x) { x += dppf<0xB1>(x); x += dppf<0x4E>(x); x += dppf<0x141>(x); x += dppf<0x140>(x); return x; }
DI void lds_barrier() { asm volatile("s_waitcnt lgkmcnt(0)\n\ts_barrier" ::: "memory"); }
DI float bf2f(u16 v) { return __uint_as_float(((unsigned)v) << 16); }
DI float bflo(unsigned v) { return __uint_as_float(v << 16); }
DI float bfhi(unsigned v) { return __uint_as_float(v & 0xffff0000u); }
DI u16 f2bf(float a) { __bf16 r = (__bf16)a; return __builtin_bit_cast(u16, r); }
DI unsigned pk2(float a, float b) {
  typedef __bf16 bf2 __attribute__((ext_vector_type(2)));
  typedef float f2 __attribute__((ext_vector_type(2)));
  f2 v = {a, b};
  bf2 r = __builtin_convertvector(v, bf2);
  return __builtin_bit_cast(unsigned, r);
}
DI int crow(int reg, int h) { return (reg & 3) + 8 * (reg >> 2) + 4 * h; }
DI float silu(float x) { return x / (1.f + __expf(-x)); }
DI void unpack8(const bf16x8& v, float* f) {
  u32x4 u = __builtin_bit_cast(u32x4, v);
#pragma unroll
  for (int i = 0; i < 4; ++i) { f[2 * i] = bflo(u[i]); f[2 * i + 1] = bfhi(u[i]); }
}
DI bf16x8 pack8(const float* f) {
  u32x4 u;
#pragma unroll
  for (int i = 0; i < 4; ++i) u[i] = pk2(f[2 * i], f[2 * i + 1]);
  return __builtin_bit_cast(bf16x8, u);
}
DI bf16x8 ld8(const u16* p) { return *(const bf16x8*)p; }
DI bf16x8 zero8() { bf16x8 z = {0, 0, 0, 0, 0, 0, 0, 0}; return z; }
DI f32x16 zero16() { f32x16 z; for (int i = 0; i < 16; ++i) z[i] = 0.f; return z; }
DI s16x4 trread(const u16* p) {
  return __builtin_amdgcn_ds_read_tr16_b64_v4i16((s16x4 __attribute__((address_space(3)))*)(p));
}
DI bf16x8 cat4(s16x4 lo, s16x4 hi) { return __builtin_shufflevector(lo, hi, 0, 1, 2, 3, 4, 5, 6, 7); }
DI void rope_cs(int pos, int i, float& cs, float& sn) {
  float inv = exp2f(-(float)i * (13.287712379549449f / 16.f));
  float rev = (float)pos * inv * 0.15915494309189535f;
  rev -= floorf(rev);
  cs = __builtin_amdgcn_cosf(rev);
  sn = __builtin_amdgcn_sinf(rev);
}

DI void transpose_item(const float* src, u16* dst, int K, int N, int kt, int nt, char* smem) {
  float* tile = (float*)smem;
  const int tid = otid();
  __syncthreads();
  {
    const int kk = tid >> 4, n4 = tid & 15;
#pragma unroll
    for (int i = 0; i < 2; ++i) {
      const int k = kk + 32 * i;
      f32x4 v = *(const f32x4*)(src + (size_t)(kt * 64 + k) * N + nt * 64 + n4 * 4);
      tile[k * 65 + n4 * 4 + 0] = v[0]; tile[k * 65 + n4 * 4 + 1] = v[1];
      tile[k * 65 + n4 * 4 + 2] = v[2]; tile[k * 65 + n4 * 4 + 3] = v[3];
    }
  }
  __syncthreads();
  {
    const int n = tid >> 3, k8 = tid & 7;
    float f[8];
#pragma unroll
    for (int j = 0; j < 8; ++j) f[j] = tile[(k8 * 8 + j) * 65 + n];
    *(bf16x8*)(dst + (size_t)(nt * 64 + n) * K + kt * 64 + k8 * 8) = pack8(f);
  }
}

DI void convert_weights(const KP& p, int layer, char* smem, int b0 = 0) {
  const int n_in = 32 * 97, n_uq = 8 * 24, n_ukv = 4 * 32, n_out = 32 * 32, n_lora = 8;
  const int total = n_in + n_uq + n_ukv + n_out + 4 * n_lora;
  for (int it = obid() - b0; it < total; it += (int)gridDim.x - b0) {
    if (it < 0) break;
    int i = it;
    if (i < n_in) { transpose_item(p.w_in + (size_t)layer * DM * NIN, p.WinT, DM, NIN, i / 97, i % 97, smem); continue; }
    i -= n_in;
    if (i < n_uq) { transpose_item(p.w_uq + (size_t)layer * 512 * 1536, p.WuqT, 512, 1536, i / 24, i % 24, smem); continue; }
    i -= n_uq;
    if (i < n_ukv) { transpose_item(p.w_ukv + (size_t)layer * 256 * 2048, p.WukvT, 256, 2048, i / 32, i % 32, smem); continue; }
    i -= n_ukv;
    if (i < n_out) { transpose_item(p.w_out + (size_t)layer * DM * DM, p.WoutT, DM, DM, i / 32, i % 32, smem); continue; }
    i -= n_out;
    {
      const int which = i / (2 * n_lora), r = i % (2 * n_lora), d = r / n_lora, nt = r % n_lora;
      const float* src = (which ? p.a2 : p.w2) + ((size_t)layer * 2 + d) * 64 * 512;
      u16* dst = (which ? p.A2T : p.W2T) + (size_t)d * 512 * 64;
      transpose_item(src, dst, 64, 512, 0, nt, smem);
    }
  }
}

DI void mod_phase(const KP& p, char* smem) {
  float* sc = (float*)smem;
  float* red = sc + 5 * 2048;
  const int tid = otid();
  __syncthreads();
  for (int i = tid; i < 5 * 2048; i += NTHR) {
    float v = i < 4 * 2048 ? p.c[i] : p.c_ctx[i - 4 * 2048];
    sc[i] = silu(v);
  }
  __syncthreads();
  const int kg = tid >> 5, col = tid & 31;
  for (int it = obid(); it < 384; it += gridDim.x) {
    const int layer = it / 192, j = (it % 192) * 32 + col;
    const float* w = p.w_ada + (size_t)layer * DM * 6144 + j;
    float acc[5] = {0.f, 0.f, 0.f, 0.f, 0.f};
    for (int k = kg * 128; k < kg * 128 + 128; k += 16) {
      float wv[16];
#pragma unroll
      for (int u = 0; u < 16; ++u) wv[u] = w[(size_t)(k + u) * 6144];
#pragma unroll
      for (int u = 0; u < 16; ++u)
#pragma unroll
        for (int r = 0; r < 5; ++r) acc[r] += sc[r * 2048 + k + u] * wv[u];
    }
#pragma unroll
    for (int r = 0; r < 5; ++r) red[(kg * 5 + r) * 32 + col] = acc[r];
    __syncthreads();
    if (tid < 160) {
      const int r = tid >> 5;
      float s = p.b_ada[(size_t)layer * 6144 + j];
      for (int g = 0; g < 16; ++g) s += red[(g * 5 + r) * 32 + col];
      p.mod[((size_t)layer * 5 + r) * 6144 + j] = s;
    }
    __syncthreads();
  }
}

DI void h0_phase(const KP& p) {
  const int lane = otid() & 63, w = otid() >> 6;
  for (int row = obid() * 8 + w; row < NTOK; row += gridDim.x * 8) {
    const float* src = row < NLAT ? p.x + (size_t)row * DM : p.ctx + (size_t)(row - NLAT) * DM;
    const int bb = row < NLAT ? (row >> 12) : 4;
    const float* md = p.mod + (size_t)bb * 6144;
#pragma unroll
    for (int i = 0; i < 8; ++i) {
      const int c = (i * 64 + lane) * 4;
      f32x4 v = *(const f32x4*)(src + c), sh = *(const f32x4*)(md + c), scl = *(const f32x4*)(md + 2048 + c);
      u32x2 o;
      o[0] = pk2(v[0] * (1.f + scl[0]) + sh[0], v[1] * (1.f + scl[1]) + sh[1]);
      o[1] = pk2(v[2] * (1.f + scl[2]) + sh[2], v[3] * (1.f + scl[3]) + sh[3]);
      *(u32x2*)(p.H + (size_t)row * DM + c) = o;
    }
  }
}

namespace pg8 {
#define PG8_LAS __attribute__((address_space(3)))
typedef unsigned short bf16_t;
typedef short bf16x8 __attribute__((ext_vector_type(8)));
typedef float f32x4 __attribute__((ext_vector_type(4)));
typedef unsigned u32x4 __attribute__((ext_vector_type(4)));
constexpr int BM = 256, BK = 64, HALF = 128, HTB = HALF * BK * 2  , STAGE_BYTES = 8 * HTB, NXCD = 8, WGM = 8;

__host__ __device__ __forceinline__ int lds_byte(int r, int c) { const int st = (r >> 4) * 2 + (c >> 5), rr = r & 15, cc = c & 31, ob = rr * 64 + cc * 2; return st * 1024 + (ob ^ (((ob >> 9) & 1) << 5)); }
__host__ __device__ __forceinline__ void stage_rc(int b, int& R, int& C) { const int st = b / 1024, sb = b % 1024, swz = sb ^ (((sb >> 9) & 1) << 5); R = (st >> 1) * 16 + swz / 64; C = (st & 1) * 32 + (swz % 64) / 2; }
__host__ __device__ __forceinline__ int perm32(int rho) { const int n = rho >> 4, i = rho & 15; return 8 * (i >> 2) + 4 * n + (i & 3); }

struct Unit { int pm, pn; };
struct Gemm { const bf16_t* A; const bf16_t* Bt; int M, N, K; };

struct StaticOrder {
    int nM, nN, nwg, G, c;
    __host__ __device__ void init(int M, int N, int G_, int c_) { nM = M / BM; nN = N / BM; nwg = nM * nN; G = G_; c = c_; }
    __host__ __device__ bool next(int i, Unit& u) const {
        const long L = (long)i * G + c; if (L >= nwg) return false;
        int wgid = (int)L; { const int q = nwg / NXCD, r = nwg % NXCD, xcd = wgid % NXCD, off = wgid / NXCD; wgid = (xcd < r ? xcd * (q + 1) : r * (q + 1) + (xcd - r) * q) + off; }
        const int nig = WGM * nN, gid = wgid / nig, fm = gid * WGM, gsz = (nM - fm) < WGM ? (nM - fm) : WGM;
        u.pm = fm + ((wgid % nig) % gsz); u.pn = (wgid % nig) / gsz; return true;
    }
    __device__ __forceinline__ void a_ready(const Unit&) const {}
    __device__ __forceinline__ void done(const Unit&) const {}
};
__device__ __forceinline__ unsigned cvt_pk_bf16(float lo, float hi) { unsigned r; asm volatile("v_cvt_pk_bf16_f32 %0, %1, %2" : "=v"(r) : "v"(lo), "v"(hi)); return r; }

template <class Epi, class Sched, bool STAMP = false>
__device__ __forceinline__ void gemm_phase(PG8_LAS unsigned char* lds, const Gemm g, const Sched& S, const Epi& E, unsigned long long* stamps) {
    const int tid = otid(), wid = __builtin_amdgcn_readfirstlane(tid >> 6), lane = tid & 63, wr = wid >> 2, wc = wid & 3, fr = lane & 15, fq = lane >> 4;
    const int K = g.K, nt = K / BK;
    int ts_lo = 0, ts_hi = 0, nts = 0; const unsigned long long rt_entry = STAMP ? (unsigned long long)wall_clock64() : 0ull;
#define PG8_STAMP() do { if (STAMP && wid == 0 && nts < 64) { const unsigned long long _c = (unsigned long long)clock64(); \
        ts_lo = (lane == nts) ? (int)(unsigned)_c : ts_lo; ts_hi = (lane == nts) ? (int)(unsigned)(_c >> 32) : ts_hi; ++nts; } } while (0)
    PG8_STAMP();
    unsigned voffA[2], voffB[2];
#pragma unroll
    for (int i = 0; i < 2; ++i) { int R, C; stage_rc(tid * 16 + i * 8192, R, C); const int Rb = Epi::PERM ? ((R & ~31) + perm32(R & 31)) : R;
        voffA[i] = (unsigned)(R * K + C) * 2u; voffB[i] = (unsigned)(Rb * K + C) * 2u; }
    const size_t kstep = (size_t)(BK * 2);
    const size_t hstep = (size_t)HALF * K * 2;
    const size_t tstep = 2 * hstep;
    const unsigned ldsw = (unsigned)wid * 1024u;
    const int aoff = lds_byte(wr * 64 + fr, fq * 8), boff = lds_byte(wc * 32 + fr, fq * 8);
#define PG8_SA(b, h) (((b) * 2 + (h)) * HTB)
#define PG8_SB(b, h) ((4 + (b) * 2 + (h)) * HTB)
#define PG8_STAGE(bufoff, gbase, voff) do { _Pragma("unroll") for (int _i = 0; _i < 2; ++_i) \
        __builtin_amdgcn_global_load_lds((const unsigned*)((const char*)(gbase) + (voff)[_i]), (PG8_LAS unsigned*)(lds + (bufoff) + ldsw + _i * 8192), 16, 0, 0); } while (0)
#define PG8_LDA(dst, b, h) do { _Pragma("unroll") for (int m = 0; m < 4; ++m) _Pragma("unroll") for (int k = 0; k < 2; ++k) dst[m][k] = *(const PG8_LAS bf16x8*)(lds + PG8_SA(b, h) + aoff + m * 2048 + k * 1024); } while (0)
#define PG8_LDB(dst, b, h) do { _Pragma("unroll") for (int n = 0; n < 2; ++n) _Pragma("unroll") for (int k = 0; k < 2; ++k) dst[n][k] = *(const PG8_LAS bf16x8*)(lds + PG8_SB(b, h) + boff + n * 2048 + k * 1024); } while (0)
#define PG8_MMA(ai, bj, At, Bt) do { __builtin_amdgcn_s_setprio(1); _Pragma("unroll") for (int m = 0; m < 4; ++m) _Pragma("unroll") for (int n = 0; n < 2; ++n) _Pragma("unroll") for (int k = 0; k < 2; ++k) \
        acc[ai][bj][m][n] = __builtin_amdgcn_mfma_f32_16x16x32_bf16(Bt[n][k], At[m][k], acc[ai][bj][m][n], 0, 0, 0); __builtin_amdgcn_s_setprio(0); } while (0)
#define PG8_WAIT_V(n) asm volatile("s_waitcnt vmcnt(" #n ")" ::: "memory")
#define PG8_WAIT_L(n) asm volatile("s_waitcnt lgkmcnt(" #n ")" ::: "memory")
#define PG8_BAR __builtin_amdgcn_s_barrier()
#define PG8_SCHED __builtin_amdgcn_sched_barrier(0)
    Unit cur, nxt; int ui = 0;
    if (!S.next(0, cur)) return;
    f32x4 acc[2][2][4][2];
#pragma unroll
    for (int a = 0; a < 2; ++a)
#pragma unroll
        for (int b = 0; b < 2; ++b)
#pragma unroll
            for (int m = 0; m < 4; ++m)
#pragma unroll
                for (int n = 0; n < 2; ++n) acc[a][b][m][n] = (f32x4){0.f, 0.f, 0.f, 0.f};
    bf16x8 At[4][2], B0[2][2], B1[2][2];
    const char* cA = (const char*)g.A + (size_t)cur.pm * tstep; const char* cB = (const char*)g.Bt + (size_t)cur.pn * tstep;
    S.a_ready(cur);
    PG8_STAGE(PG8_SB(0, 0), cB, voffB); PG8_STAGE(PG8_SA(0, 0), cA, voffA); PG8_STAGE(PG8_SB(0, 1), cB + hstep, voffB); PG8_STAGE(PG8_SA(0, 1), cA + hstep, voffA);
    if (wr == 1) PG8_BAR;
    PG8_WAIT_V(4); PG8_BAR;
    PG8_STAGE(PG8_SB(1, 0), cB + kstep, voffB); PG8_STAGE(PG8_SA(1, 0), cA + kstep, voffA); PG8_STAGE(PG8_SB(1, 1), cB + hstep + kstep, voffB);
    PG8_WAIT_V(6); PG8_BAR;
    PG8_STAMP();
    for (;;) {
        const bool has_next = S.next(ui + 1, nxt);
        const char* nA = has_next ? (const char*)g.A + (size_t)nxt.pm * tstep : cA; const char* nB = has_next ? (const char*)g.Bt + (size_t)nxt.pn * tstep : cB;
        for (int t = 0; t < nt; t += 2) {
            const bool last = (t == nt - 2);
            const char* a1 = cA + (size_t)(t + 1) * kstep;
            const char* a2 = last ? nA : cA + (size_t)(t + 2) * kstep; const char* b2 = last ? nB : cB + (size_t)(t + 2) * kstep;
            const char* a3 = a2 + kstep; const char* b3 = b2 + kstep;
            if (last && has_next) S.a_ready(nxt);
            PG8_LDB(B0, 0, 0); PG8_SCHED; PG8_LDA(At, 0, 0); PG8_STAGE(PG8_SA(1, 1), a1 + hstep, voffA);
            PG8_WAIT_L(8); PG8_BAR; PG8_WAIT_L(0); PG8_MMA(0, 0, At, B0); PG8_BAR; PG8_SCHED;
            PG8_LDB(B1, 0, 1); PG8_STAGE(PG8_SB(0, 0), b2, voffB);
            PG8_BAR; PG8_WAIT_L(0); PG8_MMA(0, 1, At, B1); PG8_BAR;
            PG8_LDA(At, 0, 1); PG8_STAGE(PG8_SA(0, 0), a2, voffA);
            PG8_BAR; PG8_WAIT_L(0); PG8_MMA(1, 0, At, B0); PG8_BAR; PG8_SCHED;
            PG8_STAGE(PG8_SB(0, 1), b2 + hstep, voffB);
            PG8_WAIT_V(6); PG8_BAR; PG8_MMA(1, 1, At, B1); PG8_BAR;
            PG8_LDB(B0, 1, 0); PG8_SCHED; PG8_LDA(At, 1, 0); PG8_STAGE(PG8_SA(0, 1), a2 + hstep, voffA);
            PG8_WAIT_L(8); PG8_BAR; PG8_WAIT_L(0); PG8_MMA(0, 0, At, B0); PG8_BAR; PG8_SCHED;
            PG8_LDB(B1, 1, 1); PG8_STAGE(PG8_SB(1, 0), b3, voffB);
            PG8_BAR; PG8_WAIT_L(0); PG8_MMA(0, 1, At, B1); PG8_BAR;
            PG8_LDA(At, 1, 1); PG8_STAGE(PG8_SA(1, 0), a3, voffA);
            PG8_BAR; PG8_WAIT_L(0); PG8_MMA(1, 0, At, B0); PG8_BAR; PG8_SCHED;
            PG8_STAGE(PG8_SB(1, 1), b3 + hstep, voffB);
            PG8_WAIT_V(6); PG8_BAR; PG8_MMA(1, 1, At, B1); PG8_BAR;
        }
        PG8_STAMP();
        if constexpr (!Epi::AFTER_DRAIN) { E(acc, cur, wr, wc, fr, fq); S.done(cur); }
        PG8_STAMP();
        if (!has_next) break;
#pragma unroll
        for (int a = 0; a < 2; ++a)
#pragma unroll
            for (int b = 0; b < 2; ++b)
#pragma unroll
                for (int m = 0; m < 4; ++m)
#pragma unroll
                    for (int n = 0; n < 2; ++n) acc[a][b][m][n] = (f32x4){0.f, 0.f, 0.f, 0.f};
        cur = nxt; cA = nA; cB = nB; ++ui;
    }
    PG8_WAIT_V(0);
    if (wr == 0) PG8_BAR;
    PG8_BAR;
    if constexpr (Epi::AFTER_DRAIN) { E.fused(acc, cur, wr, wc, fr, fq, lds, wid, lane); S.done(cur); }
    PG8_STAMP();
    if (STAMP && wid == 0) { stamps[lane] = lane < nts ? (((unsigned long long)(unsigned)ts_hi << 32) | (unsigned)ts_lo) : 0ull;
        if (lane == 62) stamps[62] = rt_entry; if (lane == 63) stamps[63] = (unsigned long long)wall_clock64(); }
#undef PG8_STAMP
#undef PG8_SA
#undef PG8_SB
#undef PG8_STAGE
#undef PG8_LDA
#undef PG8_LDB
#undef PG8_MMA
#undef PG8_WAIT_V
#undef PG8_WAIT_L
#undef PG8_BAR
#undef PG8_SCHED
}

struct EpiP {
    static constexpr bool PERM = true, AFTER_DRAIN = false;
    bf16_t* O;
    __device__ __forceinline__ void operator()(const f32x4 (&acc)[2][2][4][2], const Unit& u, int wr, int wc, int fr, int fq) const {
        const int row0 = u.pm * BM + wr * 64 + fr, col0 = u.pn * BM + wc * 32 + 8 * fq;
#pragma unroll
        for (int ai = 0; ai < 2; ++ai)
#pragma unroll
            for (int m = 0; m < 4; ++m) { bf16_t* rowp = O + (size_t)(row0 + ai * HALF + m * 16) * 6208 + col0;
#pragma unroll
                for (int bj = 0; bj < 2; ++bj) { if (col0 + bj * HALF >= 6208) continue;
                    const f32x4 v0 = acc[ai][bj][m][0], v1 = acc[ai][bj][m][1];
                    u32x4 w; w.x = cvt_pk_bf16(v0[0], v0[1]); w.y = cvt_pk_bf16(v0[2], v0[3]); w.z = cvt_pk_bf16(v1[0], v1[1]); w.w = cvt_pk_bf16(v1[2], v1[3]);
                    *(u32x4*)(rowp + bj * HALF) = w; } }
    }
};
struct EpiZ {
    static constexpr bool PERM = false, AFTER_DRAIN = false;
    const float* xlat; const float* xctx; float* olat; float* octx; const float* mod;
    __device__ __forceinline__ void operator()(const f32x4 (&acc)[2][2][4][2], const Unit& u, int wr, int wc, int fr, int fq) const {
        const int row0 = u.pm * BM + wr * 64 + fr, col0 = u.pn * BM + wc * 32 + 4 * fq;
#pragma unroll
        for (int ai = 0; ai < 2; ++ai)
#pragma unroll
            for (int m = 0; m < 4; ++m) {
                const int row = row0 + ai * HALF + m * 16;
                const bool lat = row < 16384;
                const int bb = lat ? (row >> 12) : 4;
                const float* xr = lat ? xlat + (size_t)row * 2048 : xctx + (size_t)(row - 16384) * 2048;
                float* orow = lat ? olat + (size_t)row * 2048 : octx + (size_t)(row - 16384) * 2048;
                const float* gr = mod + (size_t)bb * 6144 + 4096;
#pragma unroll
                for (int bj = 0; bj < 2; ++bj)
#pragma unroll
                    for (int n = 0; n < 2; ++n) {
                        const int c = col0 + bj * HALF + n * 16;
                        const f32x4 xv = *(const f32x4*)(xr + c), gv = *(const f32x4*)(gr + c);
                        *(f32x4*)(orow + c) = 1.4142135623730951f * xv + gv * acc[ai][bj][m][n];
                    } }
    }
};
struct OutOrder : StaticOrder {
    int ctx;
    __device__ bool next(int i, Unit& u) const {
        if (ctx) { if (i != 0) return false; u.pm = 64 + (c >> 3); u.pn = c & 7; return true; }
        return StaticOrder::next(i, u);
    }
};
}

DI void gemm_tile(const KP& p, int mode, int layer, int m0, int n0, char* smem) {
  constexpr int STG = 512 * 72;
  u16* base = (u16*)smem;
  float* rs = (float*)(base + 2 * STG);
  const int tid = otid(), lane = tid & 63, w = tid >> 6, wm = w >> 2, wn = w & 3, l31 = lane & 31, h = lane >> 5;
  const u16* A; const u16* Bt; const float* gv = nullptr; int lda, K, N;
  if (mode == 0) { A = p.H; lda = DM; K = DM; N = NIN; Bt = p.WinT; }
  else if (mode == 1) { A = p.P + 2048; lda = NIN; K = 512; N = 1536; Bt = p.WuqT; gv = p.q_g + layer * 512; }
  else if (mode == 2) { A = p.P + 2560; lda = NIN; K = 256; N = 2048; Bt = p.WukvT; gv = p.kv_g + layer * 256; }
  else { A = p.H; lda = DM; K = DM; N = DM; Bt = p.WoutT; }
  const bool xf = (mode == 1 || mode == 2);
  const bool active = (n0 + wn * 64) < N;
  __syncthreads();
  if (xf) {
    const int r = tid >> 1, part = tid & 1;
    const u16* src = A + (size_t)(m0 + r) * lda + part * (K >> 1);
    float ss = 0.f;
    for (int i = 0; i < (K >> 1); i += 8) {
      float f[8]; unpack8(ld8(src + i), f);
#pragma unroll
      for (int j = 0; j < 8; ++j) ss += f[j] * f[j];
    }
    ss += __shfl_xor(ss, 1);
    if (!part) rs[r] = rsqrtf(ss / (float)K + 1e-6f);
    __syncthreads();
  }
  f32x16 acc[4][2];
#pragma unroll
  for (int i = 0; i < 4; ++i)
#pragma unroll
    for (int j = 0; j < 2; ++j) acc[i][j] = zero16();
  bf16x8 ra[4], rb[4];
  const int arow = tid >> 3, ac = tid & 7;
  auto loadg = [&](int k0) {
#pragma unroll
    for (int i = 0; i < 4; ++i) ra[i] = ld8(A + (size_t)(m0 + arow + 64 * i) * lda + k0 + ac * 8);
#pragma unroll
    for (int i = 0; i < 4; ++i) {
      int nrow = n0 + arow + 64 * i;
      nrow = nrow < N ? nrow : N - 1;
      rb[i] = ld8(Bt + (size_t)nrow * K + k0 + ac * 8);
    }
  };
  auto stage = [&](int buf, int k0) {
    u16* As = base + buf * STG;
    u16* Bs = As + 256 * 72;
#pragma unroll
    for (int i = 0; i < 4; ++i) {
      bf16x8 v = ra[i];
      if (xf) {
        float f[8]; unpack8(v, f);
        const float sc = rs[arow + 64 * i];
        f32x4 g0 = *(const f32x4*)(gv + k0 + ac * 8), g1 = *(const f32x4*)(gv + k0 + ac * 8 + 4);
#pragma unroll
        for (int j = 0; j < 4; ++j) { f[j] *= sc * g0[j]; f[4 + j] *= sc * g1[j]; }
        v = pack8(f);
      }
      *(bf16x8*)(As + (arow + 64 * i) * 72 + ac * 8) = v;
    }
#pragma unroll
    for (int i = 0; i < 4; ++i) *(bf16x8*)(Bs + (arow + 64 * i) * 72 + ac * 8) = rb[i];
  };
  const int nk = K >> 6;
  loadg(0);
  stage(0, 0);
  if (nk > 1) loadg(64);
  __syncthreads();
  for (int kt = 0; kt < nk; ++kt) {
    if (kt + 1 < nk) stage((kt + 1) & 1, (kt + 1) * 64);
    if (kt + 2 < nk) loadg((kt + 2) * 64);
    const u16* As = base + (kt & 1) * STG;
    const u16* Bs = As + 256 * 72;
    if (active) {
#pragma unroll
      for (int ks = 0; ks < 4; ++ks) {
        bf16x8 bfr[2], afr[4];
#pragma unroll
        for (int ni = 0; ni < 2; ++ni) bfr[ni] = ld8(Bs + (wn * 64 + ni * 32 + l31) * 72 + ks * 16 + h * 8);
#pragma unroll
        for (int mi = 0; mi < 4; ++mi) afr[mi] = ld8(As + (wm * 128 + mi * 32 + l31) * 72 + ks * 16 + h * 8);
#pragma unroll
        for (int mi = 0; mi < 4; ++mi)
#pragma unroll
          for (int ni = 0; ni < 2; ++ni) acc[mi][ni] = MFMA(afr[mi], bfr[ni], acc[mi][ni]);
      }
    }
    __syncthreads();
  }
#pragma unroll
  for (int mi = 0; mi < 4; ++mi)
#pragma unroll
    for (int ni = 0; ni < 2; ++ni) {
      const int cb = n0 + wn * 64 + ni * 32;
      if (cb >= N) continue;
      const int col = cb + l31;
      const int rb0 = m0 + wm * 128 + mi * 32;
      const f32x16& a = acc[mi][ni];
      if (mode == 0) {
#pragma unroll
        for (int r = 0; r < 16; ++r) p.P[(size_t)(rb0 + crow(r, h)) * NIN + col] = f2bf(a[r]);
      } else if (mode == 1) {
        const int dd = cb % 192;
        const bool rope = (dd >= 128) && (rb0 < NLAT);
        const int part = (dd - 128) >> 5;
#pragma unroll
        for (int r = 0; r < 16; ++r) {
          const int row = rb0 + crow(r, h);
          float v = a[r] * QSCALE;
          if (rope) {
            const int t = row & 4095;
            const int pos = part ? (t & 63) : (t >> 6);
            float cs, sn; rope_cs(pos, l31 & 15, cs, sn);
            const float pr = __shfl_xor(v, 16);
            v = (l31 < 16) ? (v * cs - pr * sn) : (v * cs + pr * sn);
          }
          p.Q[(size_t)row * 1536 + col] = f2bf(v);
        }
      } else if (mode == 2) {
        const int head = col >> 8, dd = col & 255;
#pragma unroll
        for (int g = 0; g < 4; ++g) {
          const int row = rb0 + 8 * g + 4 * h;
          int b, pos;
          if (row < NLAT) { b = row >> 12; pos = 256 + (row & 4095); } else { b = (row - NLAT) >> 8; pos = (row - NLAT) & 255; }
          if (dd < 128) {
#pragma unroll
            for (int j = 0; j < 4; ++j) p.Kn[((size_t)(b * 8 + head) * LPOS + pos + j) * 128 + dd] = f2bf(a[4 * g + j]);
          } else {
            u32x2 o; o[0] = pk2(a[4 * g], a[4 * g + 1]); o[1] = pk2(a[4 * g + 2], a[4 * g + 3]);
            *(u32x2*)(p.Vt + ((size_t)(b * 8 + head) * 128 + (dd - 128)) * LPOS + pos) = o;
          }
        }
      } else {
#pragma unroll
        for (int r = 0; r < 16; ++r) {
          const int row = rb0 + crow(r, h);
          const int bb = row < NLAT ? (row >> 12) : 4;
          const float gate = p.mod[((size_t)layer * 5 + bb) * 6144 + 4096 + col];
          float xv;
          float* dst;
          if (row < NLAT) {
            dst = p.out + (size_t)row * DM + col;
            xv = layer == 0 ? p.x[(size_t)row * DM + col] : *dst;
          } else {
            dst = p.X1c + (size_t)(row - NLAT) * DM + col;
            xv = p.ctx[(size_t)(row - NLAT) * DM + col];
          }
          *dst = ALPHA * xv + gate * a[r];
        }
      }
    }
}

DI void krope_item(const KP& p, int it) {
  const int tid = otid(), tok = tid >> 6, dim = tid & 63;
  const int row = it * 8 + tok;
  const u16* src = p.P + (size_t)row * NIN + 2816;
  float v = bf2f(src[dim]);
  int b, pos;
  if (row < NLAT) {
    const float pr = bf2f(src[dim ^ 16]);
    const int t = row & 4095, part = dim >> 5;
    const int ps = part ? (t & 63) : (t >> 6);
    float cs, sn; rope_cs(ps, dim & 15, cs, sn);
    v = ((dim & 31) < 16) ? (v * cs - pr * sn) : (v * cs + pr * sn);
    b = row >> 12; pos = 256 + t;
  } else { b = (row - NLAT) >> 8; pos = (row - NLAT) & 255; }
  p.Kr[((size_t)b * LPOS + pos) * 64 + dim] = f2bf(v);
}

DI void attn_item(const KP& p, int qrow0, int b, int hd, int nkeys, char* smem) {
  constexpr int STG = 64 * 200 + 128 * 72;
  u16* base = (u16*)smem;
  const int tid = otid(), lane = tid & 63, w = tid >> 6, l31 = lane & 31, h = lane >> 5;
  const int qrow = qrow0 + 32 * w + l31;
  bf16x8 qf[12];
  {
    const u16* qp = p.Q + (size_t)qrow * 1536 + hd * 192 + 8 * h;
#pragma unroll
    for (int ks = 0; ks < 12; ++ks) qf[ks] = ld8(qp + 16 * ks);
  }
  f32x16 o[4];
#pragma unroll
  for (int i = 0; i < 4; ++i) o[i] = zero16();
  float m = -1e30f, lsum = 0.f;
  const u16* kn = p.Kn + (size_t)(b * 8 + hd) * LPOS * 128;
  const u16* kr = p.Kr + (size_t)b * LPOS * 64;
  const u16* vt = p.Vt + (size_t)(b * 8 + hd) * 128 * LPOS;
  int koff[3], kdst[3], voff[2], vdst[2];
#pragma unroll
  for (int i = 0; i < 2; ++i) { const int idx = tid + NTHR * i, key = idx >> 4, c = idx & 15; koff[i] = key * 128 + c * 8; kdst[i] = key * 200 + c * 8; }
  { const int key = tid >> 3, c = tid & 7; koff[2] = key * 64 + c * 8; kdst[2] = key * 200 + 128 + c * 8; }
#pragma unroll
  for (int i = 0; i < 2; ++i) { const int idx = tid + NTHR * i, dd = idx >> 3, c = idx & 7; voff[i] = dd * LPOS + c * 8; vdst[i] = dd * 72 + 16 * (c >> 1) + 4 * (c & 1); }
  bf16x8 rk[3], rv[2];
  auto loadg = [&](int kt0) {
    const u16* knt = kn + (size_t)kt0 * 128;
    const u16* krt = kr + (size_t)kt0 * 64;
    const u16* vtt = vt + kt0;
    rk[0] = ld8(knt + koff[0]); rk[1] = ld8(knt + koff[1]); rk[2] = ld8(krt + koff[2]);
    rv[0] = ld8(vtt + voff[0]); rv[1] = ld8(vtt + voff[1]);
  };
  auto stage = [&](int buf) {
    u16* Ksm = base + buf * STG;
    u16* Vsm = Ksm + 64 * 200;
#pragma unroll
    for (int i = 0; i < 3; ++i) *(bf16x8*)(Ksm + kdst[i]) = rk[i];
#pragma unroll
    for (int i = 0; i < 2; ++i) {
      u32x4 u = __builtin_bit_cast(u32x4, rv[i]);
      u32x2 lo = {u[0], u[1]}, hi = {u[2], u[3]};
      u16* dst = Vsm + vdst[i];
      *(u32x2*)dst = lo;
      *(u32x2*)(dst + 8) = hi;
    }
  };
  __syncthreads();
  if (__builtin_amdgcn_readfirstlane(w) >= 4) __builtin_amdgcn_s_setprio(1);
  const int ntile = nkeys >> 6;
  loadg(0);
  stage(0);
  if (ntile > 1) loadg(64);
  __syncthreads();
  for (int t = 0; t < ntile; ++t) {
    const u16* Ksm = base + (t & 1) * STG;
    const u16* Vsm = Ksm + 64 * 200;
    if (t + 1 < ntile) stage((t + 1) & 1);
    if (t + 2 < ntile) loadg((t + 2) * 64);
    f32x16 s[2];
#pragma unroll
    for (int kt = 0; kt < 2; ++kt) {
      s[kt] = zero16();
#pragma unroll
      for (int ks = 0; ks < 12; ++ks) {
        bf16x8 a = ld8(Ksm + (kt * 32 + l31) * 200 + ks * 16 + h * 8);
        s[kt] = MFMA(a, qf[ks], s[kt]);
        if ((ks & 3) == 3) asm volatile("" ::: "memory");
      }
    }
    float mx = s[0][0];
#pragma unroll
    for (int r = 0; r < 16; ++r) { mx = fmaxf(mx, s[0][r]); mx = fmaxf(mx, s[1][r]); }
    {
      const auto sw = __builtin_amdgcn_permlane32_swap(__float_as_uint(mx), __float_as_uint(mx), false, false);
      mx = fmaxf(__uint_as_float(sw[0]), __uint_as_float(sw[1]));
    }
    if (__builtin_amdgcn_ballot_w64(mx > m + 8.f) != 0ull) {
      const float mnew = fmaxf(m, mx);
      const float alpha = __builtin_amdgcn_exp2f(m - mnew);
      m = mnew;
      lsum *= alpha;
#pragma unroll
      for (int dt = 0; dt < 4; ++dt)
#pragma unroll
        for (int r = 0; r < 16; ++r) o[dt][r] *= alpha;
    }
    float ps0 = 0.f, ps1 = 0.f;
#pragma unroll
    for (int r = 0; r < 16; ++r) {
      const float e0 = __builtin_amdgcn_exp2f(s[0][r] - m), e1 = __builtin_amdgcn_exp2f(s[1][r] - m);
      s[0][r] = e0; s[1][r] = e1;
      ps0 += e0; ps1 += e1;
    }
    lsum += ps0 + ps1;
#pragma unroll
    for (int kt = 0; kt < 2; ++kt)
#pragma unroll
      for (int sI = 0; sI < 2; ++sI) {
        u32x4 pu;
#pragma unroll
        for (int j = 0; j < 4; ++j) pu[j] = pk2(s[kt][8 * sI + 2 * j], s[kt][8 * sI + 2 * j + 1]);
        const bf16x8 pb = __builtin_bit_cast(bf16x8, pu);
        const int kb = kt * 32 + sI * 16 + 8 * h;
#pragma unroll
        for (int dt = 0; dt < 4; ++dt) o[dt] = MFMA(ld8(Vsm + (dt * 32 + l31) * 72 + kb), pb, o[dt]);
        asm volatile("" ::: "memory");
      }
    __syncthreads();
  }
  __builtin_amdgcn_s_setprio(0);
  lsum += __shfl_xor(lsum, 32);
  const float inv = 1.f / lsum;
  const u16* gp = p.P + (size_t)qrow * NIN + 2880 + hd * 128;
  u16* op = p.H + (size_t)qrow * DM + 512 + hd * 128;
#pragma unroll
  for (int dt = 0; dt < 4; ++dt)
#pragma unroll
    for (int g = 0; g < 4; ++g) {
      const int d0 = dt * 32 + 8 * g + 4 * h;
      u32x2 gg = *(const u32x2*)(gp + d0);
      float g0 = bflo(gg[0]), g1 = bfhi(gg[0]), g2 = bflo(gg[1]), g3 = bfhi(gg[1]);
      u32x2 ov;
      ov[0] = pk2(o[dt][4 * g] * inv * silu(g0), o[dt][4 * g + 1] * inv * silu(g1));
      ov[1] = pk2(o[dt][4 * g + 2] * inv * silu(g2), o[dt][4 * g + 3] * inv * silu(g3));
      *(u32x2*)(op + d0) = ov;
    }
}

DI void ret_chain(const KP& p, int layer, int chain, char* smem) {
  const int d = chain >> 4, b = (chain >> 2) & 3, hd = chain & 3;
  u16* Qs = (u16*)smem;
  u16* Ks = Qs + 128 * 136;
  u16* Vs = Ks + 128 * 136;
  u16* Sts = Vs + 128 * 136;
  const int tid = otid(), lane = tid & 63, w = tid >> 6, l31 = lane & 31, h = lane >> 5;
  const int q4 = (lane & 15) >> 2, p4 = lane & 3, blk = (lane >> 4) & 1;
  const float logit = p.ret_logit[(layer * 2 + d) * 4 + hd];
  const float z = -logit;
  const float logg = -(fmaxf(z, 0.f) + log1pf(expf(-fabsf(z))));
  const float lg2 = logg * 1.4426950408889634f;
  const float gC = exp2f(128.f * lg2);
  const float kscale = 0.08838834764831845f;
  const int iw = w & 3, half = w >> 2;
  const int kt = w & 3, vh = w >> 2;
  f32x16 st[2];
  st[0] = zero16(); st[1] = zero16();
  __syncthreads();
  for (int i = tid; i < 128 * 136 / 8; i += NTHR) *(bf16x8*)(Sts + i * 8) = zero8();
  bf16x8 rq[4], rk[4], rv[4];
  const int trow = tid >> 4, tc = tid & 15;
  auto rowbase = [&](int n) -> size_t {
    if (d == 0) return n < 2 ? (size_t)(NLAT + b * 256 + 128 * n) : (size_t)(b * 4096 + 128 * (n - 2));
    return n < 2 ? (size_t)(NLAT + b * 256 + 128 * (1 - n)) : (size_t)(b * 4096 + 128 * (33 - n));
  };
  auto loadg = [&](int n) {
    const size_t rb = rowbase(n);
#pragma unroll
    for (int i = 0; i < 4; ++i) {
      const u16* src = p.P + (rb + trow + 32 * i) * NIN + hd * 128 + tc * 8;
      rq[i] = ld8(src); rk[i] = ld8(src + 512); rv[i] = ld8(src + 1024);
    }
  };
  loadg(0);
  for (int n = 0; n < 34; ++n) {
    const size_t rb = rowbase(n);
#pragma unroll
    for (int i = 0; i < 4; ++i) {
      const int j = trow + 32 * i;
      *(bf16x8*)(Qs + j * 136 + tc * 8) = rq[i];
      *(bf16x8*)(Ks + j * 136 + tc * 8) = rk[i];
      const float zeta = exp2f((d == 0 ? (float)(127 - j) : (float)j) * lg2) * kscale;
      float f[8]; unpack8(rv[i], f);
#pragma unroll
      for (int jj = 0; jj < 8; ++jj) f[jj] *= zeta;
      *(bf16x8*)(Vs + j * 136 + tc * 8) = pack8(f);
    }
    __syncthreads();
    if (n + 1 < 34) loadg(n + 1);
    f32x16 acc[2];
    acc[0] = zero16(); acc[1] = zero16();
    bf16x8 qf[8];
#pragma unroll
    for (int ks = 0; ks < 8; ++ks) qf[ks] = ld8(Qs + (32 * iw + l31) * 136 + 16 * ks + 8 * h);
#pragma unroll
    for (int et = 0; et < 2; ++et)
#pragma unroll
      for (int ks = 0; ks < 8; ++ks) {
        bf16x8 a = ld8(Sts + (32 * (2 * half + et) + l31) * 136 + 16 * ks + 8 * h);
        acc[et] = MFMA(a, qf[ks], acc[et]);
      }
#pragma unroll
    for (int et = 0; et < 2; ++et)
#pragma unroll
      for (int r = 0; r < 16; ++r) acc[et][r] *= gC;
    const int ii = 32 * iw + l31;
#pragma unroll
    for (int jt = 0; jt < 4; ++jt) {
      f32x16 sT = zero16();
#pragma unroll
      for (int ks = 0; ks < 8; ++ks) {
        bf16x8 a = ld8(Ks + (32 * jt + l31) * 136 + 16 * ks + 8 * h);
        sT = MFMA(a, qf[ks], sT);
      }
#pragma unroll
      for (int r = 0; r < 16; ++r) {
        const int j = 32 * jt + crow(r, h);
        const bool keep = d == 0 ? (ii >= j) : (j >= ii);
        sT[r] = keep ? sT[r] : 0.f;
      }
#pragma unroll
      for (int sI = 0; sI < 2; ++sI) {
        u32x4 pu;
#pragma unroll
        for (int j = 0; j < 4; ++j) pu[j] = pk2(sT[8 * sI + 2 * j], sT[8 * sI + 2 * j + 1]);
        const bf16x8 pb = __builtin_bit_cast(bf16x8, pu);
        const int j0 = 32 * jt + 16 * sI + 4 * h;
#pragma unroll
        for (int et = 0; et < 2; ++et) {
          const u16* vp = Vs + (j0 + q4) * 136 + 32 * (2 * half + et) + 16 * blk + 4 * p4;
          s16x4 lo = trread(vp), hi = trread(vp + 8 * 136);
          acc[et] = MFMA(cat4(lo, hi), pb, acc[et]);
        }
      }
    }
    {
      const float rho = exp2f((d == 0 ? (float)(ii - 127) : (float)(-ii)) * lg2);
      u16* yp = p.Yret + ((size_t)d * NTOK + rb + ii) * 512 + hd * 128;
#pragma unroll
      for (int et = 0; et < 2; ++et)
#pragma unroll
        for (int g = 0; g < 4; ++g) {
          const int e0 = 32 * (2 * half + et) + 8 * g + 4 * h;
          u32x2 ov;
          ov[0] = pk2(acc[et][4 * g] * rho, acc[et][4 * g + 1] * rho);
          ov[1] = pk2(acc[et][4 * g + 2] * rho, acc[et][4 * g + 3] * rho);
          *(u32x2*)(yp + e0) = ov;
        }
    }
#pragma unroll
    for (int vi = 0; vi < 2; ++vi)
#pragma unroll
      for (int r = 0; r < 16; ++r) st[vi][r] *= gC;
#pragma unroll
    for (int ks = 0; ks < 8; ++ks) {
      const int jb = 16 * ks + 4 * h + q4;
      const u16* kp = Ks + jb * 136 + 32 * kt + 16 * blk + 4 * p4;
      const bf16x8 a = cat4(trread(kp), trread(kp + 8 * 136));
#pragma unroll
      for (int vi = 0; vi < 2; ++vi) {
        const u16* vp = Vs + jb * 136 + 32 * (2 * vh + vi) + 16 * blk + 4 * p4;
        const bf16x8 bfr = cat4(trread(vp), trread(vp + 8 * 136));
        st[vi] = MFMA(a, bfr, st[vi]);
      }
    }
    __syncthreads();
#pragma unroll
    for (int vi = 0; vi < 2; ++vi)
#pragma unroll
      for (int g = 0; g < 4; ++g) {
        const int v = 32 * (2 * vh + vi) + l31, k0 = 32 * kt + 8 * g + 4 * h;
        u32x2 ov;
        ov[0] = pk2(st[vi][4 * g], st[vi][4 * g + 1]);
        ov[1] = pk2(st[vi][4 * g + 2], st[vi][4 * g + 3]);
        *(u32x2*)(Sts + v * 136 + k0) = ov;
      }
  }
}

DI void rwkv_chain(const KP& p, int layer, int item, char* smem) {
  const int chain = item >> 1, vhalf = item & 1;
  const int d = chain >> 5, b = (chain >> 3) & 3, hd = chain & 7;
  float* buf = (float*)smem;
  u16* twS = (u16*)(smem + 98304);
  u16* alS = twS + 32 * 72;
  const int tid = otid(), lane = tid & 63, w = tid >> 6, l31 = lane & 31, h = lane >> 5;
  auto geom = [&](int cc, int& o0, int& len, size_t& rbase) {
    const int j0 = 32 * cc;
    const bool isctx = j0 < 256;
    len = isctx ? 256 : 4096;
    if (d == 0) o0 = isctx ? j0 : j0 - 256; else o0 = isctx ? (224 - j0) : (4064 - (j0 - 256));
    rbase = isctx ? (size_t)(NLAT + b * 256) : (size_t)(b * 4096);
  };
  __syncthreads();
  if (w >= 4) {
    const int pt = tid - 256;
    const int pw = w - 4, mat = pw >> 1, nh = pw & 1;
    const int matu = __builtin_amdgcn_readfirstlane(mat);
    bf16x8 bw[4];
    const int n = hd * 64 + nh * 32 + l31;
    {
      const u16* wT = (mat ? p.A2T : p.W2T) + ((size_t)d * 512 + n) * 64 + 8 * h;
#pragma unroll
      for (int ks = 0; ks < 4; ++ks) bw[ks] = ld8(wT + 16 * ks);
    }
    const float c0 = (mat ? p.a0 : p.w0)[((size_t)layer * 2 + d) * 512 + n];
    const int tok = pt >> 3, c8 = pt & 7;
    int colg[5];
    colg[0] = 3904 + hd * 64 + c8 * 8; colg[1] = 4416 + hd * 64 + c8 * 8; colg[2] = 4928 + hd * 64 + c8 * 8;
    colg[3] = 5440 + d * 64 + c8 * 8; colg[4] = 5568 + d * 64 + c8 * 8;
    const float* mu0 = p.mu + (size_t)layer * 2 * 1792;
    const float* mu1 = mu0 + 1792;
    float m0[5][8], m1[5][8], kkc[8], kac[8];
#pragma unroll
    for (int g = 0; g < 5; ++g)
#pragma unroll
      for (int j = 0; j < 8; ++j) { m0[g][j] = mu0[colg[g] - 3904 + j]; m1[g][j] = mu1[colg[g] - 3904 + j]; }
#pragma unroll
    for (int j = 0; j < 8; ++j) { kkc[j] = p.k_k[layer * 512 + hd * 64 + c8 * 8 + j]; kac[j] = p.k_a[layer * 512 + hd * 64 + c8 * 8 + j]; }
    bf16x8 raw[5][3];
    const u16* pcol[5];
#pragma unroll
    for (int g = 0; g < 5; ++g) pcol[g] = p.P + colg[g] + (size_t)tok * NIN;
    auto loadraw = [&](int cc) {
      int o0, len; size_t rbase; geom(cc, o0, len, rbase);
      const size_t roff = (rbase + o0) * NIN;
      if (o0 > 0 && o0 + 32 < len) {
#pragma unroll
        for (int g = 0; g < 5; ++g) {
          const u16* src = pcol[g] + roff;
          raw[g][1] = ld8(src); raw[g][0] = ld8(src - NIN); raw[g][2] = ld8(src + NIN);
        }
      } else {
        const int o = o0 + tok;
#pragma unroll
        for (int g = 0; g < 5; ++g) {
          const u16* src = pcol[g] + roff;
          raw[g][1] = ld8(src);
          raw[g][0] = o > 0 ? ld8(src - NIN) : zero8();
          raw[g][2] = o < len - 1 ? ld8(src + NIN) : zero8();
        }
      }
    };
    loadraw(0);
    for (int cn = 0; cn < 137; ++cn) {
      float* bbase = buf + (cn & 1) * 32 * 384;
      float* bb = bbase + tok * 384;
      if (cn < 136) {
#pragma unroll
        for (int g = 0; g < 5; ++g) {
          float cur[8], prv[8], nxt[8], sh[8];
          unpack8(raw[g][1], cur); unpack8(raw[g][0], prv); unpack8(raw[g][2], nxt);
#pragma unroll
          for (int j = 0; j < 8; ++j) sh[j] = cur[j] + m0[g][j] * (prv[j] - cur[j]) + m1[g][j] * (nxt[j] - cur[j]);
          if (g < 3) {
            float* dst = bb + (g == 0 ? 0 : g == 1 ? 128 : 320) + c8 * 8;
            *(f32x4*)dst = f32x4{sh[0], sh[1], sh[2], sh[3]};
            *(f32x4*)(dst + 4) = f32x4{sh[4], sh[5], sh[6], sh[7]};
          } else if (g == 3) {
#pragma unroll
            for (int j = 0; j < 8; ++j) sh[j] = 1.f - 2.f * __builtin_amdgcn_rcpf(1.f + __expf(2.f * sh[j]));
            *(bf16x8*)(twS + tok * 72 + c8 * 8) = pack8(sh);
          } else {
            *(bf16x8*)(alS + tok * 72 + c8 * 8) = pack8(sh);
          }
        }
      }
      lds_barrier();
      if (cn + 1 < 136) loadraw(cn + 1);
      if (cn < 136) {
        const u16* X = mat ? alS : twS;
        f32x16 acc = zero16();
#pragma unroll
        for (int ks = 0; ks < 4; ++ks) acc = MFMA(ld8(X + l31 * 72 + ks * 16 + h * 8), bw[ks], acc);
        const int ch = nh * 32 + l31;
        float* dstb = bbase + (matu == 0 ? 64 : 256) + ch + 4 * h * 384;
#pragma unroll
        for (int r = 0; r < 16; ++r) {
          float sg = __builtin_amdgcn_rcpf(1.f + __expf(-(c0 + acc[r])));
          if (matu == 0) sg = __expf(-0.6065306597126334f * sg);
          dstb[((r & 3) + 8 * (r >> 2)) * 384] = sg;
        }
      }
      lds_barrier();
      if (cn < 136) {
        float kk[8], kr[8], ar[8];
        float ss = 0.f;
        {
          f32x4 k0 = *(const f32x4*)(bb + 128 + c8 * 8), k1 = *(const f32x4*)(bb + 132 + c8 * 8);
          f32x4 a0 = *(const f32x4*)(bb + 256 + c8 * 8), a1 = *(const f32x4*)(bb + 260 + c8 * 8);
#pragma unroll
          for (int j = 0; j < 4; ++j) { kr[j] = k0[j]; kr[4 + j] = k1[j]; ar[j] = a0[j]; ar[4 + j] = a1[j]; }
        }
#pragma unroll
        for (int j = 0; j < 8; ++j) { kk[j] = kr[j] * kkc[j]; ss += kk[j] * kk[j]; }
        ss = sum8(ss);
        const float inv = fminf(__builtin_amdgcn_rsqf(ss), 1e12f);
        float oa[8], ob[8], ok[8];
#pragma unroll
        for (int j = 0; j < 8; ++j) {
          const float kkn = kk[j] * inv;
          oa[j] = -kkn; ob[j] = kkn * ar[j]; ok[j] = kr[j] * (1.f + (ar[j] - 1.f) * kac[j]);
        }
        *(f32x4*)(bb + 192 + c8 * 8) = f32x4{oa[0], oa[1], oa[2], oa[3]}; *(f32x4*)(bb + 196 + c8 * 8) = f32x4{oa[4], oa[5], oa[6], oa[7]};
        *(f32x4*)(bb + 256 + c8 * 8) = f32x4{ob[0], ob[1], ob[2], ob[3]}; *(f32x4*)(bb + 260 + c8 * 8) = f32x4{ob[4], ob[5], ob[6], ob[7]};
        *(f32x4*)(bb + 128 + c8 * 8) = f32x4{ok[0], ok[1], ok[2], ok[3]}; *(f32x4*)(bb + 132 + c8 * 8) = f32x4{ok[4], ok[5], ok[6], ok[7]};
      }
      lds_barrier();
    }
  } else {
    const int kq = lane & 15, vrow = 32 * vhalf + 8 * w + 2 * (lane >> 4);
    f32x2 S0[2], S1[2];
#pragma unroll
    for (int i = 0; i < 2; ++i) { S0[i] = f32x2{0.f, 0.f}; S1[i] = f32x2{0.f, 0.f}; }
    float py0 = 0.f, py1 = 0.f;
    const bool hi8 = (lane & 8) != 0;
    u16* pptr;
    {
      int o0, len; size_t rbase; geom(0, o0, len, rbase);
      pptr = p.Yrw + ((size_t)d * NTOK + rbase + o0) * 512 + hd * 64 + vrow + (hi8 ? 1 : 0) + (size_t)(d ? 31 : 0) * 512;
    }
    for (int c = -1; c < 136; ++c) {
      int o0 = 0, len; size_t rbase = 0;
      if (c >= 0) geom(c, o0, len, rbase);
      const float* bbase = buf + (c & 1) * 32 * 384;
      u16* yp = p.Yrw + ((size_t)d * NTOK + rbase + o0) * 512 + hd * 64 + vrow + (hi8 ? 1 : 0);
      f32x4 R0[5], R1[5], R2[5], R3[5];
      f32x2 v0, v1, v2, v3;
      auto ldstep = [&](int s, f32x4 (&R)[5], f32x2& vv) {
        s = s < 32 ? s : 31;
        const int i = d ? 31 - s : s;
        const float* t = bbase + i * 384 + 4 * kq;
#pragma unroll
        for (int q = 0; q < 5; ++q) R[q] = *(const f32x4*)(t + 64 * q);
        vv = *(const f32x2*)(bbase + i * 384 + 320 + vrow);
      };
      auto step = [&](const f32x4 (&R)[5], f32x2 vv, int s) {
        const int i = d ? 31 - s : s;
#define PAIR(q, j) (f32x2{R[q][2 * (j)], R[q][2 * (j) + 1]})
        f32x2 pa = S0[0] * PAIR(3, 0), pb = S1[0] * PAIR(3, 0);
        pa = S0[1] * PAIR(3, 1) + pa; pb = S1[1] * PAIR(3, 1) + pb;
        float sa0 = pa[0] + pa[1], sa1 = pb[0] + pb[1];
        float q = hi8 ? py1 : py0;
        const float qs = hi8 ? py0 : py1;
        q += dppf<0x140>(qs);
        sa0 += dppf<0xB1>(sa0); sa1 += dppf<0xB1>(sa1); q += dppf<0xB1>(q);
        sa0 += dppf<0x4E>(sa0); sa1 += dppf<0x4E>(sa1); q += dppf<0x4E>(q);
        sa0 += dppf<0x141>(sa0); sa1 += dppf<0x141>(sa1); q += dppf<0x141>(q);
        sa0 += dppf<0x140>(sa0); sa1 += dppf<0x140>(sa1);
        *pptr = f2bf(q);
        const f32x2 sA = {sa0, sa0}, sB = {sa1, sa1}, vA = {vv[0], vv[0]}, vB = {vv[1], vv[1]};
        f32x2 ya = {0.f, 0.f}, yb = {0.f, 0.f};
#pragma unroll
        for (int j = 0; j < 2; ++j) {
          const f32x2 wj = PAIR(1, j), kj = PAIR(2, j), bj = PAIR(4, j), rj = PAIR(0, j);
          S0[j] = S0[j] * wj + (sA * bj + vA * kj);
          S1[j] = S1[j] * wj + (sB * bj + vB * kj);
          ya = S0[j] * rj + ya; yb = S1[j] * rj + yb;
        }
#undef PAIR
        py0 = ya[0] + ya[1]; py1 = yb[0] + yb[1];
        pptr = yp + (size_t)i * 512;
      };
      if (c >= 0) { ldstep(0, R0, v0); ldstep(1, R1, v1); }
#pragma unroll 1
      for (int part = 0; part < 3; ++part) {
        if (c >= 0) {
          const int s0 = part * 12, s1 = part == 2 ? 32 : s0 + 12;
          for (int s = s0; s < s1; s += 4) {
            ldstep(s + 2, R2, v2); step(R0, v0, s);
            ldstep(s + 3, R3, v3); step(R1, v1, s + 1);
            ldstep(s + 4, R0, v0); step(R2, v2, s + 2);
            ldstep(s + 5, R1, v1); step(R3, v3, s + 3);
          }
        }
        lds_barrier();
      }
    }
    { const float y0 = sum16(py0), y1 = sum16(py1); *pptr = f2bf(hi8 ? y1 : y0); }
  }
}

DI void merge_phase(const KP& p, int layer, int M) {
  const int lane = otid() & 63, w = otid() >> 6;
  const float* mu0 = p.mu + (size_t)layer * 2 * 1792;
  const float* mu1 = mu0 + 1792;
  for (int row = obid() * 8 + w; row < M; row += gridDim.x * 8) {
    const int ch0 = lane * 8;
    {
      float y0[8], y1[8], y[8];
      unpack8(ld8(p.Yret + (size_t)row * 512 + ch0), y0);
      unpack8(ld8(p.Yret + ((size_t)NTOK + row) * 512 + ch0), y1);
      float s = 0.f;
#pragma unroll
      for (int j = 0; j < 8; ++j) { y[j] = y0[j] + y1[j]; s += y[j]; }
      s += __shfl_xor(s, 1); s += __shfl_xor(s, 2); s += __shfl_xor(s, 4); s += __shfl_xor(s, 8);
      const float mean = s * (1.f / 128.f);
      float v = 0.f;
#pragma unroll
      for (int j = 0; j < 8; ++j) { const float dlt = y[j] - mean; v += dlt * dlt; }
      v += __shfl_xor(v, 1); v += __shfl_xor(v, 2); v += __shfl_xor(v, 4); v += __shfl_xor(v, 8);
      const float rstd = rsqrtf(v * (1.f / 128.f) + 1e-5f);
      float gt[8], o[8];
      unpack8(ld8(p.P + (size_t)row * NIN + 1536 + ch0), gt);
#pragma unroll
      for (int j = 0; j < 8; ++j) o[j] = (y[j] - mean) * rstd * p.ret_gn[layer * 512 + ch0 + j] * silu(gt[j]);
      *(bf16x8*)(p.H + (size_t)row * DM + ch0) = pack8(o);
    }
    {
      float y0[8], y1[8], y[8];
      unpack8(ld8(p.Yrw + (size_t)row * 512 + ch0), y0);
      unpack8(ld8(p.Yrw + ((size_t)NTOK + row) * 512 + ch0), y1);
      float s = 0.f;
#pragma unroll
      for (int j = 0; j < 8; ++j) { y[j] = y0[j] + y1[j]; s += y[j]; }
      s += __shfl_xor(s, 1); s += __shfl_xor(s, 2); s += __shfl_xor(s, 4);
      const float mean = s * (1.f / 64.f);
      float v = 0.f;
#pragma unroll
      for (int j = 0; j < 8; ++j) { const float dlt = y[j] - mean; v += dlt * dlt; }
      v += __shfl_xor(v, 1); v += __shfl_xor(v, 2); v += __shfl_xor(v, 4);
      const float rstd = rsqrtf(v * (1.f / 64.f) + 64e-5f);
      int o, len;
      if (row < NLAT) { o = row & 4095; len = 4096; } else { o = (row - NLAT) & 255; len = 256; }
      float f[3][8];
#pragma unroll
      for (int g = 0; g < 3; ++g) {
        const int col = 3904 + 512 * g + ch0;
        const u16* src = p.P + (size_t)row * NIN + col;
        float cur[8], prv[8], nxt[8];
        unpack8(ld8(src), cur);
        if (o > 0) unpack8(ld8(src - NIN), prv); else { for (int j = 0; j < 8; ++j) prv[j] = 0.f; }
        if (o < len - 1) unpack8(ld8(src + NIN), nxt); else { for (int j = 0; j < 8; ++j) nxt[j] = 0.f; }
#pragma unroll
        for (int j = 0; j < 8; ++j) {
          const float m0v = mu0[col - 3904 + j], m1v = mu1[col - 3904 + j];
          f[g][j] = cur[j] + m0v * (prv[j] - cur[j]) + m1v * (nxt[j] - cur[j]);
        }
      }
      float rk = 0.f;
#pragma unroll
      for (int j = 0; j < 8; ++j) rk += f[0][j] * f[1][j] * p.r_k[layer * 512 + ch0 + j];
      rk += __shfl_xor(rk, 1); rk += __shfl_xor(rk, 2); rk += __shfl_xor(rk, 4);
      float gt[8], ov[8];
      unpack8(ld8(p.P + (size_t)row * NIN + 5696 + ch0), gt);
#pragma unroll
      for (int j = 0; j < 8; ++j)
        ov[j] = ((y[j] - mean) * rstd * p.rw_gn[layer * 512 + ch0 + j] + rk * f[2][j]) * silu(gt[j]);
      *(bf16x8*)(p.H + (size_t)row * DM + 1536 + ch0) = pack8(ov);
    }
  }
}

DI void ln_phase(const KP& p, int layer, int r0, int M, int b0 = 0) {
  const int lane = otid() & 63, w = otid() >> 6;
  const float* g = p.ln_g + layer * DM;
  const float* bb_ = p.ln_b + layer * DM;
  if (obid() < b0) return;
  for (int row = r0 + (obid() - b0) * 8 + w; row < M; row += ((int)gridDim.x - b0) * 8) {
    float* ptr = row < NLAT ? p.out + (size_t)row * DM : p.X1c + (size_t)(row - NLAT) * DM;
    f32x4 v[8];
    float s = 0.f;
#pragma unroll
    for (int i = 0; i < 8; ++i) { v[i] = *(const f32x4*)(ptr + (i * 64 + lane) * 4); s += v[i][0] + v[i][1] + v[i][2] + v[i][3]; }
#pragma unroll
    for (int o = 1; o < 64; o <<= 1) s += __shfl_xor(s, o);
    const float mean = s * (1.f / 2048.f);
    float q = 0.f;
#pragma unroll
    for (int i = 0; i < 8; ++i)
#pragma unroll
      for (int j = 0; j < 4; ++j) { const float dlt = v[i][j] - mean; q += dlt * dlt; }
#pragma unroll
    for (int o = 1; o < 64; o <<= 1) q += __shfl_xor(q, o);
    const float rstd = rsqrtf(q * (1.f / 2048.f) + 1e-5f);
    const int bidx = row < NLAT ? (row >> 12) : 4;
    const float* md = p.mod + ((size_t)5 + bidx) * 6144;
#pragma unroll
    for (int i = 0; i < 8; ++i) {
      const int c = (i * 64 + lane) * 4;
      f32x4 gg = *(const f32x4*)(g + c), bbv = *(const f32x4*)(bb_ + c), y;
#pragma unroll
      for (int j = 0; j < 4; ++j) y[j] = (v[i][j] - mean) * rstd * gg[j] + bbv[j];
      *(f32x4*)(ptr + c) = y;
      if (layer == 0) {
        f32x4 sh = *(const f32x4*)(md + c), scl = *(const f32x4*)(md + 2048 + c);
        u32x2 o;
        o[0] = pk2(y[0] * (1.f + scl[0]) + sh[0], y[1] * (1.f + scl[1]) + sh[1]);
        o[1] = pk2(y[2] * (1.f + scl[2]) + sh[2], y[3] * (1.f + scl[3]) + sh[3]);
        *(u32x2*)(p.H + (size_t)row * DM + c) = o;
      }
    }
  }
}

#define XB_TMO      128
#define XB_XCNT(j)  (256  + 64 * (j))
#define XB_XSUB(j)  (1280 + 64 * (j))
#define XB_XGEN(j)  (2304 + 64 * (j))
#define XB_TOP      3328
#define XB_TOPGEN   3392
#define XCD_BAR_WORDS 3456
#define XB_SPIN_CAP (1u << 18)
#define LAS __attribute__((address_space(3)))

__device__ __forceinline__ unsigned xb_ld(unsigned* p)              { return __hip_atomic_load(p, __ATOMIC_RELAXED, __HIP_MEMORY_SCOPE_AGENT); }
__device__ __forceinline__ unsigned xb_add(unsigned* p, unsigned v) { return __hip_atomic_fetch_add(p, v, __ATOMIC_RELAXED, __HIP_MEMORY_SCOPE_AGENT); }
__device__ __forceinline__ unsigned xb_xcc_id() { return (unsigned)__builtin_amdgcn_s_getreg((3 << 11) | 20) & 0xFu; }
#define XB_SPIN(cond, bar) do { unsigned _sp = 0; while (cond) { __builtin_amdgcn_s_sleep(1); \
    if ((++_sp & 255u) == 0u) { if (xb_ld(&(bar)[XB_TMO])) break; if (_sp > XB_SPIN_CAP) { atomicAdd(&(bar)[XB_TMO], 1u); break; } } } } while (0)

struct XcdBarrier {
    unsigned* bar; unsigned x;
    volatile LAS unsigned* st;
};

__device__ __forceinline__ XcdBarrier xcd_barrier_post(unsigned* bar, volatile LAS unsigned* st) {
    XcdBarrier b; b.bar = bar; b.x = xb_xcc_id(); b.st = st;
    if (threadIdx.x == 0) (void)xb_add(&bar[XB_XCNT(b.x)], 1u);
    return b;
}
__device__ __forceinline__ void xcd_barrier_complete(unsigned* bar, unsigned x, unsigned& nloc, unsigned& nx) {
    const unsigned G = gridDim.x * gridDim.y * gridDim.z;
    unsigned sum, cnt, mine, sp = 0u;
    for (;;) {
        sum = 0u; cnt = 0u; mine = 0u;
#pragma unroll
        for (unsigned j = 0; j < 16; ++j) { const unsigned c = xb_ld(&bar[XB_XCNT(j)]); sum += c; cnt += (c > 0u) ? 1u : 0u; mine = (j == x) ? c : mine; }
        if (sum == G) break;
        __builtin_amdgcn_s_sleep(1);
        if ((++sp & 255u) == 0u) { if (xb_ld(&bar[XB_TMO])) break; if (sp > XB_SPIN_CAP) { atomicAdd(&bar[XB_TMO], 1u); break; } }
    }
    nloc = mine > 0u ? mine : 1u; nx = cnt > 0u ? cnt : 1u;
}

__device__ __forceinline__ void xcd_barrier(const XcdBarrier& b) {
    asm volatile("s_waitcnt vmcnt(0)" ::: "memory");
    __syncthreads();
    if (threadIdx.x == 0) {
        unsigned* bar = b.bar;
        __builtin_amdgcn_s_waitcnt(0);
        unsigned nloc = b.st[0], nx = b.st[1];
        if (nloc == 0u) { xcd_barrier_complete(bar, b.x, nloc, nx); b.st[0] = nloc; b.st[1] = nx; }
        const unsigned old = xb_add(&bar[XB_XSUB(b.x)], 1u);
        const unsigned gen = old / nloc;
        if (old + 1u == (gen + 1u) * nloc) {
            __builtin_amdgcn_fence(__ATOMIC_RELEASE, "agent");
            asm volatile("s_waitcnt vmcnt(0)" ::: "memory");
            const unsigned og = xb_add(&bar[XB_TOP], 1u);
            const unsigned tg = og / nx;
            if (og + 1u == (tg + 1u) * nx) xb_add(&bar[XB_TOPGEN], 1u);
            else XB_SPIN(xb_ld(&bar[XB_TOPGEN]) == tg, bar);
            __builtin_amdgcn_fence(__ATOMIC_ACQUIRE, "agent");
            xb_add(&bar[XB_XGEN(b.x)], 1u);
            asm volatile("s_waitcnt vmcnt(0)" ::: "memory");
        } else {
            XB_SPIN(xb_ld(&bar[XB_XGEN(b.x)]) == gen, bar);
            __builtin_amdgcn_fence(__ATOMIC_ACQUIRE, "agent");
            asm volatile("s_waitcnt vmcnt(0)" ::: "memory");
        }
    }
    __syncthreads();
}


__global__ void __launch_bounds__(NTHR) hybrid_block_megakernel(KP p) {
  extern __shared__ __attribute__((aligned(16))) char smem[];
  cg::grid_group grid = cg::this_grid();
  __shared__ int s_item;
  const int tid = otid();
  __shared__ uint4 xb_words;
  if (threadIdx.x == 0) xb_words = make_uint4(0u, 0u, 0u, 0u);
  __syncthreads();
  const XcdBarrier xb = xcd_barrier_post(p.cnt + 128, (volatile LAS unsigned*)&xb_words);

  mod_phase(p, smem);
  convert_weights(p, 0, smem);
  grid.sync();
  h0_phase(p);
  xcd_barrier(xb);

  for (int layer = 0; layer < 2; ++layer) {
    const int Mq = layer == 0 ? NTOK : NLAT;
    {
      pg8::StaticOrder S; S.init(NTOK, 6400, (int)gridDim.x, obid());
      pg8::EpiP E{p.P};
      pg8::gemm_phase<pg8::EpiP, pg8::StaticOrder, false>((PG8_LAS unsigned char*)smem, pg8::Gemm{p.H, p.WinT, NTOK, 6400, DM}, S, E, nullptr);
    }
    xcd_barrier(xb);
    {
      const int n_uq = (Mq / 256) * 6, n_ukv = 68 * 8, n_kr = NTOK / 8;
      for (int it = obid(); it < n_uq + n_ukv + n_kr; it += gridDim.x) {
        if (it < n_uq) gemm_tile(p, 1, layer, (it / 6) * 256, (it % 6) * 256, smem);
        else if (it < n_uq + n_ukv) { const int i = it - n_uq; gemm_tile(p, 2, layer, (i / 8) * 256, (i % 8) * 256, smem); }
        else krope_item(p, it - n_uq - n_ukv);
      }
    }
    xcd_barrier(xb);
    {
      for (int ch = obid(); ch < 160; ch += gridDim.x) {
        if (ch < 128) rwkv_chain(p, layer, ch, smem); else ret_chain(p, layer, ch - 128, smem);
      }
      const int n_att = layer == 0 ? 512 + 32 : 512;
      while (true) {
        __syncthreads();
        if (tid == 0) s_item = (int)atomicAdd(&p.cnt[layer], 1u);
        __syncthreads();
        const int it = s_item;
        if (it >= n_att) break;
        if (it < 512) {
          const int b = it >> 7, hd = (it >> 4) & 7, qb = it & 15;
          attn_item(p, b * 4096 + qb * 256, b, hd, LPOS, smem);
        } else {
          const int i = it - 512, b = i >> 3, hd = i & 7;
          attn_item(p, NLAT + b * 256, b, hd, 256, smem);
        }
      }
    }
    xcd_barrier(xb);
    merge_phase(p, layer, Mq);
    xcd_barrier(xb);
    const int nb0 = (layer == 0 && (int)gridDim.x >= 64) ? 32 : 0;
    {
      pg8::EpiZ Ez{layer == 0 ? p.x : p.out, p.ctx, p.out, p.X1c, p.mod + (size_t)layer * 5 * 6144};
      const int npass = layer == 0 ? 2 : 1;
      for (int pass = 0; pass < npass; ++pass) {
        pg8::OutOrder S; S.init(NLAT, DM, (int)gridDim.x, obid()); S.ctx = pass;
        if (pass == 0 || obid() < nb0)
          pg8::gemm_phase<pg8::EpiZ, pg8::OutOrder, false>((PG8_LAS unsigned char*)smem, pg8::Gemm{p.H, p.WoutT, pass ? NTOK : NLAT, DM, DM}, S, Ez, nullptr);
        if (pass == 0) xcd_barrier(xb);
      }
    }
    if (layer == 0) {
      if (!nb0) for (int it = obid(); it < 32; it += gridDim.x) gemm_tile(p, 3, layer, NLAT + (it >> 3) * 256, (it & 7) * 256, smem);
      ln_phase(p, 0, 0, NLAT, nb0);
      convert_weights(p, 1, smem, nb0);
      xcd_barrier(xb);
      ln_phase(p, 0, NLAT, NTOK);
      xcd_barrier(xb);
    } else {
      ln_phase(p, 1, 0, NLAT);
    }
  }
}

extern "C" void kernel_launch(void* const* d_in, const int* in_sizes, int n_in, void* d_out, int out_size, void* d_ws,
                              size_t ws_size, hipStream_t stream) {
  static int grid_blocks = 0;
  if (!grid_blocks) {
    int dev = 0, cus = 0, per_cu = 0;
    hipGetDevice(&dev);
    hipDeviceGetAttribute(&cus, hipDeviceAttributeMultiprocessorCount, dev);
    hipFuncSetAttribute((const void*)hybrid_block_megakernel, hipFuncAttributeMaxDynamicSharedMemorySize, (int)LDS_BYTES);
    hipOccupancyMaxActiveBlocksPerMultiprocessor(&per_cu, hybrid_block_megakernel, NTHR, LDS_BYTES);
    if (per_cu > 1) per_cu = 1;
    grid_blocks = cus * per_cu;
  }
  KP p{};
  const float* const* in = (const float* const*)d_in;
  p.x = in[0]; p.c = in[1]; p.ctx = in[2]; p.c_ctx = in[3]; p.w_ada = in[4]; p.b_ada = in[5]; p.w_in = in[6];
  p.ret_logit = in[7]; p.ret_gn = in[8]; p.q_g = in[9]; p.w_uq = in[10]; p.kv_g = in[11]; p.w_ukv = in[12]; p.mu = in[13];
  p.w0 = in[14]; p.w2 = in[15]; p.a0 = in[16]; p.a2 = in[17]; p.k_k = in[18]; p.k_a = in[19]; p.r_k = in[20]; p.rw_gn = in[21];
  p.w_out = in[22]; p.ln_g = in[23]; p.ln_b = in[24];
  p.out = (float*)d_out;
  char* ws = (char*)d_ws;
  size_t off = 0;
  auto take = [&](size_t bytes) { char* r = ws + off; off += (bytes + 255) & ~(size_t)255; return r; };
  p.P = (u16*)take((size_t)NTOK * NIN * 2);
  p.H = (u16*)take((size_t)NTOK * DM * 2);
  p.Q = (u16*)take((size_t)NTOK * 1536 * 2);
  p.Kn = (u16*)take((size_t)4 * 8 * LPOS * 128 * 2);
  p.Vt = (u16*)take((size_t)4 * 8 * 128 * LPOS * 2);
  p.Kr = (u16*)take((size_t)4 * LPOS * 64 * 2);
  p.Yret = (u16*)take((size_t)2 * NTOK * 512 * 2);
  p.Yrw = (u16*)take((size_t)2 * NTOK * 512 * 2);
  p.WinT = (u16*)take((size_t)6400 * DM * 2);
  p.WuqT = (u16*)take((size_t)1536 * 512 * 2);
  p.WukvT = (u16*)take((size_t)2048 * 256 * 2);
  p.WoutT = (u16*)take((size_t)DM * DM * 2);
  p.W2T = (u16*)take((size_t)2 * 512 * 64 * 2);
  p.A2T = (u16*)take((size_t)2 * 512 * 64 * 2);
  p.X1c = (float*)take((size_t)1024 * DM * 4);
  p.mod = (float*)take((size_t)2 * 5 * 6144 * 4);
  p.cnt = (unsigned*)take(512 + XCD_BAR_WORDS * 4);
  if (off > ws_size) { fprintf(stderr, "workspace too small: need %zu have %zu\n", off, ws_size); return; }
  hipMemsetAsync(p.cnt, 0, 512 + XCD_BAR_WORDS * 4, stream);
  void* args[] = {&p};
  hipError_t e = hipLaunchCooperativeKernel((void*)hybrid_block_megakernel, dim3(grid_blocks), dim3(NTHR), args, LDS_BYTES, stream);
  if (e != hipSuccess) fprintf(stderr, "cooperative launch failed: %s (grid %d)\n", hipGetErrorString(e), grid_blocks);
}
```

```cpp
#include <hip/hip_runtime.h>
#include <hip/hip_cooperative_groups.h>
#include <cstdio>
namespace cg = cooperative_groups;

#define DI __device__ __forceinline__
typedef unsigned short u16;
using bf16x8 = __attribute__((ext_vector_type(8))) short;
using s16x4 = __attribute__((ext_vector_type(4))) short;
using f32x16 = __attribute__((ext_vector_type(16))) float;
using f32x4 = __attribute__((ext_vector_type(4))) float;
using u32x4 = __attribute__((ext_vector_type(4))) unsigned;
using u32x2 = __attribute__((ext_vector_type(2))) unsigned;
using f32x2 = __attribute__((ext_vector_type(2))) float;
#define MFMA(a, b, c) __builtin_amdgcn_mfma_f32_32x32x16_bf16((a), (b), (c), 0, 0, 0)

constexpr int DM = 2048, NIN = 6208, NLAT = 16384, NTOK = 17408, LPOS = 4352;
constexpr int NTHR = 512;
constexpr size_t LDS_BYTES = 149504;
constexpr float ALPHA = 1.4142135623730951f;
constexpr float QSCALE = 0.07216878364870323f * 1.4426950408889634f;

struct KP {
  const float *x, *c, *ctx, *c_ctx, *w_ada, *b_ada, *w_in, *ret_logit, *ret_gn, *q_g, *w_uq, *kv_g, *w_ukv, *mu, *w0, *w2, *a0,
      *a2, *k_k, *k_a, *r_k, *rw_gn, *w_out, *ln_g, *ln_b;
  float* out;
  u16 *P, *H, *Q, *Kn, *Vt, *Kr, *Yret, *Yrw, *WinT, *WuqT, *WukvT, *WoutT, *W2T, *A2T;
  float *X1c, *mod;
  unsigned* cnt;
};

DI int otid() { int t = threadIdx.x; asm volatile("" : "+v"(t)); return t; }
DI int obid() { int t = blockIdx.x; asm volatile("" : "+s"(t)); return t; }
template <int CTRL> DI float dppf(float v) {
  return __builtin_bit_cast(float, __builtin_amdgcn_update_dpp(0, __builtin_bit_cast(int, v), CTRL, 0xf, 0xf, true));
}
DI float sum8(float x) { x += dppf<0xB1>(x); x += dppf<0x4E>(x); x += dppf<0x141>(x); return x; }
DI float sum16(float x) { x += dppf<0xB1>(x); x += dppf<0x4E>(x); x += dppf<0x141>(x); x += dppf<0x140>(x); return x; }
DI void lds_barrier() { asm volatile("s_waitcnt lgkmcnt(0)\n\ts_barrier" ::: "memory"); }
DI float bf2f(u16 v) { return __uint_as_float(((unsigned)v) << 16); }
DI float bflo(unsigned v) { return __uint_as_float(v << 16); }
DI float bfhi(unsigned v) { return __uint_as_float(v & 0xffff0000u); }
DI u16 f2bf(float a) { __bf16 r = (__bf16)a; return __builtin_bit_cast(u16, r); }
DI unsigned pk2(float a, float b) {
  typedef __bf16 bf2 __attribute__((ext_vector_type(2)));
  typedef float f2 __attribute__((ext_vector_type(2)));
  f2 v = {a, b};
  bf2 r = __builtin_convertvector(v, bf2);
  return __builtin_bit_cast(unsigned, r);
}
DI int crow(int reg, int h) { return (reg & 3) + 8 * (reg >> 2) + 4 * h; }
DI float silu(float x) { return x / (1.f + __expf(-x)); }
DI void unpack8(const bf16x8& v, float* f) {
  u32x4 u = __builtin_bit_cast(u32x4, v);
#pragma unroll
  for (int i = 0; i < 4; ++i) { f[2 * i] = bflo(u[i]); f[2 * i + 1] = bfhi(u[i]); }
}
DI bf16x8 pack8(const float* f) {
  u32x4 u;
#pragma unroll
  for (int i = 0; i < 4; ++i) u[i] = pk2(f[2 * i], f[2 * i + 1]);
  return __builtin_bit_cast(bf16x8, u);
}
DI bf16x8 ld8(const u16* p) { return *(const bf16x8*)p; }
DI bf16x8 zero8() { bf16x8 z = {0, 0, 0, 0, 0, 0, 0, 0}; return z; }
DI f32x16 zero16() { f32x16 z; for (int i = 0; i < 16; ++i) z[i] = 0.f; return z; }
DI s16x4 trread(const u16* p) {
  return __builtin_amdgcn_ds_read_tr16_b64_v4i16((s16x4 __attribute__((address_space(3)))*)(p));
}
DI bf16x8 cat4(s16x4 lo, s16x4 hi) { return __builtin_shufflevector(lo, hi, 0, 1, 2, 3, 4, 5, 6, 7); }
DI void rope_cs(int pos, int i, float& cs, float& sn) {
  float inv = exp2f(-(float)i * (13.287712379549449f / 16.f));
  float rev = (float)pos * inv * 0.15915494309189535f;
  rev -= floorf(rev);
  cs = __builtin_amdgcn_cosf(rev);
  sn = __builtin_amdgcn_sinf(rev);
}

DI void transpose_item(const float* src, u16* dst, int K, int N, int kt, int nt, char* smem) {
  float* tile = (float*)smem;
  const int tid = otid();
  __syncthreads();
  {
    const int kk = tid >> 4, n4 = tid & 15;
#pragma unroll
    for (int i = 0; i < 2; ++i) {
      const int k = kk + 32 * i;
      f32x4 v = *(const f32x4*)(src + (size_t)(kt * 64 + k) * N + nt * 64 + n4 * 4);
      tile[k * 65 + n4 * 4 + 0] = v[0]; tile[k * 65 + n4 * 4 + 1] = v[1];
      tile[k * 65 + n4 * 4 + 2] = v[2]; tile[k * 65 + n4 * 4 + 3] = v[3];
    }
  }
  __syncthreads();
  {
    const int n = tid >> 3, k8 = tid & 7;
    float f[8];
#pragma unroll
    for (int j = 0; j < 8; ++j) f[j] = tile[(k8 * 8 + j) * 65 + n];
    *(bf16x8*)(dst + (size_t)(nt * 64 + n) * K + kt * 64 + k8 * 8) = pack8(f);
  }
}

DI void convert_weights(const KP& p, int layer, char* smem, int b0 = 0) {
  const int n_in = 32 * 97, n_uq = 8 * 24, n_ukv = 4 * 32, n_out = 32 * 32, n_lora = 8;
  const int total = n_in + n_uq + n_ukv + n_out + 4 * n_lora;
  for (int it = obid() - b0; it < total; it += (int)gridDim.x - b0) {
    if (it < 0) break;
    int i = it;
    if (i < n_in) { transpose_item(p.w_in + (size_t)layer * DM * NIN, p.WinT, DM, NIN, i / 97, i % 97, smem); continue; }
    i -= n_in;
    if (i < n_uq) { transpose_item(p.w_uq + (size_t)layer * 512 * 1536, p.WuqT, 512, 1536, i / 24, i % 24, smem); continue; }
    i -= n_uq;
    if (i < n_ukv) { transpose_item(p.w_ukv + (size_t)layer * 256 * 2048, p.WukvT, 256, 2048, i / 32, i % 32, smem); continue; }
    i -= n_ukv;
    if (i < n_out) { transpose_item(p.w_out + (size_t)layer * DM * DM, p.WoutT, DM, DM, i / 32, i % 32, smem); continue; }
    i -= n_out;
    {
      const int which = i / (2 * n_lora), r = i % (2 * n_lora), d = r / n_lora, nt = r % n_lora;
      const float* src = (which ? p.a2 : p.w2) + ((size_t)layer * 2 + d) * 64 * 512;
      u16* dst = (which ? p.A2T : p.W2T) + (size_t)d * 512 * 64;
      transpose_item(src, dst, 64, 512, 0, nt, smem);
    }
  }
}

DI void mod_phase(const KP& p, char* smem) {
  float* sc = (float*)smem;
  float* red = sc + 5 * 2048;
  const int tid = otid();
  __syncthreads();
  for (int i = tid; i < 5 * 2048; i += NTHR) {
    float v = i < 4 * 2048 ? p.c[i] : p.c_ctx[i - 4 * 2048];
    sc[i] = silu(v);
  }
  __syncthreads();
  const int kg = tid >> 5, col = tid & 31;
  for (int it = obid(); it < 384; it += gridDim.x) {
    const int layer = it / 192, j = (it % 192) * 32 + col;
    const float* w = p.w_ada + (size_t)layer * DM * 6144 + j;
    float acc[5] = {0.f, 0.f, 0.f, 0.f, 0.f};
    for (int k = kg * 128; k < kg * 128 + 128; k += 16) {
      float wv[16];
#pragma unroll
      for (int u = 0; u < 16; ++u) wv[u] = w[(size_t)(k + u) * 6144];
#pragma unroll
      for (int u = 0; u < 16; ++u)
#pragma unroll
        for (int r = 0; r < 5; ++r) acc[r] += sc[r * 2048 + k + u] * wv[u];
    }
#pragma unroll
    for (int r = 0; r < 5; ++r) red[(kg * 5 + r) * 32 + col] = acc[r];
    __syncthreads();
    if (tid < 160) {
      const int r = tid >> 5;
      float s = p.b_ada[(size_t)layer * 6144 + j];
      for (int g = 0; g < 16; ++g) s += red[(g * 5 + r) * 32 + col];
      p.mod[((size_t)layer * 5 + r) * 6144 + j] = s;
    }
    __syncthreads();
  }
}

DI void h0_phase(const KP& p) {
  const int lane = otid() & 63, w = otid() >> 6;
  for (int row = obid() * 8 + w; row < NTOK; row += gridDim.x * 8) {
    const float* src = row < NLAT ? p.x + (size_t)row * DM : p.ctx + (size_t)(row - NLAT) * DM;
    const int bb = row < NLAT ? (row >> 12) : 4;
    const float* md = p.mod + (size_t)bb * 6144;
#pragma unroll
    for (int i = 0; i < 8; ++i) {
      const int c = (i * 64 + lane) * 4;
      f32x4 v = *(const f32x4*)(src + c), sh = *(const f32x4*)(md + c), scl = *(const f32x4*)(md + 2048 + c);
      u32x2 o;
      o[0] = pk2(v[0] * (1.f + scl[0]) + sh[0], v[1] * (1.f + scl[1]) + sh[1]);
      o[1] = pk2(v[2] * (1.f + scl[2]) + sh[2], v[3] * (1.f + scl[3]) + sh[3]);
      *(u32x2*)(p.H + (size_t)row * DM + c) = o;
    }
  }
}

namespace pg8 {
#define PG8_LAS __attribute__((address_space(3)))
typedef unsigned short bf16_t;
typedef short bf16x8 __attribute__((ext_vector_type(8)));
typedef float f32x4 __attribute__((ext_vector_type(4)));
typedef unsigned u32x4 __attribute__((ext_vector_type(4)));
constexpr int BM = 256, BK = 64, HALF = 128, HTB = HALF * BK * 2  , STAGE_BYTES = 8 * HTB, NXCD = 8, WGM = 8;

__host__ __device__ __forceinline__ int lds_byte(int r, int c) { const int st = (r >> 4) * 2 + (c >> 5), rr = r & 15, cc = c & 31, ob = rr * 64 + cc * 2; return st * 1024 + (ob ^ (((ob >> 9) & 1) << 5)); }
__host__ __device__ __forceinline__ void stage_rc(int b, int& R, int& C) { const int st = b / 1024, sb = b % 1024, swz = sb ^ (((sb >> 9) & 1) << 5); R = (st >> 1) * 16 + swz / 64; C = (st & 1) * 32 + (swz % 64) / 2; }
__host__ __device__ __forceinline__ int perm32(int rho) { const int n = rho >> 4, i = rho & 15; return 8 * (i >> 2) + 4 * n + (i & 3); }

struct Unit { int pm, pn; };
struct Gemm { const bf16_t* A; const bf16_t* Bt; int M, N, K; };

struct StaticOrder {
    int nM, nN, nwg, G, c;
    __host__ __device__ void init(int M, int N, int G_, int c_) { nM = M / BM; nN = N / BM; nwg = nM * nN; G = G_; c = c_; }
    __host__ __device__ bool next(int i, Unit& u) const {
        const long L = (long)i * G + c; if (L >= nwg) return false;
        int wgid = (int)L; { const int q = nwg / NXCD, r = nwg % NXCD, xcd = wgid % NXCD, off = wgid / NXCD; wgid = (xcd < r ? xcd * (q + 1) : r * (q + 1) + (xcd - r) * q) + off; }
        const int nig = WGM * nN, gid = wgid / nig, fm = gid * WGM, gsz = (nM - fm) < WGM ? (nM - fm) : WGM;
        u.pm = fm + ((wgid % nig) % gsz); u.pn = (wgid % nig) / gsz; return true;
    }
    __device__ __forceinline__ void a_ready(const Unit&) const {}
    __device__ __forceinline__ void done(const Unit&) const {}
};
__device__ __forceinline__ unsigned cvt_pk_bf16(float lo, float hi) { unsigned r; asm volatile("v_cvt_pk_bf16_f32 %0, %1, %2" : "=v"(r) : "v"(lo), "v"(hi)); return r; }

template <class Epi, class Sched, bool STAMP = false>
__device__ __forceinline__ void gemm_phase(PG8_LAS unsigned char* lds, const Gemm g, const Sched& S, const Epi& E, unsigned long long* stamps) {
    const int tid = otid(), wid = __builtin_amdgcn_readfirstlane(tid >> 6), lane = tid & 63, wr = wid >> 2, wc = wid & 3, fr = lane & 15, fq = lane >> 4;
    const int K = g.K, nt = K / BK;
    int ts_lo = 0, ts_hi = 0, nts = 0; const unsigned long long rt_entry = STAMP ? (unsigned long long)wall_clock64() : 0ull;
#define PG8_STAMP() do { if (STAMP && wid == 0 && nts < 64) { const unsigned long long _c = (unsigned long long)clock64(); \
        ts_lo = (lane == nts) ? (int)(unsigned)_c : ts_lo; ts_hi = (lane == nts) ? (int)(unsigned)(_c >> 32) : ts_hi; ++nts; } } while (0)
    PG8_STAMP();
    unsigned voffA[2], voffB[2];
#pragma unroll
    for (int i = 0; i < 2; ++i) { int R, C; stage_rc(tid * 16 + i * 8192, R, C); const int Rb = Epi::PERM ? ((R & ~31) + perm32(R & 31)) : R;
        voffA[i] = (unsigned)(R * K + C) * 2u; voffB[i] = (unsigned)(Rb * K + C) * 2u; }
    const size_t kstep = (size_t)(BK * 2);
    const size_t hstep = (size_t)HALF * K * 2;
    const size_t tstep = 2 * hstep;
    const unsigned ldsw = (unsigned)wid * 1024u;
    const int aoff = lds_byte(wr * 64 + fr, fq * 8), boff = lds_byte(wc * 32 + fr, fq * 8);
#define PG8_SA(b, h) (((b) * 2 + (h)) * HTB)
#define PG8_SB(b, h) ((4 + (b) * 2 + (h)) * HTB)
#define PG8_STAGE(bufoff, gbase, voff) do { _Pragma("unroll") for (int _i = 0; _i < 2; ++_i) \
        __builtin_amdgcn_global_load_lds((const unsigned*)((const char*)(gbase) + (voff)[_i]), (PG8_LAS unsigned*)(lds + (bufoff) + ldsw + _i * 8192), 16, 0, 0); } while (0)
#define PG8_LDA(dst, b, h) do { _Pragma("unroll") for (int m = 0; m < 4; ++m) _Pragma("unroll") for (int k = 0; k < 2; ++k) dst[m][k] = *(const PG8_LAS bf16x8*)(lds + PG8_SA(b, h) + aoff + m * 2048 + k * 1024); } while (0)
#define PG8_LDB(dst, b, h) do { _Pragma("unroll") for (int n = 0; n < 2; ++n) _Pragma("unroll") for (int k = 0; k < 2; ++k) dst[n][k] = *(const PG8_LAS bf16x8*)(lds + PG8_SB(b, h) + boff + n * 2048 + k * 1024); } while (0)
#define PG8_MMA(ai, bj, At, Bt) do { __builtin_amdgcn_s_setprio(1); _Pragma("unroll") for (int m = 0; m < 4; ++m) _Pragma("unroll") for (int n = 0; n < 2; ++n) _Pragma("unroll") for (int k = 0; k < 2; ++k) \
        acc[ai][bj][m][n] = __builtin_amdgcn_mfma_f32_16x16x32_bf16(Bt[n][k], At[m][k], acc[ai][bj][m][n], 0, 0, 0); __builtin_amdgcn_s_setprio(0); } while (0)
#define PG8_WAIT_V(n) asm volatile("s_waitcnt vmcnt(" #n ")" ::: "memory")
#define PG8_WAIT_L(n) asm volatile("s_waitcnt lgkmcnt(" #n ")" ::: "memory")
#define PG8_BAR __builtin_amdgcn_s_barrier()
#define PG8_SCHED __builtin_amdgcn_sched_barrier(0)
    Unit cur, nxt; int ui = 0;
    if (!S.next(0, cur)) return;
    f32x4 acc[2][2][4][2];
#pragma unroll
    for (int a = 0; a < 2; ++a)
#pragma unroll
        for (int b = 0; b < 2; ++b)
#pragma unroll
            for (int m = 0; m < 4; ++m)
#pragma unroll
                for (int n = 0; n < 2; ++n) acc[a][b][m][n] = (f32x4){0.f, 0.f, 0.f, 0.f};
    bf16x8 At[4][2], B0[2][2], B1[2][2];
    const char* cA = (const char*)g.A + (size_t)cur.pm * tstep; const char* cB = (const char*)g.Bt + (size_t)cur.pn * tstep;
    S.a_ready(cur);
    PG8_STAGE(PG8_SB(0, 0), cB, voffB); PG8_STAGE(PG8_SA(0, 0), cA, voffA); PG8_STAGE(PG8_SB(0, 1), cB + hstep, voffB); PG8_STAGE(PG8_SA(0, 1), cA + hstep, voffA);
    if (wr == 1) PG8_BAR;
    PG8_WAIT_V(4); PG8_BAR;
    PG8_STAGE(PG8_SB(1, 0), cB + kstep, voffB); PG8_STAGE(PG8_SA(1, 0), cA + kstep, voffA); PG8_STAGE(PG8_SB(1, 1), cB + hstep + kstep, voffB);
    PG8_WAIT_V(6); PG8_BAR;
    PG8_STAMP();
    for (;;) {
        const bool has_next = S.next(ui + 1, nxt);
        const char* nA = has_next ? (const char*)g.A + (size_t)nxt.pm * tstep : cA; const char* nB = has_next ? (const char*)g.Bt + (size_t)nxt.pn * tstep : cB;
        for (int t = 0; t < nt; t += 2) {
            const bool last = (t == nt - 2);
            const char* a1 = cA + (size_t)(t + 1) * kstep;
            const char* a2 = last ? nA : cA + (size_t)(t + 2) * kstep; const char* b2 = last ? nB : cB + (size_t)(t + 2) * kstep;
            const char* a3 = a2 + kstep; const char* b3 = b2 + kstep;
            if (last && has_next) S.a_ready(nxt);
            PG8_LDB(B0, 0, 0); PG8_SCHED; PG8_LDA(At, 0, 0); PG8_STAGE(PG8_SA(1, 1), a1 + hstep, voffA);
            PG8_WAIT_L(8); PG8_BAR; PG8_WAIT_L(0); PG8_MMA(0, 0, At, B0); PG8_BAR; PG8_SCHED;
            PG8_LDB(B1, 0, 1); PG8_STAGE(PG8_SB(0, 0), b2, voffB);
            PG8_BAR; PG8_WAIT_L(0); PG8_MMA(0, 1, At, B1); PG8_BAR;
            PG8_LDA(At, 0, 1); PG8_STAGE(PG8_SA(0, 0), a2, voffA);
            PG8_BAR; PG8_WAIT_L(0); PG8_MMA(1, 0, At, B0); PG8_BAR; PG8_SCHED;
            PG8_STAGE(PG8_SB(0, 1), b2 + hstep, voffB);
            PG8_WAIT_V(6); PG8_BAR; PG8_MMA(1, 1, At, B1); PG8_BAR;
            PG8_LDB(B0, 1, 0); PG8_SCHED; PG8_LDA(At, 1, 0); PG8_STAGE(PG8_SA(0, 1), a2 + hstep, voffA);
            PG8_WAIT_L(8); PG8_BAR; PG8_WAIT_L(0); PG8_MMA(0, 0, At, B0); PG8_BAR; PG8_SCHED;
            PG8_LDB(B1, 1, 1); PG8_STAGE(PG8_SB(1, 0), b3, voffB);
            PG8_BAR; PG8_WAIT_L(0); PG8_MMA(0, 1, At, B1); PG8_BAR;
            PG8_LDA(At, 1, 1); PG8_STAGE(PG8_SA(1, 0), a3, voffA);
            PG8_BAR; PG8_WAIT_L(0); PG8_MMA(1, 0, At, B0); PG8_BAR; PG8_SCHED;
            PG8_STAGE(PG8_SB(1, 1), b3 + hstep, voffB);
            PG8_WAIT_V(6); PG8_BAR; PG8_MMA(1, 1, At, B1); PG8_BAR;
        }
        PG8_STAMP();
        if constexpr (!Epi::AFTER_DRAIN) { E(acc, cur, wr, wc, fr, fq); S.done(cur); }
        PG8_STAMP();
        if (!has_next) break;
#pragma unroll
        for (int a = 0; a < 2; ++a)
#pragma unroll
            for (int b = 0; b < 2; ++b)
#pragma unroll
                for (int m = 0; m < 4; ++m)
#pragma unroll
                    for (int n = 0; n < 2; ++n) acc[a][b][m][n] = (f32x4){0.f, 0.f, 0.f, 0.f};
        cur = nxt; cA = nA; cB = nB; ++ui;
    }
    PG8_WAIT_V(0);
    if (wr == 0) PG8_BAR;
    PG8_BAR;
    if constexpr (Epi::AFTER_DRAIN) { E.fused(acc, cur, wr, wc, fr, fq, lds, wid, lane); S.done(cur); }
    PG8_STAMP();
    if (STAMP && wid == 0) { stamps[lane] = lane < nts ? (((unsigned long long)(unsigned)ts_hi << 32) | (unsigned)ts_lo) : 0ull;
        if (lane == 62) stamps[62] = rt_entry; if (lane == 63) stamps[63] = (unsigned long long)wall_clock64(); }
#undef PG8_STAMP
#undef PG8_SA
#undef PG8_SB
#undef PG8_STAGE
#undef PG8_LDA
#undef PG8_LDB
#undef PG8_MMA
#undef PG8_WAIT_V
#undef PG8_WAIT_L
#undef PG8_BAR
#undef PG8_SCHED
}

struct EpiP {
    static constexpr bool PERM = true, AFTER_DRAIN = false;
    bf16_t* O;
    __device__ __forceinline__ void operator()(const f32x4 (&acc)[2][2][4][2], const Unit& u, int wr, int wc, int fr, int fq) const {
        const int row0 = u.pm * BM + wr * 64 + fr, col0 = u.pn * BM + wc * 32 + 8 * fq;
#pragma unroll
        for (int ai = 0; ai < 2; ++ai)
#pragma unroll
            for (int m = 0; m < 4; ++m) { bf16_t* rowp = O + (size_t)(row0 + ai * HALF + m * 16) * 6208 + col0;
#pragma unroll
                for (int bj = 0; bj < 2; ++bj) { if (col0 + bj * HALF >= 6208) continue;
                    const f32x4 v0 = acc[ai][bj][m][0], v1 = acc[ai][bj][m][1];
                    u32x4 w; w.x = cvt_pk_bf16(v0[0], v0[1]); w.y = cvt_pk_bf16(v0[2], v0[3]); w.z = cvt_pk_bf16(v1[0], v1[1]); w.w = cvt_pk_bf16(v1[2], v1[3]);
                    *(u32x4*)(rowp + bj * HALF) = w; } }
    }
};
struct EpiZ {
    static constexpr bool PERM = false, AFTER_DRAIN = false;
    const float* xlat; const float* xctx; float* olat; float* octx; const float* mod;
    __device__ __forceinline__ void operator()(const f32x4 (&acc)[2][2][4][2], const Unit& u, int wr, int wc, int fr, int fq) const {
        const int row0 = u.pm * BM + wr * 64 + fr, col0 = u.pn * BM + wc * 32 + 4 * fq;
#pragma unroll
        for (int ai = 0; ai < 2; ++ai)
#pragma unroll
            for (int m = 0; m < 4; ++m) {
                const int row = row0 + ai * HALF + m * 16;
                const bool lat = row < 16384;
                const int bb = lat ? (row >> 12) : 4;
                const float* xr = lat ? xlat + (size_t)row * 2048 : xctx + (size_t)(row - 16384) * 2048;
                float* orow = lat ? olat + (size_t)row * 2048 : octx + (size_t)(row - 16384) * 2048;
                const float* gr = mod + (size_t)bb * 6144 + 4096;
#pragma unroll
                for (int bj = 0; bj < 2; ++bj)
#pragma unroll
                    for (int n = 0; n < 2; ++n) {
                        const int c = col0 + bj * HALF + n * 16;
                        const f32x4 xv = *(const f32x4*)(xr + c), gv = *(const f32x4*)(gr + c);
                        *(f32x4*)(orow + c) = 1.4142135623730951f * xv + gv * acc[ai][bj][m][n];
                    } }
    }
};
struct OutOrder : StaticOrder {
    int ctx;
    __device__ bool next(int i, Unit& u) const {
        if (ctx) { if (i != 0) return false; u.pm = 64 + (c >> 3); u.pn = c & 7; return true; }
        return StaticOrder::next(i, u);
    }
};
}

DI void gemm_tile(const KP& p, int mode, int layer, int m0, int n0, char* smem) {
  constexpr int STG = 512 * 72;
  u16* base = (u16*)smem;
  float* rs = (float*)(base + 2 * STG);
  const int tid = otid(), lane = tid & 63, w = tid >> 6, wm = w >> 2, wn = w & 3, l31 = lane & 31, h = lane >> 5;
  const u16* A; const u16* Bt; const float* gv = nullptr; int lda, K, N;
  if (mode == 0) { A = p.H; lda = DM; K = DM; N = NIN; Bt = p.WinT; }
  else if (mode == 1) { A = p.P + 2048; lda = NIN; K = 512; N = 1536; Bt = p.WuqT; gv = p.q_g + layer * 512; }
  else if (mode == 2) { A = p.P + 2560; lda = NIN; K = 256; N = 2048; Bt = p.WukvT; gv = p.kv_g + layer * 256; }
  else { A = p.H; lda = DM; K = DM; N = DM; Bt = p.WoutT; }
  const bool xf = (mode == 1 || mode == 2);
  const bool active = (n0 + wn * 64) < N;
  __syncthreads();
  if (xf) {
    const int r = tid >> 1, part = tid & 1;
    const u16* src = A + (size_t)(m0 + r) * lda + part * (K >> 1);
    float ss = 0.f;
    for (int i = 0; i < (K >> 1); i += 8) {
      float f[8]; unpack8(ld8(src + i), f);
#pragma unroll
      for (int j = 0; j < 8; ++j) ss += f[j] * f[j];
    }
    ss += __shfl_xor(ss, 1);
    if (!part) rs[r] = rsqrtf(ss / (float)K + 1e-6f);
    __syncthreads();
  }
  f32x16 acc[4][2];
#pragma unroll
  for (int i = 0; i < 4; ++i)
#pragma unroll
    for (int j = 0; j < 2; ++j) acc[i][j] = zero16();
  bf16x8 ra[4], rb[4];
  const int arow = tid >> 3, ac = tid & 7;
  auto loadg = [&](int k0) {
#pragma unroll
    for (int i = 0; i < 4; ++i) ra[i] = ld8(A + (size_t)(m0 + arow + 64 * i) * lda + k0 + ac * 8);
#pragma unroll
    for (int i = 0; i < 4; ++i) {
      int nrow = n0 + arow + 64 * i;
      nrow = nrow < N ? nrow : N - 1;
      rb[i] = ld8(Bt + (size_t)nrow * K + k0 + ac * 8);
    }
  };
  auto stage = [&](int buf, int k0) {
    u16* As = base + buf * STG;
    u16* Bs = As + 256 * 72;
#pragma unroll
    for (int i = 0; i < 4; ++i) {
      bf16x8 v = ra[i];
      if (xf) {
        float f[8]; unpack8(v, f);
        const float sc = rs[arow + 64 * i];
        f32x4 g0 = *(const f32x4*)(gv + k0 + ac * 8), g1 = *(const f32x4*)(gv + k0 + ac * 8 + 4);
#pragma unroll
        for (int j = 0; j < 4; ++j) { f[j] *= sc * g0[j]; f[4 + j] *= sc * g1[j]; }
        v = pack8(f);
      }
      *(bf16x8*)(As + (arow + 64 * i) * 72 + ac * 8) = v;
    }
#pragma unroll
    for (int i = 0; i < 4; ++i) *(bf16x8*)(Bs + (arow + 64 * i) * 72 + ac * 8) = rb[i];
  };
  const int nk = K >> 6;
  loadg(0);
  stage(0, 0);
  if (nk > 1) loadg(64);
  __syncthreads();
  for (int kt = 0; kt < nk; ++kt) {
    if (kt + 1 < nk) stage((kt + 1) & 1, (kt + 1) * 64);
    if (kt + 2 < nk) loadg((kt + 2) * 64);
    const u16* As = base + (kt & 1) * STG;
    const u16* Bs = As + 256 * 72;
    if (active) {
#pragma unroll
      for (int ks = 0; ks < 4; ++ks) {
        bf16x8 bfr[2], afr[4];
#pragma unroll
        for (int ni = 0; ni < 2; ++ni) bfr[ni] = ld8(Bs + (wn * 64 + ni * 32 + l31) * 72 + ks * 16 + h * 8);
#pragma unroll
        for (int mi = 0; mi < 4; ++mi) afr[mi] = ld8(As + (wm * 128 + mi * 32 + l31) * 72 + ks * 16 + h * 8);
#pragma unroll
        for (int mi = 0; mi < 4; ++mi)
#pragma unroll
          for (int ni = 0; ni < 2; ++ni) acc[mi][ni] = MFMA(afr[mi], bfr[ni], acc[mi][ni]);
      }
    }
    __syncthreads();
  }
#pragma unroll
  for (int mi = 0; mi < 4; ++mi)
#pragma unroll
    for (int ni = 0; ni < 2; ++ni) {
      const int cb = n0 + wn * 64 + ni * 32;
      if (cb >= N) continue;
      const int col = cb + l31;
      const int rb0 = m0 + wm * 128 + mi * 32;
      const f32x16& a = acc[mi][ni];
      if (mode == 0) {
#pragma unroll
        for (int r = 0; r < 16; ++r) p.P[(size_t)(rb0 + crow(r, h)) * NIN + col] = f2bf(a[r]);
      } else if (mode == 1) {
        const int dd = cb % 192;
        const bool rope = (dd >= 128) && (rb0 < NLAT);
        const int part = (dd - 128) >> 5;
#pragma unroll
        for (int r = 0; r < 16; ++r) {
          const int row = rb0 + crow(r, h);
          float v = a[r] * QSCALE;
          if (rope) {
            const int t = row & 4095;
            const int pos = part ? (t & 63) : (t >> 6);
            float cs, sn; rope_cs(pos, l31 & 15, cs, sn);
            const float pr = __shfl_xor(v, 16);
            v = (l31 < 16) ? (v * cs - pr * sn) : (v * cs + pr * sn);
          }
          p.Q[(size_t)row * 1536 + col] = f2bf(v);
        }
      } else if (mode == 2) {
        const int head = col >> 8, dd = col & 255;
#pragma unroll
        for (int g = 0; g < 4; ++g) {
          const int row = rb0 + 8 * g + 4 * h;
          int b, pos;
          if (row < NLAT) { b = row >> 12; pos = 256 + (row & 4095); } else { b = (row - NLAT) >> 8; pos = (row - NLAT) & 255; }
          if (dd < 128) {
#pragma unroll
            for (int j = 0; j < 4; ++j) p.Kn[((size_t)(b * 8 + head) * LPOS + pos + j) * 128 + dd] = f2bf(a[4 * g + j]);
          } else {
            u32x2 o; o[0] = pk2(a[4 * g], a[4 * g + 1]); o[1] = pk2(a[4 * g + 2], a[4 * g + 3]);
            *(u32x2*)(p.Vt + ((size_t)(b * 8 + head) * 128 + (dd - 128)) * LPOS + pos) = o;
          }
        }
      } else {
#pragma unroll
        for (int r = 0; r < 16; ++r) {
          const int row = rb0 + crow(r, h);
          const int bb = row < NLAT ? (row >> 12) : 4;
          const float gate = p.mod[((size_t)layer * 5 + bb) * 6144 + 4096 + col];
          float xv;
          float* dst;
          if (row < NLAT) {
            dst = p.out + (size_t)row * DM + col;
            xv = layer == 0 ? p.x[(size_t)row * DM + col] : *dst;
          } else {
            dst = p.X1c + (size_t)(row - NLAT) * DM + col;
            xv = p.ctx[(size_t)(row - NLAT) * DM + col];
          }
          *dst = ALPHA * xv + gate * a[r];
        }
      }
    }
}

DI void krope_item(const KP& p, int it) {
  const int tid = otid(), tok = tid >> 6, dim = tid & 63;
  const int row = it * 8 + tok;
  const u16* src = p.P + (size_t)row * NIN + 2816;
  float v = bf2f(src[dim]);
  int b, pos;
  if (row < NLAT) {
    const float pr = bf2f(src[dim ^ 16]);
    const int t = row & 4095, part = dim >> 5;
    const int ps = part ? (t & 63) : (t >> 6);
    float cs, sn; rope_cs(ps, dim & 15, cs, sn);
    v = ((dim & 31) < 16) ? (v * cs - pr * sn) : (v * cs + pr * sn);
    b = row >> 12; pos = 256 + t;
  } else { b = (row - NLAT) >> 8; pos = (row - NLAT) & 255; }
  p.Kr[((size_t)b * LPOS + pos) * 64 + dim] = f2bf(v);
}

DI void attn_item(const KP& p, int qrow0, int b, int hd, int nkeys, char* smem) {
  constexpr int STG = 64 * 200 + 128 * 72;
  u16* base = (u16*)smem;
  const int tid = otid(), lane = tid & 63, w = tid >> 6, l31 = lane & 31, h = lane >> 5;
  const int qrow = qrow0 + 32 * w + l31;
  bf16x8 qf[12];
  {
    const u16* qp = p.Q + (size_t)qrow * 1536 + hd * 192 + 8 * h;
#pragma unroll
    for (int ks = 0; ks < 12; ++ks) qf[ks] = ld8(qp + 16 * ks);
  }
  f32x16 o[4];
#pragma unroll
  for (int i = 0; i < 4; ++i) o[i] = zero16();
  float lsum = 0.f;
  f32x16 nm = zero16();
  b = __builtin_amdgcn_readfirstlane(b); hd = __builtin_amdgcn_readfirstlane(hd);
  const u16* kn = p.Kn + (size_t)(b * 8 + hd) * LPOS * 128;
  const u16* kr = p.Kr + (size_t)b * LPOS * 64;
  const u16* vt = p.Vt + (size_t)(b * 8 + hd) * 128 * LPOS;
  int koff[3], kdst[3], voff[2], vdst[2];
#pragma unroll
  for (int i = 0; i < 2; ++i) { const int idx = tid + NTHR * i, key = idx >> 4, c = idx & 15; koff[i] = key * 128 + c * 8; kdst[i] = key * 200 + c * 8; }
  { const int key = tid >> 3, c = tid & 7; koff[2] = key * 64 + c * 8; kdst[2] = key * 200 + 128 + c * 8; }
#pragma unroll
  for (int i = 0; i < 2; ++i) { const int idx = tid + NTHR * i, dd = idx >> 3, c = idx & 7; voff[i] = dd * LPOS + c * 8; vdst[i] = dd * 72 + 16 * (c >> 1) + 4 * (c & 1); }
  bf16x8 rk[3], rv[2];
  const auto rsKn = __builtin_amdgcn_make_buffer_rsrc((void*)kn, 0, LPOS * 128 * 2, 0x00020000);
  const auto rsKr = __builtin_amdgcn_make_buffer_rsrc((void*)kr, 0, LPOS * 64 * 2, 0x00020000);
  const auto rsVt = __builtin_amdgcn_make_buffer_rsrc((void*)vt, 0, 128 * LPOS * 2, 0x00020000);
  const int kb0 = koff[0] * 2, kb2 = koff[2] * 2, vb0 = voff[0] * 2;
  auto loadg = [&](int kt0) {
    rk[0] = __builtin_bit_cast(bf16x8, __builtin_amdgcn_raw_buffer_load_b128(rsKn, kb0, kt0 * 256, 0));
    rk[1] = __builtin_bit_cast(bf16x8, __builtin_amdgcn_raw_buffer_load_b128(rsKn, kb0, kt0 * 256 + 32 * 128 * 2, 0));
    rk[2] = __builtin_bit_cast(bf16x8, __builtin_amdgcn_raw_buffer_load_b128(rsKr, kb2, kt0 * 128, 0));
    rv[0] = __builtin_bit_cast(bf16x8, __builtin_amdgcn_raw_buffer_load_b128(rsVt, vb0, kt0 * 2, 0));
    rv[1] = __builtin_bit_cast(bf16x8, __builtin_amdgcn_raw_buffer_load_b128(rsVt, vb0, kt0 * 2 + 64 * LPOS * 2, 0));
  };
  auto stage = [&](int buf) {
    u16* Ksm = base + buf * STG;
    u16* Vsm = Ksm + 64 * 200;
#pragma unroll
    for (int i = 0; i < 3; ++i) *(bf16x8*)(Ksm + kdst[i]) = rk[i];
#pragma unroll
    for (int i = 0; i < 2; ++i) {
      u32x4 u = __builtin_bit_cast(u32x4, rv[i]);
      u32x2 lo = {u[0], u[1]}, hi = {u[2], u[3]};
      u16* dst = Vsm + vdst[i];
      *(u32x2*)dst = lo;
      *(u32x2*)(dst + 8) = hi;
    }
  };
  __syncthreads();
  if (__builtin_amdgcn_readfirstlane(w) >= 4) __builtin_amdgcn_s_setprio(1);
  const int ntile = nkeys >> 6;
  loadg(0);
  stage(0);
  if (ntile > 1) loadg(64);
  __syncthreads();
  for (int t = 0; t < ntile; ++t) {
    const u16* Ksm = base + (t & 1) * STG;
    const u16* Vsm = Ksm + 64 * 200;
    if (t + 1 < ntile) stage((t + 1) & 1);
    if (t + 2 < ntile) loadg((t + 2) * 64);
    f32x16 s[2];
#pragma unroll
    for (int kt = 0; kt < 2; ++kt) {
#pragma unroll
      for (int ks = 0; ks < 12; ++ks) {
        bf16x8 a = ld8(Ksm + (kt * 32 + l31) * 200 + ks * 16 + h * 8);
        s[kt] = ks == 0 ? MFMA(a, qf[ks], nm) : MFMA(a, qf[ks], s[kt]);
        if ((ks & 3) == 3) asm volatile("" ::: "memory");
      }
    }
    float mx = s[0][0];
#pragma unroll
    for (int r = 0; r < 16; ++r) { mx = fmaxf(mx, s[0][r]); mx = fmaxf(mx, s[1][r]); }
    {
      const auto sw = __builtin_amdgcn_permlane32_swap(__float_as_uint(mx), __float_as_uint(mx), false, false);
      mx = fmaxf(__uint_as_float(sw[0]), __uint_as_float(sw[1]));
    }
    if (t == 0 || __builtin_amdgcn_ballot_w64(mx > 8.f) != 0ull) {
      const float dlt = t == 0 ? mx : fmaxf(mx, 0.f);
      if (t != 0) {
        const float alpha = __builtin_amdgcn_exp2f(-dlt);
        lsum *= alpha;
#pragma unroll
        for (int dt = 0; dt < 4; ++dt)
#pragma unroll
          for (int r = 0; r < 16; ++r) o[dt][r] *= alpha;
      }
      const float nmv = nm[0] - dlt;
#pragma unroll
      for (int r = 0; r < 16; ++r) { nm[r] = nmv; s[0][r] -= dlt; s[1][r] -= dlt; }
    }
    float ps0 = 0.f, ps1 = 0.f;
#pragma unroll
    for (int r = 0; r < 16; ++r) {
      const float e0 = __builtin_amdgcn_exp2f(s[0][r]), e1 = __builtin_amdgcn_exp2f(s[1][r]);
      s[0][r] = e0; s[1][r] = e1;
      ps0 += e0; ps1 += e1;
    }
    lsum += ps0 + ps1;
#pragma unroll
    for (int kt = 0; kt < 2; ++kt)
#pragma unroll
      for (int sI = 0; sI < 2; ++sI) {
        u32x4 pu;
#pragma unroll
        for (int j = 0; j < 4; ++j) pu[j] = pk2(s[kt][8 * sI + 2 * j], s[kt][8 * sI + 2 * j + 1]);
        const bf16x8 pb = __builtin_bit_cast(bf16x8, pu);
        const int kb = kt * 32 + sI * 16 + 8 * h;
#pragma unroll
        for (int dt = 0; dt < 4; ++dt) o[dt] = MFMA(ld8(Vsm + (dt * 32 + l31) * 72 + kb), pb, o[dt]);
        asm volatile("" ::: "memory");
      }
    __syncthreads();
  }
  __builtin_amdgcn_s_setprio(0);
  lsum += __shfl_xor(lsum, 32);
  const float inv = 1.f / lsum;
  const u16* gp = p.P + (size_t)qrow * NIN + 2880 + hd * 128;
  u16* op = p.H + (size_t)qrow * DM + 512 + hd * 128;
#pragma unroll
  for (int dt = 0; dt < 4; ++dt)
#pragma unroll
    for (int g = 0; g < 4; ++g) {
      const int d0 = dt * 32 + 8 * g + 4 * h;
      u32x2 gg = *(const u32x2*)(gp + d0);
      float g0 = bflo(gg[0]), g1 = bfhi(gg[0]), g2 = bflo(gg[1]), g3 = bfhi(gg[1]);
      u32x2 ov;
      ov[0] = pk2(o[dt][4 * g] * inv * silu(g0), o[dt][4 * g + 1] * inv * silu(g1));
      ov[1] = pk2(o[dt][4 * g + 2] * inv * silu(g2), o[dt][4 * g + 3] * inv * silu(g3));
      *(u32x2*)(op + d0) = ov;
    }
}

DI void ret_chain(const KP& p, int layer, int chain, char* smem) {
  const int d = chain >> 4, b = (chain >> 2) & 3, hd = chain & 3;
  u16* Qs = (u16*)smem;
  u16* Ks = Qs + 128 * 136;
  u16* Vs = Ks + 128 * 136;
  u16* Sts = Vs + 128 * 136;
  const int tid = otid(), lane = tid & 63, w = tid >> 6, l31 = lane & 31, h = lane >> 5;
  const int q4 = (lane & 15) >> 2, p4 = lane & 3, blk = (lane >> 4) & 1;
  const float logit = p.ret_logit[(layer * 2 + d) * 4 + hd];
  const float z = -logit;
  const float logg = -(fmaxf(z, 0.f) + log1pf(expf(-fabsf(z))));
  const float lg2 = logg * 1.4426950408889634f;
  const float gC = exp2f(128.f * lg2);
  const float kscale = 0.08838834764831845f;
  const int iw = w & 3, half = w >> 2;
  const int kt = w & 3, vh = w >> 2;
  f32x16 st[2];
  st[0] = zero16(); st[1] = zero16();
  __syncthreads();
  for (int i = tid; i < 128 * 136 / 8; i += NTHR) *(bf16x8*)(Sts + i * 8) = zero8();
  bf16x8 rq[4], rk[4], rv[4];
  const int trow = tid >> 4, tc = tid & 15;
  auto rowbase = [&](int n) -> size_t {
    if (d == 0) return n < 2 ? (size_t)(NLAT + b * 256 + 128 * n) : (size_t)(b * 4096 + 128 * (n - 2));
    return n < 2 ? (size_t)(NLAT + b * 256 + 128 * (1 - n)) : (size_t)(b * 4096 + 128 * (33 - n));
  };
  auto loadg = [&](int n) {
    const size_t rb = rowbase(n);
#pragma unroll
    for (int i = 0; i < 4; ++i) {
      const u16* src = p.P + (rb + trow + 32 * i) * NIN + hd * 128 + tc * 8;
      rq[i] = ld8(src); rk[i] = ld8(src + 512); rv[i] = ld8(src + 1024);
    }
  };
  loadg(0);
  for (int n = 0; n < 34; ++n) {
    const size_t rb = rowbase(n);
#pragma unroll
    for (int i = 0; i < 4; ++i) {
      const int j = trow + 32 * i;
      *(bf16x8*)(Qs + j * 136 + tc * 8) = rq[i];
      *(bf16x8*)(Ks + j * 136 + tc * 8) = rk[i];
      const float zeta = exp2f((d == 0 ? (float)(127 - j) : (float)j) * lg2) * kscale;
      float f[8]; unpack8(rv[i], f);
#pragma unroll
      for (int jj = 0; jj < 8; ++jj) f[jj] *= zeta;
      *(bf16x8*)(Vs + j * 136 + tc * 8) = pack8(f);
    }
    __syncthreads();
    if (n + 1 < 34) loadg(n + 1);
    f32x16 acc[2];
    acc[0] = zero16(); acc[1] = zero16();
    bf16x8 qf[8];
#pragma unroll
    for (int ks = 0; ks < 8; ++ks) qf[ks] = ld8(Qs + (32 * iw + l31) * 136 + 16 * ks + 8 * h);
#pragma unroll
    for (int et = 0; et < 2; ++et)
#pragma unroll
      for (int ks = 0; ks < 8; ++ks) {
        bf16x8 a = ld8(Sts + (32 * (2 * half + et) + l31) * 136 + 16 * ks + 8 * h);
        acc[et] = MFMA(a, qf[ks], acc[et]);
      }
#pragma unroll
    for (int et = 0; et < 2; ++et)
#pragma unroll
      for (int r = 0; r < 16; ++r) acc[et][r] *= gC;
    const int ii = 32 * iw + l31;
#pragma unroll
    for (int jt = 0; jt < 4; ++jt) {
      f32x16 sT = zero16();
#pragma unroll
      for (int ks = 0; ks < 8; ++ks) {
        bf16x8 a = ld8(Ks + (32 * jt + l31) * 136 + 16 * ks + 8 * h);
        sT = MFMA(a, qf[ks], sT);
      }
#pragma unroll
      for (int r = 0; r < 16; ++r) {
        const int j = 32 * jt + crow(r, h);
        const bool keep = d == 0 ? (ii >= j) : (j >= ii);
        sT[r] = keep ? sT[r] : 0.f;
      }
#pragma unroll
      for (int sI = 0; sI < 2; ++sI) {
        u32x4 pu;
#pragma unroll
        for (int j = 0; j < 4; ++j) pu[j] = pk2(sT[8 * sI + 2 * j], sT[8 * sI + 2 * j + 1]);
        const bf16x8 pb = __builtin_bit_cast(bf16x8, pu);
        const int j0 = 32 * jt + 16 * sI + 4 * h;
#pragma unroll
        for (int et = 0; et < 2; ++et) {
          const u16* vp = Vs + (j0 + q4) * 136 + 32 * (2 * half + et) + 16 * blk + 4 * p4;
          s16x4 lo = trread(vp), hi = trread(vp + 8 * 136);
          acc[et] = MFMA(cat4(lo, hi), pb, acc[et]);
        }
      }
    }
    {
      const float rho = exp2f((d == 0 ? (float)(ii - 127) : (float)(-ii)) * lg2);
      u16* yp = p.Yret + ((size_t)d * NTOK + rb + ii) * 512 + hd * 128;
#pragma unroll
      for (int et = 0; et < 2; ++et)
#pragma unroll
        for (int g = 0; g < 4; ++g) {
          const int e0 = 32 * (2 * half + et) + 8 * g + 4 * h;
          u32x2 ov;
          ov[0] = pk2(acc[et][4 * g] * rho, acc[et][4 * g + 1] * rho);
          ov[1] = pk2(acc[et][4 * g + 2] * rho, acc[et][4 * g + 3] * rho);
          *(u32x2*)(yp + e0) = ov;
        }
    }
#pragma unroll
    for (int vi = 0; vi < 2; ++vi)
#pragma unroll
      for (int r = 0; r < 16; ++r) st[vi][r] *= gC;
#pragma unroll
    for (int ks = 0; ks < 8; ++ks) {
      const int jb = 16 * ks + 4 * h + q4;
      const u16* kp = Ks + jb * 136 + 32 * kt + 16 * blk + 4 * p4;
      const bf16x8 a = cat4(trread(kp), trread(kp + 8 * 136));
#pragma unroll
      for (int vi = 0; vi < 2; ++vi) {
        const u16* vp = Vs + jb * 136 + 32 * (2 * vh + vi) + 16 * blk + 4 * p4;
        const bf16x8 bfr = cat4(trread(vp), trread(vp + 8 * 136));
        st[vi] = MFMA(a, bfr, st[vi]);
      }
    }
    __syncthreads();
#pragma unroll
    for (int vi = 0; vi < 2; ++vi)
#pragma unroll
      for (int g = 0; g < 4; ++g) {
        const int v = 32 * (2 * vh + vi) + l31, k0 = 32 * kt + 8 * g + 4 * h;
        u32x2 ov;
        ov[0] = pk2(st[vi][4 * g], st[vi][4 * g + 1]);
        ov[1] = pk2(st[vi][4 * g + 2], st[vi][4 * g + 3]);
        *(u32x2*)(Sts + v * 136 + k0) = ov;
      }
  }
}

DI void rwkv_chain(const KP& p, int layer, int item, char* smem) {
  const int chain = item >> 1, vhalf = item & 1;
  const int d = chain >> 5, b = (chain >> 3) & 3, hd = chain & 7;
  float* buf = (float*)smem;
  u16* twS = (u16*)(smem + 98304);
  u16* alS = twS + 32 * 72;
  const int tid = otid(), lane = tid & 63, w = tid >> 6, l31 = lane & 31, h = lane >> 5;
  auto geom = [&](int cc, int& o0, int& len, size_t& rbase) {
    const int j0 = 32 * cc;
    const bool isctx = j0 < 256;
    len = isctx ? 256 : 4096;
    if (d == 0) o0 = isctx ? j0 : j0 - 256; else o0 = isctx ? (224 - j0) : (4064 - (j0 - 256));
    rbase = isctx ? (size_t)(NLAT + b * 256) : (size_t)(b * 4096);
  };
  __syncthreads();
  if (w >= 4) {
    const int pt = tid - 256;
    const int pw = w - 4, mat = pw >> 1, nh = pw & 1;
    const int matu = __builtin_amdgcn_readfirstlane(mat);
    bf16x8 bw[4];
    const int n = hd * 64 + nh * 32 + l31;
    {
      const u16* wT = (mat ? p.A2T : p.W2T) + ((size_t)d * 512 + n) * 64 + 8 * h;
#pragma unroll
      for (int ks = 0; ks < 4; ++ks) bw[ks] = ld8(wT + 16 * ks);
    }
    const float c0 = (mat ? p.a0 : p.w0)[((size_t)layer * 2 + d) * 512 + n];
    const int tok = pt >> 3, c8 = pt & 7;
    int colg[5];
    colg[0] = 3904 + hd * 64 + c8 * 8; colg[1] = 4416 + hd * 64 + c8 * 8; colg[2] = 4928 + hd * 64 + c8 * 8;
    colg[3] = 5440 + d * 64 + c8 * 8; colg[4] = 5568 + d * 64 + c8 * 8;
    const float* mu0 = p.mu + (size_t)layer * 2 * 1792;
    const float* mu1 = mu0 + 1792;
    float m0[5][8], m1[5][8], kkc[8], kac[8];
#pragma unroll
    for (int g = 0; g < 5; ++g)
#pragma unroll
      for (int j = 0; j < 8; ++j) { m0[g][j] = mu0[colg[g] - 3904 + j]; m1[g][j] = mu1[colg[g] - 3904 + j]; }
#pragma unroll
    for (int j = 0; j < 8; ++j) { kkc[j] = p.k_k[layer * 512 + hd * 64 + c8 * 8 + j]; kac[j] = p.k_a[layer * 512 + hd * 64 + c8 * 8 + j]; }
    bf16x8 raw[5][3];
    const u16* pcol[5];
#pragma unroll
    for (int g = 0; g < 5; ++g) pcol[g] = p.P + colg[g] + (size_t)tok * NIN;
    auto loadraw = [&](int cc) {
      int o0, len; size_t rbase; geom(cc, o0, len, rbase);
      const size_t roff = (rbase + o0) * NIN;
      if (o0 > 0 && o0 + 32 < len) {
#pragma unroll
        for (int g = 0; g < 5; ++g) {
          const u16* src = pcol[g] + roff;
          raw[g][1] = ld8(src); raw[g][0] = ld8(src - NIN); raw[g][2] = ld8(src + NIN);
        }
      } else {
        const int o = o0 + tok;
#pragma unroll
        for (int g = 0; g < 5; ++g) {
          const u16* src = pcol[g] + roff;
          raw[g][1] = ld8(src);
          raw[g][0] = o > 0 ? ld8(src - NIN) : zero8();
          raw[g][2] = o < len - 1 ? ld8(src + NIN) : zero8();
        }
      }
    };
    loadraw(0);
    for (int cn = 0; cn < 137; ++cn) {
      float* bbase = buf + (cn & 1) * 32 * 384;
      float* bb = bbase + tok * 384;
      if (cn < 136) {
#pragma unroll
        for (int g = 0; g < 5; ++g) {
          float cur[8], prv[8], nxt[8], sh[8];
          unpack8(raw[g][1], cur); unpack8(raw[g][0], prv); unpack8(raw[g][2], nxt);
#pragma unroll
          for (int j = 0; j < 8; ++j) sh[j] = cur[j] + m0[g][j] * (prv[j] - cur[j]) + m1[g][j] * (nxt[j] - cur[j]);
          if (g < 3) {
            float* dst = bb + (g == 0 ? 0 : g == 1 ? 128 : 320) + c8 * 8;
            *(f32x4*)dst = f32x4{sh[0], sh[1], sh[2], sh[3]};
            *(f32x4*)(dst + 4) = f32x4{sh[4], sh[5], sh[6], sh[7]};
          } else if (g == 3) {
#pragma unroll
            for (int j = 0; j < 8; ++j) sh[j] = 1.f - 2.f * __builtin_amdgcn_rcpf(1.f + __expf(2.f * sh[j]));
            *(bf16x8*)(twS + tok * 72 + c8 * 8) = pack8(sh);
          } else {
            *(bf16x8*)(alS + tok * 72 + c8 * 8) = pack8(sh);
          }
        }
      }
      lds_barrier();
      if (cn + 1 < 136) loadraw(cn + 1);
      if (cn < 136) {
        const u16* X = mat ? alS : twS;
        f32x16 acc = zero16();
#pragma unroll
        for (int ks = 0; ks < 4; ++ks) acc = MFMA(ld8(X + l31 * 72 + ks * 16 + h * 8), bw[ks], acc);
        const int ch = nh * 32 + l31;
        float* dstb = bbase + (matu == 0 ? 64 : 256) + ch + 4 * h * 384;
#pragma unroll
        for (int r = 0; r < 16; ++r) {
          float sg = __builtin_amdgcn_rcpf(1.f + __expf(-(c0 + acc[r])));
          if (matu == 0) sg = __expf(-0.6065306597126334f * sg);
          dstb[((r & 3) + 8 * (r >> 2)) * 384] = sg;
        }
      }
      lds_barrier();
      if (cn < 136) {
        float kk[8], kr[8], ar[8];
        float ss = 0.f;
        {
          f32x4 k0 = *(const f32x4*)(bb + 128 + c8 * 8), k1 = *(const f32x4*)(bb + 132 + c8 * 8);
          f32x4 a0 = *(const f32x4*)(bb + 256 + c8 * 8), a1 = *(const f32x4*)(bb + 260 + c8 * 8);
#pragma unroll
          for (int j = 0; j < 4; ++j) { kr[j] = k0[j]; kr[4 + j] = k1[j]; ar[j] = a0[j]; ar[4 + j] = a1[j]; }
        }
#pragma unroll
        for (int j = 0; j < 8; ++j) { kk[j] = kr[j] * kkc[j]; ss += kk[j] * kk[j]; }
        ss = sum8(ss);
        const float inv = fminf(__builtin_amdgcn_rsqf(ss), 1e12f);
        float oa[8], ob[8], ok[8];
#pragma unroll
        for (int j = 0; j < 8; ++j) {
          const float kkn = kk[j] * inv;
          oa[j] = -kkn; ob[j] = kkn * ar[j]; ok[j] = kr[j] * (1.f + (ar[j] - 1.f) * kac[j]);
        }
        *(f32x4*)(bb + 192 + c8 * 8) = f32x4{oa[0], oa[1], oa[2], oa[3]}; *(f32x4*)(bb + 196 + c8 * 8) = f32x4{oa[4], oa[5], oa[6], oa[7]};
        *(f32x4*)(bb + 256 + c8 * 8) = f32x4{ob[0], ob[1], ob[2], ob[3]}; *(f32x4*)(bb + 260 + c8 * 8) = f32x4{ob[4], ob[5], ob[6], ob[7]};
        *(f32x4*)(bb + 128 + c8 * 8) = f32x4{ok[0], ok[1], ok[2], ok[3]}; *(f32x4*)(bb + 132 + c8 * 8) = f32x4{ok[4], ok[5], ok[6], ok[7]};
      }
      lds_barrier();
    }
  } else {
    const int kq = lane & 15, vrow = 32 * vhalf + 8 * w + 2 * (lane >> 4);
    f32x2 S0[2], S1[2];
#pragma unroll
    for (int i = 0; i < 2; ++i) { S0[i] = f32x2{0.f, 0.f}; S1[i] = f32x2{0.f, 0.f}; }
    float py0 = 0.f, py1 = 0.f;
    const bool hi8 = (lane & 8) != 0;
    u16* pptr;
    {
      int o0, len; size_t rbase; geom(0, o0, len, rbase);
      pptr = p.Yrw + ((size_t)d * NTOK + rbase + o0) * 512 + hd * 64 + vrow + (hi8 ? 1 : 0) + (size_t)(d ? 31 : 0) * 512;
    }
    for (int c = -1; c < 136; ++c) {
      int o0 = 0, len; size_t rbase = 0;
      if (c >= 0) geom(c, o0, len, rbase);
      const float* bbase = buf + (c & 1) * 32 * 384;
      u16* yp = p.Yrw + ((size_t)d * NTOK + rbase + o0) * 512 + hd * 64 + vrow + (hi8 ? 1 : 0);
      f32x4 R0[5], R1[5], R2[5], R3[5];
      f32x2 v0, v1, v2, v3;
      auto ldstep = [&](int s, f32x4 (&R)[5], f32x2& vv) {
        s = s < 32 ? s : 31;
        const int i = d ? 31 - s : s;
        const float* t = bbase + i * 384 + 4 * kq;
#pragma unroll
        for (int q = 0; q < 5; ++q) R[q] = *(const f32x4*)(t + 64 * q);
        vv = *(const f32x2*)(bbase + i * 384 + 320 + vrow);
      };
      auto step = [&](const f32x4 (&R)[5], f32x2 vv, int s) {
        const int i = d ? 31 - s : s;
#define PAIR(q, j) (f32x2{R[q][2 * (j)], R[q][2 * (j) + 1]})
        f32x2 pa = S0[0] * PAIR(3, 0), pb = S1[0] * PAIR(3, 0);
        pa = S0[1] * PAIR(3, 1) + pa; pb = S1[1] * PAIR(3, 1) + pb;
        float sa0 = pa[0] + pa[1], sa1 = pb[0] + pb[1];
        float q = hi8 ? py1 : py0;
        const float qs = hi8 ? py0 : py1;
        q += dppf<0x140>(qs);
        sa0 += dppf<0xB1>(sa0); sa1 += dppf<0xB1>(sa1); q += dppf<0xB1>(q);
        sa0 += dppf<0x4E>(sa0); sa1 += dppf<0x4E>(sa1); q += dppf<0x4E>(q);
        sa0 += dppf<0x141>(sa0); sa1 += dppf<0x141>(sa1); q += dppf<0x141>(q);
        sa0 += dppf<0x140>(sa0); sa1 += dppf<0x140>(sa1);
        *pptr = f2bf(q);
        const f32x2 sA = {sa0, sa0}, sB = {sa1, sa1}, vA = {vv[0], vv[0]}, vB = {vv[1], vv[1]};
        f32x2 ya = {0.f, 0.f}, yb = {0.f, 0.f};
#pragma unroll
        for (int j = 0; j < 2; ++j) {
          const f32x2 wj = PAIR(1, j), kj = PAIR(2, j), bj = PAIR(4, j), rj = PAIR(0, j);
          S0[j] = S0[j] * wj + (sA * bj + vA * kj);
          S1[j] = S1[j] * wj + (sB * bj + vB * kj);
          ya = S0[j] * rj + ya; yb = S1[j] * rj + yb;
        }
#undef PAIR
        py0 = ya[0] + ya[1]; py1 = yb[0] + yb[1];
        pptr = yp + (size_t)i * 512;
      };
      if (c >= 0) { ldstep(0, R0, v0); ldstep(1, R1, v1); }
#pragma unroll 1
      for (int part = 0; part < 3; ++part) {
        if (c >= 0) {
          const int s0 = part * 12, s1 = part == 2 ? 32 : s0 + 12;
          for (int s = s0; s < s1; s += 4) {
            ldstep(s + 2, R2, v2); step(R0, v0, s);
            ldstep(s + 3, R3, v3); step(R1, v1, s + 1);
            ldstep(s + 4, R0, v0); step(R2, v2, s + 2);
            ldstep(s + 5, R1, v1); step(R3, v3, s + 3);
          }
        }
        lds_barrier();
      }
    }
    { const float y0 = sum16(py0), y1 = sum16(py1); *pptr = f2bf(hi8 ? y1 : y0); }
  }
}

DI void merge_phase(const KP& p, int layer, int M) {
  const int lane = otid() & 63, w = otid() >> 6;
  const float* mu0 = p.mu + (size_t)layer * 2 * 1792;
  const float* mu1 = mu0 + 1792;
  for (int row = obid() * 8 + w; row < M; row += gridDim.x * 8) {
    const int ch0 = lane * 8;
    {
      float y0[8], y1[8], y[8];
      unpack8(ld8(p.Yret + (size_t)row * 512 + ch0), y0);
      unpack8(ld8(p.Yret + ((size_t)NTOK + row) * 512 + ch0), y1);
      float s = 0.f;
#pragma unroll
      for (int j = 0; j < 8; ++j) { y[j] = y0[j] + y1[j]; s += y[j]; }
      s += __shfl_xor(s, 1); s += __shfl_xor(s, 2); s += __shfl_xor(s, 4); s += __shfl_xor(s, 8);
      const float mean = s * (1.f / 128.f);
      float v = 0.f;
#pragma unroll
      for (int j = 0; j < 8; ++j) { const float dlt = y[j] - mean; v += dlt * dlt; }
      v += __shfl_xor(v, 1); v += __shfl_xor(v, 2); v += __shfl_xor(v, 4); v += __shfl_xor(v, 8);
      const float rstd = rsqrtf(v * (1.f / 128.f) + 1e-5f);
      float gt[8], o[8];
      unpack8(ld8(p.P + (size_t)row * NIN + 1536 + ch0), gt);
#pragma unroll
      for (int j = 0; j < 8; ++j) o[j] = (y[j] - mean) * rstd * p.ret_gn[layer * 512 + ch0 + j] * silu(gt[j]);
      *(bf16x8*)(p.H + (size_t)row * DM + ch0) = pack8(o);
    }
    {
      float y0[8], y1[8], y[8];
      unpack8(ld8(p.Yrw + (size_t)row * 512 + ch0), y0);
      unpack8(ld8(p.Yrw + ((size_t)NTOK + row) * 512 + ch0), y1);
      float s = 0.f;
#pragma unroll
      for (int j = 0; j < 8; ++j) { y[j] = y0[j] + y1[j]; s += y[j]; }
      s += __shfl_xor(s, 1); s += __shfl_xor(s, 2); s += __shfl_xor(s, 4);
      const float mean = s * (1.f / 64.f);
      float v = 0.f;
#pragma unroll
      for (int j = 0; j < 8; ++j) { const float dlt = y[j] - mean; v += dlt * dlt; }
      v += __shfl_xor(v, 1); v += __shfl_xor(v, 2); v += __shfl_xor(v, 4);
      const float rstd = rsqrtf(v * (1.f / 64.f) + 64e-5f);
      int o, len;
      if (row < NLAT) { o = row & 4095; len = 4096; } else { o = (row - NLAT) & 255; len = 256; }
      float f[3][8];
#pragma unroll
      for (int g = 0; g < 3; ++g) {
        const int col = 3904 + 512 * g + ch0;
        const u16* src = p.P + (size_t)row * NIN + col;
        float cur[8], prv[8], nxt[8];
        unpack8(ld8(src), cur);
        if (o > 0) unpack8(ld8(src - NIN), prv); else { for (int j = 0; j < 8; ++j) prv[j] = 0.f; }
        if (o < len - 1) unpack8(ld8(src + NIN), nxt); else { for (int j = 0; j < 8; ++j) nxt[j] = 0.f; }
#pragma unroll
        for (int j = 0; j < 8; ++j) {
          const float m0v = mu0[col - 3904 + j], m1v = mu1[col - 3904 + j];
          f[g][j] = cur[j] + m0v * (prv[j] - cur[j]) + m1v * (nxt[j] - cur[j]);
        }
      }
      float rk = 0.f;
#pragma unroll
      for (int j = 0; j < 8; ++j) rk += f[0][j] * f[1][j] * p.r_k[layer * 512 + ch0 + j];
      rk += __shfl_xor(rk, 1); rk += __shfl_xor(rk, 2); rk += __shfl_xor(rk, 4);
      float gt[8], ov[8];
      unpack8(ld8(p.P + (size_t)row * NIN + 5696 + ch0), gt);
#pragma unroll
      for (int j = 0; j < 8; ++j)
        ov[j] = ((y[j] - mean) * rstd * p.rw_gn[layer * 512 + ch0 + j] + rk * f[2][j]) * silu(gt[j]);
      *(bf16x8*)(p.H + (size_t)row * DM + 1536 + ch0) = pack8(ov);
    }
  }
}

DI void ln_phase(const KP& p, int layer, int r0, int M, int b0 = 0) {
  const int lane = otid() & 63, w = otid() >> 6;
  const float* g = p.ln_g + layer * DM;
  const float* bb_ = p.ln_b + layer * DM;
  if (obid() < b0) return;
  for (int row = r0 + (obid() - b0) * 8 + w; row < M; row += ((int)gridDim.x - b0) * 8) {
    float* ptr = row < NLAT ? p.out + (size_t)row * DM : p.X1c + (size_t)(row - NLAT) * DM;
    f32x4 v[8];
    float s = 0.f;
#pragma unroll
    for (int i = 0; i < 8; ++i) { v[i] = *(const f32x4*)(ptr + (i * 64 + lane) * 4); s += v[i][0] + v[i][1] + v[i][2] + v[i][3]; }
#pragma unroll
    for (int o = 1; o < 64; o <<= 1) s += __shfl_xor(s, o);
    const float mean = s * (1.f / 2048.f);
    float q = 0.f;
#pragma unroll
    for (int i = 0; i < 8; ++i)
#pragma unroll
      for (int j = 0; j < 4; ++j) { const float dlt = v[i][j] - mean; q += dlt * dlt; }
#pragma unroll
    for (int o = 1; o < 64; o <<= 1) q += __shfl_xor(q, o);
    const float rstd = rsqrtf(q * (1.f / 2048.f) + 1e-5f);
    const int bidx = row < NLAT ? (row >> 12) : 4;
    const float* md = p.mod + ((size_t)5 + bidx) * 6144;
#pragma unroll
    for (int i = 0; i < 8; ++i) {
      const int c = (i * 64 + lane) * 4;
      f32x4 gg = *(const f32x4*)(g + c), bbv = *(const f32x4*)(bb_ + c), y;
#pragma unroll
      for (int j = 0; j < 4; ++j) y[j] = (v[i][j] - mean) * rstd * gg[j] + bbv[j];
      *(f32x4*)(ptr + c) = y;
      if (layer == 0) {
        f32x4 sh = *(const f32x4*)(md + c), scl = *(const f32x4*)(md + 2048 + c);
        u32x2 o;
        o[0] = pk2(y[0] * (1.f + scl[0]) + sh[0], y[1] * (1.f + scl[1]) + sh[1]);
        o[1] = pk2(y[2] * (1.f + scl[2]) + sh[2], y[3] * (1.f + scl[3]) + sh[3]);
        *(u32x2*)(p.H + (size_t)row * DM + c) = o;
      }
    }
  }
}

#define XB_TMO      128
#define XB_XCNT(j)  (256  + 64 * (j))
#define XB_XSUB(j)  (1280 + 64 * (j))
#define XB_XGEN(j)  (2304 + 64 * (j))
#define XB_TOP      3328
#define XB_TOPGEN   3392
#define XCD_BAR_WORDS 3456
#define XB_SPIN_CAP (1u << 18)
#define LAS __attribute__((address_space(3)))

__device__ __forceinline__ unsigned xb_ld(unsigned* p)              { return __hip_atomic_load(p, __ATOMIC_RELAXED, __HIP_MEMORY_SCOPE_AGENT); }
__device__ __forceinline__ unsigned xb_add(unsigned* p, unsigned v) { return __hip_atomic_fetch_add(p, v, __ATOMIC_RELAXED, __HIP_MEMORY_SCOPE_AGENT); }
__device__ __forceinline__ unsigned xb_xcc_id() { return (unsigned)__builtin_amdgcn_s_getreg((3 << 11) | 20) & 0xFu; }
#define XB_SPIN(cond, bar) do { unsigned _sp = 0; while (cond) { __builtin_amdgcn_s_sleep(1); \
    if ((++_sp & 255u) == 0u) { if (xb_ld(&(bar)[XB_TMO])) break; if (_sp > XB_SPIN_CAP) { atomicAdd(&(bar)[XB_TMO], 1u); break; } } } } while (0)

struct XcdBarrier {
    unsigned* bar; unsigned x;
    volatile LAS unsigned* st;
};

__device__ __forceinline__ XcdBarrier xcd_barrier_post(unsigned* bar, volatile LAS unsigned* st) {
    XcdBarrier b; b.bar = bar; b.x = xb_xcc_id(); b.st = st;
    if (threadIdx.x == 0) (void)xb_add(&bar[XB_XCNT(b.x)], 1u);
    return b;
}
__device__ __forceinline__ void xcd_barrier_complete(unsigned* bar, unsigned x, unsigned& nloc, unsigned& nx) {
    const unsigned G = gridDim.x * gridDim.y * gridDim.z;
    unsigned sum, cnt, mine, sp = 0u;
    for (;;) {
        sum = 0u; cnt = 0u; mine = 0u;
#pragma unroll
        for (unsigned j = 0; j < 16; ++j) { const unsigned c = xb_ld(&bar[XB_XCNT(j)]); sum += c; cnt += (c > 0u) ? 1u : 0u; mine = (j == x) ? c : mine; }
        if (sum == G) break;
        __builtin_amdgcn_s_sleep(1);
        if ((++sp & 255u) == 0u) { if (xb_ld(&bar[XB_TMO])) break; if (sp > XB_SPIN_CAP) { atomicAdd(&bar[XB_TMO], 1u); break; } }
    }
    nloc = mine > 0u ? mine : 1u; nx = cnt > 0u ? cnt : 1u;
}

__device__ __forceinline__ void xcd_barrier(const XcdBarrier& b) {
    asm volatile("s_waitcnt vmcnt(0)" ::: "memory");
    __syncthreads();
    if (threadIdx.x == 0) {
        unsigned* bar = b.bar;
        __builtin_amdgcn_s_waitcnt(0);
        unsigned nloc = b.st[0], nx = b.st[1];
        if (nloc == 0u) { xcd_barrier_complete(bar, b.x, nloc, nx); b.st[0] = nloc; b.st[1] = nx; }
        const unsigned old = xb_add(&bar[XB_XSUB(b.x)], 1u);
        const unsigned gen = old / nloc;
        if (old + 1u == (gen + 1u) * nloc) {
            __builtin_amdgcn_fence(__ATOMIC_RELEASE, "agent");
            asm volatile("s_waitcnt vmcnt(0)" ::: "memory");
            const unsigned og = xb_add(&bar[XB_TOP], 1u);
            const unsigned tg = og / nx;
            if (og + 1u == (tg + 1u) * nx) xb_add(&bar[XB_TOPGEN], 1u);
            else XB_SPIN(xb_ld(&bar[XB_TOPGEN]) == tg, bar);
            __builtin_amdgcn_fence(__ATOMIC_ACQUIRE, "agent");
            xb_add(&bar[XB_XGEN(b.x)], 1u);
            asm volatile("s_waitcnt vmcnt(0)" ::: "memory");
        } else {
            XB_SPIN(xb_ld(&bar[XB_XGEN(b.x)]) == gen, bar);
            __builtin_amdgcn_fence(__ATOMIC_ACQUIRE, "agent");
            asm volatile("s_waitcnt vmcnt(0)" ::: "memory");
        }
    }
    __syncthreads();
}


__global__ void __launch_bounds__(NTHR) hybrid_block_megakernel(KP p) {
  extern __shared__ __attribute__((aligned(16))) char smem[];
  cg::grid_group grid = cg::this_grid();
  __shared__ int s_item;
  const int tid = otid();
  __shared__ uint4 xb_words;
  if (threadIdx.x == 0) xb_words = make_uint4(0u, 0u, 0u, 0u);
  __syncthreads();
  const XcdBarrier xb = xcd_barrier_post(p.cnt + 128, (volatile LAS unsigned*)&xb_words);

  mod_phase(p, smem);
  convert_weights(p, 0, smem);
  grid.sync();
  h0_phase(p);
  xcd_barrier(xb);

  for (int layer = 0; layer < 2; ++layer) {
    const int Mq = layer == 0 ? NTOK : NLAT;
    {
      pg8::StaticOrder S; S.init(NTOK, 6400, (int)gridDim.x, obid());
      pg8::EpiP E{p.P};
      pg8::gemm_phase<pg8::EpiP, pg8::StaticOrder, false>((PG8_LAS unsigned char*)smem, pg8::Gemm{p.H, p.WinT, NTOK, 6400, DM}, S, E, nullptr);
    }
    xcd_barrier(xb);
    {
      const int n_uq = (Mq / 256) * 6, n_ukv = 68 * 8, n_kr = NTOK / 8;
      for (int it = obid(); it < n_uq + n_ukv + n_kr; it += gridDim.x) {
        if (it < n_uq) gemm_tile(p, 1, layer, (it / 6) * 256, (it % 6) * 256, smem);
        else if (it < n_uq + n_ukv) { const int i = it - n_uq; gemm_tile(p, 2, layer, (i / 8) * 256, (i % 8) * 256, smem); }
        else krope_item(p, it - n_uq - n_ukv);
      }
    }
    xcd_barrier(xb);
    {
      for (int ch = obid(); ch < 160; ch += gridDim.x) {
        if (ch < 128) rwkv_chain(p, layer, ch, smem); else ret_chain(p, layer, ch - 128, smem);
      }
      const int n_att = layer == 0 ? 512 + 32 : 512;
      while (true) {
        __syncthreads();
        if (tid == 0) s_item = (int)atomicAdd(&p.cnt[layer], 1u);
        __syncthreads();
        const int it = s_item;
        if (it >= n_att) break;
        if (it < 512) {
          const int b = it >> 7, hd = (it >> 4) & 7, qb = it & 15;
          attn_item(p, b * 4096 + qb * 256, b, hd, LPOS, smem);
        } else {
          const int i = it - 512, b = i >> 3, hd = i & 7;
          attn_item(p, NLAT + b * 256, b, hd, 256, smem);
        }
      }
    }
    xcd_barrier(xb);
    merge_phase(p, layer, Mq);
    xcd_barrier(xb);
    const int nb0 = (layer == 0 && (int)gridDim.x >= 64) ? 32 : 0;
    {
      pg8::EpiZ Ez{layer == 0 ? p.x : p.out, p.ctx, p.out, p.X1c, p.mod + (size_t)layer * 5 * 6144};
      const int npass = layer == 0 ? 2 : 1;
      for (int pass = 0; pass < npass; ++pass) {
        pg8::OutOrder S; S.init(NLAT, DM, (int)gridDim.x, obid()); S.ctx = pass;
        if (pass == 0 || obid() < nb0)
          pg8::gemm_phase<pg8::EpiZ, pg8::OutOrder, false>((PG8_LAS unsigned char*)smem, pg8::Gemm{p.H, p.WoutT, pass ? NTOK : NLAT, DM, DM}, S, Ez, nullptr);
        if (pass == 0) xcd_barrier(xb);
      }
    }
    if (layer == 0) {
      if (!nb0) for (int it = obid(); it < 32; it += gridDim.x) gemm_tile(p, 3, layer, NLAT + (it >> 3) * 256, (it & 7) * 256, smem);
      ln_phase(p, 0, 0, NLAT, nb0);
      convert_weights(p, 1, smem, nb0);
      xcd_barrier(xb);
      ln_phase(p, 0, NLAT, NTOK);
      xcd_barrier(xb);
    } else {
      ln_phase(p, 1, 0, NLAT);
    }
  }
}

extern "C" void kernel_launch(void* const* d_in, const int* in_sizes, int n_in, void* d_out, int out_size, void* d_ws,
                              size_t ws_size, hipStream_t stream) {
  static int grid_blocks = 0;
  if (!grid_blocks) {
    int dev = 0, cus = 0, per_cu = 0;
    hipGetDevice(&dev);
    hipDeviceGetAttribute(&cus, hipDeviceAttributeMultiprocessorCount, dev);
    hipFuncSetAttribute((const void*)hybrid_block_megakernel, hipFuncAttributeMaxDynamicSharedMemorySize, (int)LDS_BYTES);
    hipOccupancyMaxActiveBlocksPerMultiprocessor(&per_cu, hybrid_block_megakernel, NTHR, LDS_BYTES);
    if (per_cu > 1) per_cu = 1;
    grid_blocks = cus * per_cu;
  }
  KP p{};
  const float* const* in = (const float* const*)d_in;
  p.x = in[0]; p.c = in[1]; p.ctx = in[2]; p.c_ctx = in[3]; p.w_ada = in[4]; p.b_ada = in[5]; p.w_in = in[6];
  p.ret_logit = in[7]; p.ret_gn = in[8]; p.q_g = in[9]; p.w_uq = in[10]; p.kv_g = in[11]; p.w_ukv = in[12]; p.mu = in[13];
  p.w0 = in[14]; p.w2 = in[15]; p.a0 = in[16]; p.a2 = in[17]; p.k_k = in[18]; p.k_a = in[19]; p.r_k = in[20]; p.rw_gn = in[21];
  p.w_out = in[22]; p.ln_g = in[23]; p.ln_b = in[24];
  p.out = (float*)d_out;
  char* ws = (char*)d_ws;
  size_t off = 0;
  auto take = [&](size_t bytes) { char* r = ws + off; off += (bytes + 255) & ~(size_t)255; return r; };
  p.P = (u16*)take((size_t)NTOK * NIN * 2);
  p.H = (u16*)take((size_t)NTOK * DM * 2);
  p.Q = (u16*)take((size_t)NTOK * 1536 * 2);
  p.Kn = (u16*)take((size_t)4 * 8 * LPOS * 128 * 2);
  p.Vt = (u16*)take((size_t)4 * 8 * 128 * LPOS * 2);
  p.Kr = (u16*)take((size_t)4 * LPOS * 64 * 2);
  p.Yret = (u16*)take((size_t)2 * NTOK * 512 * 2);
  p.Yrw = (u16*)take((size_t)2 * NTOK * 512 * 2);
  p.WinT = (u16*)take((size_t)6400 * DM * 2);
  p.WuqT = (u16*)take((size_t)1536 * 512 * 2);
  p.WukvT = (u16*)take((size_t)2048 * 256 * 2);
  p.WoutT = (u16*)take((size_t)DM * DM * 2);
  p.W2T = (u16*)take((size_t)2 * 512 * 64 * 2);
  p.A2T = (u16*)take((size_t)2 * 512 * 64 * 2);
  p.X1c = (float*)take((size_t)1024 * DM * 4);
  p.mod = (float*)take((size_t)2 * 5 * 6144 * 4);
  p.cnt = (unsigned*)take(512 + XCD_BAR_WORDS * 4);
  if (off > ws_size) { fprintf(stderr, "workspace too small: need %zu have %zu\n", off, ws_size); return; }
  hipMemsetAsync(p.cnt, 0, 512 + XCD_BAR_WORDS * 4, stream);
  void* args[] = {&p};
  hipError_t e = hipLaunchCooperativeKernel((void*)hybrid_block_megakernel, dim3(grid_blocks), dim3(NTHR), args, LDS_BYTES, stream);
  if (e != hipSuccess) fprintf(stderr, "cooperative launch failed: %s (grid %d)\n", hipGetErrorString(e), grid_blocks);
}
```
